# Optimizing an MI355X kernel written in HIP

```python
import math
import jax
import jax.numpy as jnp
from jax import lax
import numpy as np

D_MODEL = 1024
BATCH = 4
SEQ = 8192
DEPTH = 2

GRID_W = 64
CTX_LEN = 256
N_EVEN = (DEPTH + 1) // 2
N_ODD = DEPTH // 2
N_MOD = 9
D_FF = 2816
EPS = 1e-6
HEAD_DIM = 64
ROPE_BASE = 10000.0
BLOCK = 128

S5_WIDTH = 512
S5_GROUP = 16
S5_GROUPS = S5_WIDTH // S5_GROUP
S5_STATE = 64
SWA_HEADS = 8
SWA_KV_HEADS = 2
SWA_WINDOW = 128
EVEN_IN = S5_WIDTH + (SWA_HEADS + 2 * SWA_KV_HEADS) * HEAD_DIM
EVEN_MIX = S5_WIDTH + SWA_HEADS * HEAD_DIM

LRU_WIDTH = 512
LRU_BLOCKS = 8
LRU_BLOCK_DIM = LRU_WIDTH // LRU_BLOCKS
CONV_W = 4
LRU_C = 8.0
DIFF_HEADS = 4
DIFF_HALF = HEAD_DIM
DIFF_V = 2 * DIFF_HALF
ODD_IN = 2 * LRU_WIDTH + 3 * DIFF_HEADS * DIFF_V
ODD_MIX = LRU_WIDTH + DIFF_HEADS * DIFF_V

kernel_name = 'hybrid_s5_swa_rglru_diffattn_prefix_dit'

F32 = jnp.float32


def rms_norm(x, g):
    xf = x.astype(F32)
    y = xf * lax.rsqrt(jnp.mean(xf * xf, axis=-1, keepdims=True) + EPS)
    return (y * g.astype(F32)).astype(x.dtype)


def modulate(h, shift, scale):
    return h * (1.0 + scale) + shift


def swiglu(h, w13, w2):
    g, u = jnp.split(h @ w13, 2, axis=-1)
    return (jax.nn.silu(g) * u) @ w2


def axial_rope_tables(n_tokens, dim):
    rows = n_tokens // GRID_W
    row = jnp.repeat(jnp.arange(rows), GRID_W).astype(F32)
    col = jnp.tile(jnp.arange(GRID_W), rows).astype(F32)
    quarter = dim // 4
    inv = ROPE_BASE ** (-jnp.arange(quarter, dtype=F32) / quarter)
    ang = jnp.concatenate([row[:, None] * inv, col[:, None] * inv], axis=-1)
    return jnp.cos(ang), jnp.sin(ang)


def apply_rope(x, cos, sin):
    x1, x2 = jnp.split(x, 2, axis=-1)
    c = cos[None, :, None, :]
    s = sin[None, :, None, :]
    return jnp.concatenate([x1 * c - x2 * s, x1 * s + x2 * c], axis=-1).astype(x.dtype)


def dwconv_centered(x, w, b):
    t = x.shape[1]
    left = CONV_W // 2
    xp = jnp.pad(x, ((0, 0), (left, CONV_W - 1 - left), (0, 0)))
    out = xp[:, 0:t] * w[0]
    for k in range(1, CONV_W):
        out = out + xp[:, k:k + t] * w[k]
    return out + b


def _lin_combine(e1, e2):
    a1, b1 = e1
    a2, b2 = e2
    return a2 * a1, a2 * b1 + b2


def _cplx_combine(e1, e2):
    a1r, a1i, b1r, b1i = e1
    a2r, a2i, b2r, b2i = e2
    return (a2r * a1r - a2i * a1i, a2r * a1i + a2i * a1r,
            a2r * b1r - a2i * b1i + b2r, a2r * b1i + a2i * b1r + b2i)


def linear_scan(a, b, h0, reverse):
    if h0 is not None:
        idx = -1 if reverse else 0
        b = b.at[:, idx].add(a[:, idx] * h0)
    _, h = lax.associative_scan(_lin_combine, (a, b), reverse=reverse, axis=1)
    return h


def _s5_direction(ul, uc, lam_re, lam_im, log_dt, b_re, b_im, c_re, c_im, reverse, need_ctx):
    lam_re = lam_re.astype(F32)
    lam_im = lam_im.astype(F32)
    dt = jnp.exp(log_dt.astype(F32))[:, None]
    mag = jnp.exp(lam_re * dt)
    ar = mag * jnp.cos(lam_im * dt)
    ai = mag * jnp.sin(lam_im * dt)
    den = lam_re * lam_re + lam_im * lam_im
    fr = ((ar - 1.0) * lam_re + ai * lam_im) / den
    fi = (ai * lam_re - (ar - 1.0) * lam_im) / den
    b_re = b_re.astype(F32)
    b_im = b_im.astype(F32)
    bbr = fr[..., None] * b_re - fi[..., None] * b_im
    bbi = fr[..., None] * b_im + fi[..., None] * b_re
    c_re = c_re.astype(F32)
    c_im = c_im.astype(F32)

    def scan(u, h0):
        t = u.shape[1]
        br = jnp.einsum('btgh,gph->btgp', u, bbr)
        bi = jnp.einsum('btgh,gph->btgp', u, bbi)
        a_r = jnp.broadcast_to(ar, (1, t) + ar.shape)
        a_i = jnp.broadcast_to(ai, (1, t) + ai.shape)
        if h0 is not None:
            idx = -1 if reverse else 0
            h0r, h0i = h0
            br = br.at[:, idx].add(ar * h0r - ai * h0i)
            bi = bi.at[:, idx].add(ar * h0i + ai * h0r)
        _, _, hr, hi = lax.associative_scan(_cplx_combine, (a_r, a_i, br, bi), reverse=reverse, axis=1)
        return hr, hi

    def readout(hr, hi):
        return jnp.einsum('btgp,ghp->btgh', hr, c_re) - jnp.einsum('btgp,ghp->btgh', hi, c_im)

    hcr, hci = scan(uc, None)
    end = 0 if reverse else -1
    hlr, hli = scan(ul, (hcr[:, end], hci[:, end]))
    y_ctx = readout(hcr, hci) if need_ctx else None
    return readout(hlr, hli), y_ctx


def s5_mixer(u_lat, u_ctx, lam_re, lam_im, log_dt, b_re, b_im, c_re, c_im, d_skip, glu_w, glu_b, need_ctx):
    bsz, t, w = u_lat.shape
    ul = u_lat.astype(F32).reshape(bsz, t, S5_GROUPS, S5_GROUP)
    uc = u_ctx.astype(F32).reshape(bsz, u_ctx.shape[1], S5_GROUPS, S5_GROUP)
    d = d_skip.astype(F32).reshape(S5_GROUPS, S5_GROUP)
    yl_f, yc_f = _s5_direction(ul, uc, lam_re[0], lam_im[0], log_dt[0], b_re[0], b_im[0], c_re[0], c_im[0], False, need_ctx)
    yl_b, yc_b = _s5_direction(ul, uc, lam_re[1], lam_im[1], log_dt[1], b_re[1], b_im[1], c_re[1], c_im[1], True, need_ctx)

    def glu(y):
        g = jax.nn.gelu(y.reshape(y.shape[0], y.shape[1], w))
        return g * jax.nn.sigmoid(g @ glu_w.astype(F32) + glu_b.astype(F32))

    y_lat = glu(yl_f + yl_b + d * ul).astype(u_lat.dtype)
    y_ctx = glu(yc_f + yc_b + d * uc).astype(u_ctx.dtype) if need_ctx else None
    return y_lat, y_ctx


def swa_attention(q, k, v, kc, vc, sink):
    bsz, s, h, dh = q.shape
    kv = k.shape[2]
    g = h // kv
    l = kc.shape[1]
    nb = s // BLOCK
    scale = dh ** -0.5
    qb = q.reshape(bsz, nb, BLOCK, kv, g, dh)

    def band(t):
        tp = jnp.pad(t, ((0, 0), (BLOCK, BLOCK), (0, 0), (0, 0))).reshape(bsz, nb + 2, BLOCK, kv, dh)
        return jnp.concatenate([tp[:, :-2], tp[:, 1:-1], tp[:, 2:]], axis=2)

    kb, vb = band(k), band(v)
    s_loc = jnp.einsum('bnqkgd,bnjkd->bnkgqj', qb, kb).astype(F32) * scale
    qpos = jnp.arange(BLOCK)[:, None] + BLOCK
    kpos = jnp.arange(3 * BLOCK)[None, :]
    kabs = jnp.arange(nb)[:, None, None] * BLOCK + kpos[None] - BLOCK
    valid = (jnp.abs(qpos - kpos) <= SWA_WINDOW)[None] & (kabs >= 0) & (kabs < s)
    s_loc = jnp.where(valid[None, :, None, None], s_loc, -jnp.inf)
    s_ctx = jnp.einsum('bnqkgd,bckd->bnkgqc', qb, kc).astype(F32) * scale
    s_sink = jnp.broadcast_to(sink.astype(F32).reshape(1, 1, kv, g, 1, 1), (bsz, nb, kv, g, BLOCK, 1))
    p = jax.nn.softmax(jnp.concatenate([s_loc, s_ctx, s_sink], axis=-1), axis=-1)
    p_loc = p[..., :3 * BLOCK].astype(v.dtype)
    p_ctx = p[..., 3 * BLOCK:3 * BLOCK + l].astype(v.dtype)
    o = jnp.einsum('bnkgqj,bnjkd->bnqkgd', p_loc, vb) + jnp.einsum('bnkgqc,bckd->bnqkgd', p_ctx, vc)
    return o.reshape(bsz, s, h * dh)


def ctx_sink_attention(qc, kc, vc, sink):
    bsz, l, h, dh = qc.shape
    kv = kc.shape[2]
    g = h // kv
    qg = qc.reshape(bsz, l, kv, g, dh)
    sc = jnp.einsum('bqkgd,bckd->bkgqc', qg, kc).astype(F32) * dh ** -0.5
    sk = jnp.broadcast_to(sink.astype(F32).reshape(1, kv, g, 1, 1), (bsz, kv, g, l, 1))
    p = jax.nn.softmax(jnp.concatenate([sc, sk], axis=-1), axis=-1)[..., :l]
    o = jnp.einsum('bkgqc,bckd->bqkgd', p.astype(vc.dtype), vc)
    return o.reshape(bsz, l, h * dh)


def even_mixer(h, hc, w_in, w_out, lam_re, lam_im, log_dt, b_re, b_im, c_re, c_im, d_skip, glu_w, glu_b,
               qk_g, sink, cos, sin, need_ctx):
    cuts = [S5_WIDTH, S5_WIDTH + SWA_HEADS * HEAD_DIM, S5_WIDTH + (SWA_HEADS + SWA_KV_HEADS) * HEAD_DIM]

    def split(z):
        bsz, t = z.shape[:2]
        u, q, k, v = jnp.split(z, cuts, axis=-1)
        q = rms_norm(q.reshape(bsz, t, SWA_HEADS, HEAD_DIM), qk_g[0])
        k = rms_norm(k.reshape(bsz, t, SWA_KV_HEADS, HEAD_DIM), qk_g[1])
        v = v.reshape(bsz, t, SWA_KV_HEADS, HEAD_DIM)
        return u, q, k, v

    u, q, k, v = split(h @ w_in)
    uc, qc, kc, vc = split(hc @ w_in)
    q = apply_rope(q, cos, sin)
    k = apply_rope(k, cos, sin)
    ya, ya_c = s5_mixer(u, uc, lam_re, lam_im, log_dt, b_re, b_im, c_re, c_im, d_skip, glu_w, glu_b, need_ctx)
    yb = swa_attention(q, k, v, kc, vc, sink)
    out = jnp.concatenate([ya, yb], axis=-1) @ w_out
    if need_ctx:
        yb_c = ctx_sink_attention(qc, kc, vc, sink)
        out_c = jnp.concatenate([ya_c, yb_c], axis=-1) @ w_out
    else:
        out_c = None
    return out, out_c


def rglru_coeffs(xc, wa, ba, wx, bx, lam):
    bsz, t, w = xc.shape
    xb = xc.reshape(bsz, t, LRU_BLOCKS, LRU_BLOCK_DIM)
    r = jax.nn.sigmoid(jnp.einsum('btnd,nde->btne', xb, wa.astype(F32)).reshape(bsz, t, w) + ba.astype(F32))
    gi = jax.nn.sigmoid(jnp.einsum('btnd,nde->btne', xb, wx.astype(F32)).reshape(bsz, t, w) + bx.astype(F32))
    log_a = -LRU_C * r * jax.nn.softplus(-lam.astype(F32))
    a = jnp.exp(log_a)
    b = jnp.sqrt(-jnp.expm1(2.0 * log_a)) * (gi * xc)
    return a, b


def _diff_block(qblk, k, v, lam):
    s = jnp.einsum('bqhmd,bkhmd->bhmqk', qblk, k).astype(F32) * DIFF_HALF ** -0.5
    p = jax.nn.softmax(s, axis=-1)
    wgt = p[:, :, 0] - lam * p[:, :, 1]
    return jnp.einsum('bhqk,bkhe->bqhe', wgt.astype(v.dtype), v)


def diff_attention_latent(q, kall, vall, lam):
    bsz, s = q.shape[:2]
    nb = s // BLOCK
    qb = q.reshape(bsz, nb, BLOCK, DIFF_HEADS, 2, DIFF_HALF).transpose(1, 0, 2, 3, 4, 5)
    o = lax.map(lambda qblk: _diff_block(qblk, kall, vall, lam), qb)
    return o.transpose(1, 0, 2, 3, 4).reshape(bsz, s, DIFF_HEADS, DIFF_V)


def odd_mixer(h, hc, w_in, w_out, conv_w, conv_b, wa, ba, wx, bx, lam_lru, qk_g, dlam, sub_g,
              lam_init, cos, sin, need_ctx):
    cuts = [LRU_WIDTH, 2 * LRU_WIDTH, 2 * LRU_WIDTH + DIFF_HEADS * DIFF_V, 2 * LRU_WIDTH + 2 * DIFF_HEADS * DIFF_V]

    def split(z):
        bsz, t = z.shape[:2]
        g, r, q, k, v = jnp.split(z, cuts, axis=-1)
        q = rms_norm(q.reshape(bsz, t, DIFF_HEADS, 2, DIFF_HALF), qk_g[0])
        k = rms_norm(k.reshape(bsz, t, DIFF_HEADS, 2, DIFF_HALF), qk_g[1])
        v = v.reshape(bsz, t, DIFF_HEADS, DIFF_V)
        return g, r, q, k, v

    g, r, q, k, v = split(h @ w_in)
    gc, rc, qc, kc, vc = split(hc @ w_in)
    bsz, t = h.shape[:2]

    xr = dwconv_centered(r, conv_w, conv_b).astype(F32)
    xrc = dwconv_centered(rc, conv_w, conv_b).astype(F32)
    y_rec = jnp.zeros_like(xr)
    y_rec_c = jnp.zeros_like(xrc)
    for dirn, reverse in ((0, False), (1, True)):
        ac, bc = rglru_coeffs(xrc, wa[dirn], ba[dirn], wx[dirn], bx[dirn], lam_lru[dirn])
        hcs = linear_scan(ac, bc, None, reverse)
        al, bl = rglru_coeffs(xr, wa[dirn], ba[dirn], wx[dirn], bx[dirn], lam_lru[dirn])
        y_rec = y_rec + linear_scan(al, bl, hcs[:, 0 if reverse else -1], reverse)
        y_rec_c = y_rec_c + hcs
    yc_lat = (y_rec * jax.nn.gelu(g.astype(F32))).astype(h.dtype)

    q = apply_rope(q.reshape(bsz, t, DIFF_HEADS * 2, DIFF_HALF), cos, sin).reshape(q.shape)
    k = apply_rope(k.reshape(bsz, t, DIFF_HEADS * 2, DIFF_HALF), cos, sin).reshape(k.shape)
    dl = dlam.astype(F32)
    lam = jnp.exp(jnp.sum(dl[0] * dl[1])) - jnp.exp(jnp.sum(dl[2] * dl[3])) + lam_init
    kall = jnp.concatenate([k, kc], axis=1)
    vall = jnp.concatenate([v, vc], axis=1)
    o = rms_norm(diff_attention_latent(q, kall, vall, lam), sub_g) * (1.0 - lam_init)
    out = jnp.concatenate([yc_lat, o.reshape(bsz, t, DIFF_HEADS * DIFF_V)], axis=-1) @ w_out
    if need_ctx:
        yc_ctx = (y_rec_c * jax.nn.gelu(gc.astype(F32))).astype(hc.dtype)
        oc = rms_norm(_diff_block(qc, kc, vc, lam), sub_g) * (1.0 - lam_init)
        out_c = jnp.concatenate([yc_ctx, oc.reshape(bsz, hc.shape[1], DIFF_HEADS * DIFF_V)], axis=-1) @ w_out
    else:
        out_c = None
    return out, out_c


def setup_inputs(seed: int = 0) -> dict:
    key = jax.random.key(seed)
    keys = iter(jax.random.split(key, 48))
    D = D_MODEL

    def nrm(shape, scale):
        return jax.random.normal(next(keys), shape, F32) * scale

    def gain(shape):
        return 1.0 + nrm(shape, 0.05)

    x = nrm((BATCH, SEQ, D), 1.0)
    c = nrm((BATCH, D), 1.0)
    ctx = nrm((BATCH, CTX_LEN, D), 1.0)
    c_ctx = nrm((D,), 1.0)
    mod_w = nrm((DEPTH, D, N_MOD * D), 0.5 * D ** -0.5)
    mod_b = nrm((DEPTH, N_MOD * D), 0.01)
    norm_g = gain((DEPTH, 3, D))
    ffn1_w13 = nrm((DEPTH, D, 2 * D_FF), D ** -0.5)
    ffn1_w2 = nrm((DEPTH, D_FF, D), D_FF ** -0.5)
    ffn2_w13 = nrm((DEPTH, D, 2 * D_FF), D ** -0.5)
    ffn2_w2 = nrm((DEPTH, D_FF, D), D_FF ** -0.5)
    ev_w_in = nrm((N_EVEN, D, EVEN_IN), D ** -0.5)
    ev_w_out = nrm((N_EVEN, EVEN_MIX, D), EVEN_MIX ** -0.5)
    s5_lam_re = -0.5 + nrm((N_EVEN, 2, S5_GROUPS, S5_STATE), 0.01)
    s5_lam_im = math.pi * jnp.arange(S5_STATE, dtype=F32) + nrm((N_EVEN, 2, S5_GROUPS, S5_STATE), 0.01)
    s5_log_dt = jax.random.uniform(next(keys), (N_EVEN, 2, S5_GROUPS), F32, math.log(0.001), math.log(0.1))
    s5_b_re = nrm((N_EVEN, 2, S5_GROUPS, S5_STATE, S5_GROUP), (2 * S5_GROUP) ** -0.5)
    s5_b_im = nrm((N_EVEN, 2, S5_GROUPS, S5_STATE, S5_GROUP), (2 * S5_GROUP) ** -0.5)
    s5_c_re = nrm((N_EVEN, 2, S5_GROUPS, S5_GROUP, S5_STATE), 0.25)
    s5_c_im = nrm((N_EVEN, 2, S5_GROUPS, S5_GROUP, S5_STATE), 0.25)
    s5_d = nrm((N_EVEN, S5_WIDTH), 1.0)
    s5_glu_w = nrm((N_EVEN, S5_WIDTH, S5_WIDTH), S5_WIDTH ** -0.5)
    s5_glu_b = nrm((N_EVEN, S5_WIDTH), 0.01)
    swa_qk_g = gain((N_EVEN, 2, HEAD_DIM))
    swa_sink = nrm((N_EVEN, SWA_HEADS), 0.5)
    od_w_in = nrm((N_ODD, D, ODD_IN), D ** -0.5)
    od_w_out = nrm((N_ODD, ODD_MIX, D), ODD_MIX ** -0.5)
    lru_conv_w = nrm((N_ODD, CONV_W, LRU_WIDTH), CONV_W ** -0.5)
    lru_conv_b = nrm((N_ODD, LRU_WIDTH), 0.01)
    lru_wa = nrm((N_ODD, 2, LRU_BLOCKS, LRU_BLOCK_DIM, LRU_BLOCK_DIM), LRU_BLOCK_DIM ** -0.5)
    lru_ba = nrm((N_ODD, 2, LRU_WIDTH), 0.01)
    lru_wx = nrm((N_ODD, 2, LRU_BLOCKS, LRU_BLOCK_DIM, LRU_BLOCK_DIM), LRU_BLOCK_DIM ** -0.5)
    lru_bx = nrm((N_ODD, 2, LRU_WIDTH), 0.01)
    a0 = jax.random.uniform(next(keys), (N_ODD, 2, LRU_WIDTH), F32, 0.9, 0.999)
    s0 = a0 ** (1.0 / LRU_C)
    lru_lam = jnp.log(s0) - jnp.log1p(-s0)
    diff_qk_g = gain((N_ODD, 2, DIFF_HALF))
    diff_lam = nrm((N_ODD, 4, DIFF_HALF), 0.1)
    diff_sub_g = gain((N_ODD, DIFF_V))
    return {'x': x, 'c': c, 'ctx': ctx, 'c_ctx': c_ctx, 'mod_w': mod_w, 'mod_b': mod_b, 'norm_g': norm_g,
            'ffn1_w13': ffn1_w13, 'ffn1_w2': ffn1_w2, 'ffn2_w13': ffn2_w13, 'ffn2_w2': ffn2_w2,
            'ev_w_in': ev_w_in, 'ev_w_out': ev_w_out, 's5_lam_re': s5_lam_re, 's5_lam_im': s5_lam_im,
            's5_log_dt': s5_log_dt, 's5_b_re': s5_b_re, 's5_b_im': s5_b_im, 's5_c_re': s5_c_re,
            's5_c_im': s5_c_im, 's5_d': s5_d, 's5_glu_w': s5_glu_w, 's5_glu_b': s5_glu_b,
            'swa_qk_g': swa_qk_g, 'swa_sink': swa_sink, 'od_w_in': od_w_in, 'od_w_out': od_w_out,
            'lru_conv_w': lru_conv_w, 'lru_conv_b': lru_conv_b, 'lru_wa': lru_wa, 'lru_ba': lru_ba,
            'lru_wx': lru_wx, 'lru_bx': lru_bx, 'lru_lam': lru_lam, 'diff_qk_g': diff_qk_g,
            'diff_lam': diff_lam, 'diff_sub_g': diff_sub_g}


def reference(x, c, ctx, c_ctx, mod_w, mod_b, norm_g, ffn1_w13, ffn1_w2, ffn2_w13, ffn2_w2,
              ev_w_in, ev_w_out, s5_lam_re, s5_lam_im, s5_log_dt, s5_b_re, s5_b_im, s5_c_re, s5_c_im,
              s5_d, s5_glu_w, s5_glu_b, swa_qk_g, swa_sink, od_w_in, od_w_out, lru_conv_w, lru_conv_b,
              lru_wa, lru_ba, lru_wx, lru_bx, lru_lam, diff_qk_g, diff_lam, diff_sub_g):
    cos, sin = axial_rope_tables(x.shape[1], HEAD_DIM)
    for i in range(DEPTH):
        last = i == DEPTH - 1
        j = i // 2
        m = (jax.nn.silu(c) @ mod_w[i] + mod_b[i]).reshape(x.shape[0], N_MOD, 1, D_MODEL)
        mc = (jax.nn.silu(c_ctx) @ mod_w[i] + mod_b[i]).reshape(N_MOD, D_MODEL)
        x = x + 0.5 * m[:, 2] * swiglu(modulate(rms_norm(x, norm_g[i, 0]), m[:, 0], m[:, 1]), ffn1_w13[i], ffn1_w2[i])
        ctx = ctx + 0.5 * mc[2] * swiglu(modulate(rms_norm(ctx, norm_g[i, 0]), mc[0], mc[1]), ffn1_w13[i], ffn1_w2[i])
        hx = modulate(rms_norm(x, norm_g[i, 1]), m[:, 3], m[:, 4])
        hc = modulate(rms_norm(ctx, norm_g[i, 1]), mc[3], mc[4])
        if i % 2 == 0:
            y, yc = even_mixer(hx, hc, ev_w_in[j], ev_w_out[j], s5_lam_re[j], s5_lam_im[j], s5_log_dt[j],
                               s5_b_re[j], s5_b_im[j], s5_c_re[j], s5_c_im[j], s5_d[j], s5_glu_w[j], s5_glu_b[j],
                               swa_qk_g[j], swa_sink[j], cos, sin, not last)
        else:
            lam_init = 0.8 - 0.6 * math.exp(-0.3 * i)
            y, yc = odd_mixer(hx, hc, od_w_in[j], od_w_out[j], lru_conv_w[j], lru_conv_b[j], lru_wa[j], lru_ba[j],
                              lru_wx[j], lru_bx[j], lru_lam[j], diff_qk_g[j], diff_lam[j], diff_sub_g[j],
                              lam_init, cos, sin, not last)
        x = x + m[:, 5] * y
        x = x + 0.5 * m[:, 8] * swiglu(modulate(rms_norm(x, norm_g[i, 2]), m[:, 6], m[:, 7]), ffn2_w13[i], ffn2_w2[i])
        if not last:
            ctx = ctx + mc[5] * yc
            ctx = ctx + 0.5 * mc[8] * swiglu(modulate(rms_norm(ctx, norm_g[i, 2]), mc[6], mc[7]), ffn2_w13[i], ffn2_w2[i])
    return x
```

```cpp
#include <hip/hip_runtime.h>
#include <hip/hip_cooperative_groups.h>
#include <cstdio>
#include <cstdint>
namespace cg = cooperative_groups;

#define DI __device__ __forceinline__
typedef unsigned short bf16_t;
typedef short bf16x8 __attribute__((ext_vector_type(8)));
typedef short s16x4 __attribute__((ext_vector_type(4)));
typedef float f32x2 __attribute__((ext_vector_type(2)));
typedef float f32x4 __attribute__((ext_vector_type(4)));
typedef float f32x16 __attribute__((ext_vector_type(16)));
typedef unsigned u32x2 __attribute__((ext_vector_type(2)));
typedef unsigned u32x4 __attribute__((ext_vector_type(4)));
typedef __bf16 bf16x2_t __attribute__((ext_vector_type(2)));

constexpr int DM = 1024, NB = 4, SEQ = 8192, CTXL = 256, TL = NB * SEQ, TC = NB * CTXL, TT = TL + TC, DFF = 2816, KEYS = SEQ + CTXL;
constexpr int NMOD = 9, MODW = NMOD * DM;
constexpr int EVEN_IN = 1280, ODD_IN = 2560;
constexpr float EPSN = 1e-6f;
constexpr float LOG2E = 1.4426950408889634f;

constexpr size_t SZ_W13 = (size_t)2 * DFF * DM * 2, SZ_W2 = (size_t)DM * DFF * 2, SZ_FFN = SZ_W13 + SZ_W2;
constexpr size_t OFF_W = 0;
constexpr size_t OFF_EVIN = OFF_W + 4 * SZ_FFN;
constexpr size_t OFF_EVOUT = OFF_EVIN + (size_t)EVEN_IN * DM * 2;
constexpr size_t OFF_GLUW = OFF_EVOUT + (size_t)DM * DM * 2;
constexpr size_t OFF_ODIN = OFF_GLUW + (size_t)512 * 512 * 2;
constexpr size_t OFF_ODOUT = OFF_ODIN + (size_t)ODD_IN * DM * 2;
constexpr size_t OFF_XN = OFF_ODOUT + (size_t)DM * DM * 2;
constexpr size_t OFF_H = OFF_XN + (size_t)TT * DM * 2;
constexpr size_t OFF_CTXX = OFF_H + (size_t)TT * DFF * 2;
constexpr size_t OFF_MOD = OFF_CTXX + (size_t)TC * DM * 4;
constexpr size_t OFF_ROPE = OFF_MOD + (size_t)2 * 5 * MODW * 4;
constexpr size_t OFF_S5A = OFF_ROPE + (size_t)SEQ * 32 * 8;
constexpr size_t OFF_S5B = OFF_S5A + (size_t)2 * 32 * 64 * 8;
constexpr size_t OFF_Q = OFF_S5B + (size_t)2 * 32 * 64 * 16 * 8;
constexpr size_t SZ_QKV = (size_t)NB * 8 * KEYS * 64 * 2;
constexpr size_t OFF_K = OFF_Q + SZ_QKV;
constexpr size_t OFF_V = OFF_K + SZ_QKV;
constexpr size_t OFF_G = OFF_V + SZ_QKV;
constexpr size_t OFF_ST = OFF_G + (size_t)TT * 512 * 2;
constexpr size_t SZ_ST = (size_t)NB * 2 * 32 * 264 * 64 * 8;
constexpr size_t OFF_LCIN = OFF_ST + (size_t)NB * 2 * 264 * 512 * 8;
constexpr size_t OFF_BAR = OFF_ST + SZ_ST;
constexpr size_t OFF_S5C = OFF_BAR + 16384;
constexpr size_t WS_END = OFF_S5C + (size_t)2 * 32 * 2 * 16 * 128 * 2;
static_assert(OFF_LCIN + (size_t)NB * 2 * 264 * 512 * 4 <= OFF_BAR, "lru regions");
static_assert(SZ_QKV / 4 + (size_t)NB * 32 * 264 * 64 * 8 <= SZ_QKV, "s5 carry-in regions");
constexpr int LDS_BYTES = 131072 + 16;

struct Params {
    const float *x, *c, *ctx, *c_ctx, *mod_w, *mod_b, *norm_g, *ffn1_w13, *ffn1_w2, *ffn2_w13, *ffn2_w2, *ev_w_in, *ev_w_out;
    const float *s5_lam_re, *s5_lam_im, *s5_log_dt, *s5_b_re, *s5_b_im, *s5_c_re, *s5_c_im, *s5_d, *s5_glu_w, *s5_glu_b, *swa_qk_g, *swa_sink;
    const float *od_w_in, *od_w_out, *lru_conv_w, *lru_conv_b, *lru_wa, *lru_ba, *lru_wx, *lru_bx, *lru_lam, *diff_qk_g, *diff_lam, *diff_sub_g;
    float* out;
    unsigned char* ws;
};

DI unsigned pk2(float lo, float hi) { f32x2 v = {lo, hi}; bf16x2_t r = __builtin_convertvector(v, bf16x2_t); return __builtin_bit_cast(unsigned, r); }
DI bf16_t f2bf(float x) { return (bf16_t)(pk2(x, 0.f) & 0xffffu); }
DI float bf2f(bf16_t v) { return __uint_as_float((unsigned)v << 16); }
DI float bflo(unsigned w) { return __uint_as_float(w << 16); }
DI float bfhi(unsigned w) { return __uint_as_float(w & 0xffff0000u); }
DI float wave_sum(float v) {
#pragma unroll
    for (int o = 32; o; o >>= 1) v += __shfl_xor(v, o);
    return v;
}
DI float wave_max(float v) {
#pragma unroll
    for (int o = 32; o; o >>= 1) v = fmaxf(v, __shfl_xor(v, o));
    return v;
}
DI float sigmoid_f(float x) { return __builtin_amdgcn_rcpf(1.f + __builtin_amdgcn_exp2f(-LOG2E * x)); }
DI float silu_f(float x) { return x * sigmoid_f(x); }
DI float gelu_tanh(float x) { const float u = 0.7978845608028654f * (x + 0.044715f * x * x * x); return x * sigmoid_f(2.f * u); }
#define LDS_FENCE() asm volatile("s_waitcnt lgkmcnt(0)" ::: "memory")
template <int V> struct IC { static constexpr int value = V; };
template <int I, int N, class F> DI void static_for(F&& f) { if constexpr (I < N) { f(IC<I>{}); static_for<I + 1, N>(f); } }

constexpr int BM = 256, BK = 64, HALF = 128, HT = HALF * BK, NXCD = 8, WGM = 8;
DI int lds_byte(int r, int c) { int st = (r >> 4) * 2 + (c >> 5), rr = r & 15, cc = c & 31, ob = rr * 64 + cc * 2; return st * 1024 + (ob ^ (((ob >> 9) & 1) << 5)); }
DI void stage_rc(int b, int& R, int& C) { int st = b / 1024, sb = b % 1024, swz = sb ^ (((sb >> 9) & 1) << 5); R = (st >> 1) * 16 + swz / 64; C = (st & 1) * 32 + (swz % 64) / 2; }

template <class Epi>
DI void gemm_phase(const int TID, const bf16_t* __restrict__ A, const bf16_t* __restrict__ Bt, int M, int N, int K, const Epi& epi, const int S = 1) {
    extern __shared__ __attribute__((aligned(16))) bf16_t shm[];
    int tidx = TID; asm volatile("" : "+v"(tidx));
#define SA(b, h) (shm + ((b) * 2 + (h)) * HT)
#define SB(b, h) (shm + (4 + (b) * 2 + (h)) * HT)
#define STAGE(P, BASE, br, kt) do { const char* _ub = (const char*)(BASE) + ((long)(br) * K + (long)((kt) + kbase) * BK) * 2; \
      __builtin_amdgcn_global_load_lds((const unsigned*)(_ub + voff0), (unsigned*)((char*)(P) + wv_s * 1024), 16, 0, 0); \
      __builtin_amdgcn_global_load_lds((const unsigned*)(_ub + voff1), (unsigned*)((char*)(P) + wv_s * 1024 + 8192), 16, 0, 0); } while (0)
#define LDA(dst, b, h) for (int m = 0; m < 4; ++m) for (int k = 0; k < 2; ++k) \
    dst[m][k] = *reinterpret_cast<const bf16x8*>((char*)SA(b, h) + lds_byte(wr * 64 + m * 16 + fr, k * 32 + fq * 8))
#define LDB(dst, b, h) for (int n = 0; n < 2; ++n) for (int k = 0; k < 2; ++k) \
    dst[n][k] = *reinterpret_cast<const bf16x8*>((char*)SB(b, h) + lds_byte(wc * 32 + n * 16 + fr, k * 32 + fq * 8))
#define MMA(ai, bj, At_, Bt_) do { __builtin_amdgcn_s_setprio(1); \
    for (int m = 0; m < 4; ++m) for (int n = 0; n < 2; ++n) for (int k = 0; k < 2; ++k) \
      acc[ai][bj][m][n] = __builtin_amdgcn_mfma_f32_16x16x32_bf16(Bt_[n][k], At_[m][k], acc[ai][bj][m][n], 0, 0, 0); \
    __builtin_amdgcn_s_setprio(0); } while (0)
#define WAIT_V(n) asm volatile("s_waitcnt vmcnt(" #n ")" ::: "memory")
#define WAIT_L(n) asm volatile("s_waitcnt lgkmcnt(" #n ")" ::: "memory")
#define BAR __builtin_amdgcn_s_barrier()
#define SCHED __builtin_amdgcn_sched_barrier(0)
    const int nM = M / BM, nN = N / BM, ntile = nM * nN, nwg = ntile * S;
    const int wid = tidx >> 6, lane = tidx & 63, wr = wid >> 2, wc = wid & 3, fr = lane & 15, fq = lane >> 4;
    const int nt = K / BK / S;
    const int wv_s = __builtin_amdgcn_readfirstlane(tidx >> 6);
    unsigned voff0, voff1;
    { int r_, c_; stage_rc(tidx * 16, r_, c_); voff0 = (unsigned)(r_ * K + c_) * 2u; stage_rc(tidx * 16 + 8192, r_, c_); voff1 = (unsigned)(r_ * K + c_) * 2u; }
#define TILE_COORDS(L_, pm_, pn_, kb_) do { int wgid = (int)(L_); \
        if (S == 1) { const int q = nwg / NXCD, r = nwg % NXCD, xcd = wgid % NXCD, off = wgid / NXCD; wgid = (xcd < r ? xcd * (q + 1) : r * (q + 1) + (xcd - r) * q) + off; kb_ = 0; } \
        else { kb_ = (wgid % S) * nt; wgid /= S; } \
        const int nig = WGM * nN, gid = wgid / nig, fm = gid * WGM, gsz = min(nM - fm, WGM); \
        pm_ = fm + ((wgid % nig) % gsz); pn_ = (wgid % nig) / gsz; } while (0)
#define STAGE_P1(brow_, bcol_) do { STAGE(SB(0, 0), Bt, bcol_, 0); STAGE(SA(0, 0), A, brow_, 0); STAGE(SB(0, 1), Bt, (bcol_) + HALF, 0); STAGE(SA(0, 1), A, (brow_) + HALF, 0); } while (0)
    long L = blockIdx.x;
    if (L >= nwg) return;
    int pm, pn, kbase;
    TILE_COORDS(L, pm, pn, kbase);
    STAGE_P1(pm * BM, pn * BM);
    for (;;) {
        const int brow = pm * BM, bcol = pn * BM;
        f32x4 acc[2][2][4][2] = {};
        bf16x8 At[4][2], B0[2][2], B1[2][2];
        if (wr == 1) BAR;
        WAIT_V(0); BAR;
        STAGE(SB(1, 0), Bt, bcol, 1); STAGE(SA(1, 0), A, brow, 1); STAGE(SB(1, 1), Bt, bcol + HALF, 1);
        WAIT_V(6); BAR;
        for (int t = 0; t < nt - 2; t += 2) {
            LDB(B0, 0, 0); SCHED; LDA(At, 0, 0); STAGE(SA(1, 1), A, brow + HALF, t + 1);
            WAIT_L(8); BAR; WAIT_L(0); MMA(0, 0, At, B0); BAR; SCHED;
            LDB(B1, 0, 1); STAGE(SB(0, 0), Bt, bcol, t + 2);
            BAR; WAIT_L(0); MMA(0, 1, At, B1); BAR;
            LDA(At, 0, 1); STAGE(SA(0, 0), A, brow, t + 2);
            BAR; WAIT_L(0); MMA(1, 0, At, B0); BAR; SCHED;
            STAGE(SB(0, 1), Bt, bcol + HALF, t + 2);
            WAIT_V(6); BAR; MMA(1, 1, At, B1); BAR;
            LDB(B0, 1, 0); SCHED; LDA(At, 1, 0); STAGE(SA(0, 1), A, brow + HALF, t + 2);
            WAIT_L(8); BAR; WAIT_L(0); MMA(0, 0, At, B0); BAR; SCHED;
            LDB(B1, 1, 1); STAGE(SB(1, 0), Bt, bcol, t + 3);
            BAR; WAIT_L(0); MMA(0, 1, At, B1); BAR;
            LDA(At, 1, 1); STAGE(SA(1, 0), A, brow, t + 3);
            BAR; WAIT_L(0); MMA(1, 0, At, B0); BAR; SCHED;
            STAGE(SB(1, 1), Bt, bcol + HALF, t + 3);
            WAIT_V(6); BAR; MMA(1, 1, At, B1); BAR;
        }
        { LDB(B0, 0, 0); LDA(At, 0, 0); STAGE(SA(1, 1), A, brow + HALF, nt - 1);
          BAR; WAIT_L(0); MMA(0, 0, At, B0); BAR;
          LDB(B1, 0, 1); BAR; WAIT_L(0); MMA(0, 1, At, B1); BAR;
          LDA(At, 0, 1); WAIT_V(4); BAR; WAIT_L(0); MMA(1, 0, At, B0); MMA(1, 1, At, B1); BAR; }
        { LDB(B0, 1, 0); LDA(At, 1, 0); WAIT_V(2); BAR; WAIT_L(0); MMA(0, 0, At, B0); BAR;
          LDB(B1, 1, 1); WAIT_V(0); BAR; WAIT_L(0); MMA(0, 1, At, B1); BAR;
          LDA(At, 1, 1); BAR; WAIT_L(0); MMA(1, 0, At, B0); MMA(1, 1, At, B1); BAR; }
        if (wr == 0) BAR;
        const int kbase_cur = kbase;
        L += gridDim.x;
        const bool has_next = L < nwg;
        int pm_n = 0, pn_n = 0, kb_n = 0;
        if (has_next) { TILE_COORDS(L, pm_n, pn_n, kb_n); kbase = kb_n; STAGE_P1(pm_n * BM, pn_n * BM); }
        asm volatile("" ::: "memory"); SCHED;
        { int t2 = TID; asm volatile("" : "+v"(t2));
          int pm2 = S == 1 ? pm : pm + (kbase_cur / nt) * nM, pn2 = pn; asm volatile("" : "+s"(pm2), "+s"(pn2));
          epi(acc, pm2, pn2, t2 >> 8, (t2 >> 6) & 3, t2 & 15, (t2 & 63) >> 4); }
        asm volatile("" ::: "memory"); SCHED;
        if (!has_next) break;
        pm = pm_n; pn = pn_n;
    }
#undef TILE_COORDS
#undef STAGE_P1
#undef SA
#undef SB
#undef STAGE
#undef LDA
#undef LDB
#undef MMA
}

struct EpiSwiglu {
    bf16_t* H;
    DI void operator()(const f32x4 (&acc)[2][2][4][2], int pm, int pn, int wr, int wc, int fr, int fq) const {
#pragma unroll
        for (int ai = 0; ai < 2; ++ai)
#pragma unroll
            for (int m = 0; m < 4; ++m) {
                const size_t row = (size_t)pm * BM + ai * HALF + wr * 64 + m * 16 + fr;
#pragma unroll
                for (int bj = 0; bj < 2; ++bj) {
                    const int hc = (pn * BM + bj * HALF + wc * 32) / 2 + 4 * fq;
                    const f32x4 g = acc[ai][bj][m][0], u = acc[ai][bj][m][1];
                    u32x2 w; w.x = pk2(silu_f(g[0]) * u[0], silu_f(g[1]) * u[1]); w.y = pk2(silu_f(g[2]) * u[2], silu_f(g[3]) * u[3]);
                    *(u32x2*)(H + row * DFF + hc) = w;
                }
            }
    }
};
struct EpiResid {
    const float *srcL, *srcC; float *dstL, *dstC; const float* gate  ; float coef;
    DI void operator()(const f32x4 (&acc)[2][2][4][2], int pm, int pn, int wr, int wc, int fr, int fq) const {
        const int row0 = pm * BM;
        const bool lat = row0 < TL;
        const float* src = lat ? srcL : srcC - (size_t)TL * DM;
        float* dst = lat ? dstL : dstC - (size_t)TL * DM;
        const int v = lat ? row0 / SEQ : 4;
        const int col0 = pn * BM + wc * 32 + 4 * fq;
        const float* gv = gate + (size_t)v * MODW + col0;
        f32x4 gt[2][2];
#pragma unroll
        for (int bj = 0; bj < 2; ++bj)
#pragma unroll
            for (int n = 0; n < 2; ++n) gt[bj][n] = *(const f32x4*)(gv + bj * HALF + n * 16) * coef;
#pragma unroll
        for (int ai = 0; ai < 2; ++ai)
#pragma unroll
            for (int m = 0; m < 4; ++m) {
                const size_t off = (size_t)(row0 + ai * HALF + wr * 64 + m * 16 + fr) * DM + col0;
                const float* sp = src + off; float* dp = dst + off;
                f32x4 s[2][2];
#pragma unroll
                for (int bj = 0; bj < 2; ++bj)
#pragma unroll
                    for (int n = 0; n < 2; ++n) s[bj][n] = *(const f32x4*)(sp + bj * HALF + n * 16);
#pragma unroll
                for (int bj = 0; bj < 2; ++bj)
#pragma unroll
                    for (int n = 0; n < 2; ++n) *(f32x4*)(dp + bj * HALF + n * 16) = s[bj][n] + gt[bj][n] * acc[ai][bj][m][n];
                asm volatile("" ::: "memory");
            }
    }
};
struct EpiPartial {
    float* part; const float* gate; float coef;
    DI void operator()(const f32x4 (&acc)[2][2][4][2], int pm, int pn, int wr, int wc, int fr, int fq) const {
        const int col0 = pn * BM + wc * 32 + 4 * fq;
        f32x4 gt[2][2];
#pragma unroll
        for (int bj = 0; bj < 2; ++bj)
#pragma unroll
            for (int n = 0; n < 2; ++n) gt[bj][n] = *(const f32x4*)(gate + col0 + bj * HALF + n * 16) * coef;
#pragma unroll
        for (int ai = 0; ai < 2; ++ai)
#pragma unroll
            for (int m = 0; m < 4; ++m) {
                float* dp = part + (size_t)(pm * BM + ai * HALF + wr * 64 + m * 16 + fr) * DM + col0;
#pragma unroll
                for (int bj = 0; bj < 2; ++bj)
#pragma unroll
                    for (int n = 0; n < 2; ++n) *(f32x4*)(dp + bj * HALF + n * 16) = gt[bj][n] * acc[ai][bj][m][n];
                asm volatile("" ::: "memory");
            }
    }
};
struct EpiStoreBf16 {
    bf16_t* Z; int ldz;
    DI void operator()(const f32x4 (&acc)[2][2][4][2], int pm, int pn, int wr, int wc, int fr, int fq) const {
#pragma unroll
        for (int ai = 0; ai < 2; ++ai)
#pragma unroll
            for (int m = 0; m < 4; ++m) {
                const size_t row = (size_t)pm * BM + ai * HALF + wr * 64 + m * 16 + fr;
#pragma unroll
                for (int bj = 0; bj < 2; ++bj)
#pragma unroll
                    for (int n = 0; n < 2; ++n) {
                        const int col = pn * BM + bj * HALF + wc * 32 + n * 16 + 4 * fq;
                        const f32x4 a = acc[ai][bj][m][n];
                        u32x2 w; w.x = pk2(a[0], a[1]); w.y = pk2(a[2], a[3]);
                        *(u32x2*)(Z + row * ldz + col) = w;
                    }
            }
    }
};
struct EpiGlu {
    const bf16_t* G; const float* bias; bf16_t* MIX;
    DI void operator()(const f32x4 (&acc)[2][2][4][2], int pm, int pn, int wr, int wc, int fr, int fq) const {
        const int col0 = pn * BM + wc * 32 + 4 * fq;
        f32x4 bv[2][2];
#pragma unroll
        for (int bj = 0; bj < 2; ++bj)
#pragma unroll
            for (int n = 0; n < 2; ++n) bv[bj][n] = *(const f32x4*)(bias + col0 + bj * HALF + n * 16);
#pragma unroll
        for (int ai = 0; ai < 2; ++ai)
#pragma unroll
            for (int m = 0; m < 4; ++m) {
                const size_t row = (size_t)pm * BM + ai * HALF + wr * 64 + m * 16 + fr;
                const bf16_t* gp = G + row * 512 + col0; bf16_t* mp = MIX + row * DM + col0;
#pragma unroll
                for (int bj = 0; bj < 2; ++bj)
#pragma unroll
                    for (int n = 0; n < 2; ++n) {
                        const u32x2 gw = *(const u32x2*)(gp + bj * HALF + n * 16);
                        const f32x4 a = acc[ai][bj][m][n] + bv[bj][n];
                        u32x2 w; w.x = pk2(bflo(gw.x) * sigmoid_f(a[0]), bfhi(gw.x) * sigmoid_f(a[1])); w.y = pk2(bflo(gw.y) * sigmoid_f(a[2]), bfhi(gw.y) * sigmoid_f(a[3]));
                        *(u32x2*)(mp + bj * HALF + n * 16) = w;
                    }
                asm volatile("" ::: "memory");
            }
    }
};

DI void transpose_item(const float* __restrict__ W, int K, int N, bf16_t* __restrict__ WT, int mode, float* scr, int item, int lane) {
    const int nblk = N / 32, kb = item / nblk, nb = item % nblk, k0 = 64 * kb, n0 = 32 * nb;
#pragma unroll 8
    for (int i = 0; i < 32; ++i) { const int kk = 2 * i + (lane >> 5); scr[kk * 33 + (lane & 31)] = W[(size_t)(k0 + kk) * N + n0 + (lane & 31)]; }
    LDS_FENCE();
    const int c = lane & 7;
#pragma unroll
    for (int j = 0; j < 4; ++j) {
        const int n = (lane >> 3) + 8 * j; const float* s = scr + (8 * c) * 33 + n;
        u32x4 o; o.x = pk2(s[0 * 33], s[1 * 33]); o.y = pk2(s[2 * 33], s[3 * 33]); o.z = pk2(s[4 * 33], s[5 * 33]); o.w = pk2(s[6 * 33], s[7 * 33]);
        const int nn = n0 + n;
        int row = nn;
        if (mode == 1) { const int jj = nn < DFF ? nn : nn - DFF; row = (jj >> 4) * 32 + (jj & 15) + (nn < DFF ? 0 : 16); }
        *(u32x4*)(WT + (size_t)row * K + k0 + 8 * c) = o;
    }
    LDS_FENCE();
}

DI void prologue_phase(const int TID, const Params& p) {
    extern __shared__ __attribute__((aligned(16))) float shf[];
    const int tid = TID, lane = tid & 63, wave = tid >> 6;
    unsigned char* ws = p.ws;
    {
        float* scr = shf + wave * (64 * 33);
        const int gw = blockIdx.x * 8 + wave, ngw = gridDim.x * 8;
        constexpr int I13 = (DM / 64) * (2 * DFF / 32), I2 = (DFF / 64) * (DM / 32);
        constexpr int IEI = (DM / 64) * (EVEN_IN / 32), IEO = (DM / 64) * (DM / 32), IGL = (512 / 64) * (512 / 32), IOI = (DM / 64) * (ODD_IN / 32), IOO = IEO;
        constexpr int NIT = 4 * (I13 + I2) + IEI + IEO + IGL + IOI + IOO;
        for (int it = gw; it < NIT; it += ngw) {
            int r = it;
            if (r < 4 * (I13 + I2)) {
                const int lf = r / (I13 + I2); r -= lf * (I13 + I2);
                const int l = lf >> 1, f = lf & 1;
                bf16_t* base = (bf16_t*)(ws + OFF_W + (size_t)lf * SZ_FFN);
                if (r < I13) transpose_item((f ? p.ffn2_w13 : p.ffn1_w13) + (size_t)l * DM * 2 * DFF, DM, 2 * DFF, base, 1, scr, r, lane);
                else transpose_item((f ? p.ffn2_w2 : p.ffn1_w2) + (size_t)l * DFF * DM, DFF, DM, (bf16_t*)((unsigned char*)base + SZ_W13), 0, scr, r - I13, lane);
                continue;
            }
            r -= 4 * (I13 + I2);
            if (r < IEI) { transpose_item(p.ev_w_in, DM, EVEN_IN, (bf16_t*)(ws + OFF_EVIN), 0, scr, r, lane); continue; } r -= IEI;
            if (r < IEO) { transpose_item(p.ev_w_out, DM, DM, (bf16_t*)(ws + OFF_EVOUT), 0, scr, r, lane); continue; } r -= IEO;
            if (r < IGL) { transpose_item(p.s5_glu_w, 512, 512, (bf16_t*)(ws + OFF_GLUW), 0, scr, r, lane); continue; } r -= IGL;
            if (r < IOI) { transpose_item(p.od_w_in, DM, ODD_IN, (bf16_t*)(ws + OFF_ODIN), 0, scr, r, lane); continue; } r -= IOI;
            transpose_item(p.od_w_out, DM, DM, (bf16_t*)(ws + OFF_ODOUT), 0, scr, r, lane);
        }
    }
    __syncthreads();
    {
        float* red = shf;
        float* MOD = (float*)(ws + OFF_MOD);
        for (int item = blockIdx.x; item < 2 * (MODW / 64); item += gridDim.x) {
            const int i = item / (MODW / 64), col = (item % (MODW / 64)) * 64 + lane;
            const float* W = p.mod_w + (size_t)i * DM * MODW + col;
            float a0 = 0.f, a1 = 0.f, a2 = 0.f, a3 = 0.f, a4 = 0.f;
            for (int k = wave * 128; k < wave * 128 + 128; ++k) {
                const float w = W[(size_t)k * MODW];
                a0 += silu_f(p.c[k]) * w; a1 += silu_f(p.c[DM + k]) * w; a2 += silu_f(p.c[2 * DM + k]) * w; a3 += silu_f(p.c[3 * DM + k]) * w; a4 += silu_f(p.c_ctx[k]) * w;
            }
            __syncthreads();
            red[(wave * 5 + 0) * 64 + lane] = a0; red[(wave * 5 + 1) * 64 + lane] = a1; red[(wave * 5 + 2) * 64 + lane] = a2; red[(wave * 5 + 3) * 64 + lane] = a3; red[(wave * 5 + 4) * 64 + lane] = a4;
            __syncthreads();
            if (tid < 320) {
                const int v = tid >> 6; float s = 0.f;
#pragma unroll
                for (int w8 = 0; w8 < 8; ++w8) s += red[(w8 * 5 + v) * 64 + lane];
                MOD[((size_t)i * 5 + v) * MODW + col] = s + p.mod_b[(size_t)i * MODW + col];
            }
        }
    }
    {
        f32x4* dstc = (f32x4*)(ws + OFF_CTXX); const f32x4* srcc = (const f32x4*)p.ctx;
        for (int idx = blockIdx.x * 512 + tid; idx < TC * DM / 4; idx += gridDim.x * 512) dstc[idx] = srcc[idx];
    }
    {
        f32x2* ROPE = (f32x2*)(ws + OFF_ROPE);
        for (int idx = blockIdx.x * 512 + tid; idx < SEQ * 32; idx += gridDim.x * 512) {
            const int pos = idx >> 5, i = idx & 31;
            const float inv = powf(10000.0f, -(float)(i & 15) / 16.0f);
            const float ang = (float)(i < 16 ? pos / 64 : pos % 64) * inv;
            float sn, cs; sincosf(ang, &sn, &cs);
            ROPE[idx] = (f32x2){cs, sn};
        }
    }
    {
        f32x2* SA_ = (f32x2*)(ws + OFF_S5A); bf16_t* SB_ = (bf16_t*)(ws + OFF_S5B); bf16_t* SC_ = (bf16_t*)(ws + OFF_S5C);
        for (int idx = blockIdx.x * 512 + tid; idx < 2 * 32 * 64; idx += gridDim.x * 512) {
            const int dg = idx >> 6, pp = idx & 63;
            const float lr = p.s5_lam_re[idx], li = p.s5_lam_im[idx], dt = expf(p.s5_log_dt[dg]);
            const float mag = expf(lr * dt); float sn, cs; sincosf(li * dt, &sn, &cs);
            const float ar = mag * cs, ai = mag * sn, den = lr * lr + li * li;
            const float fr = ((ar - 1.f) * lr + ai * li) / den, fi = (ai * lr - (ar - 1.f) * li) / den;
            SA_[idx] = (f32x2){ar, ai};
#pragma unroll
            for (int hh = 0; hh < 16; ++hh) {
                const float br = p.s5_b_re[(size_t)idx * 16 + hh], bi = p.s5_b_im[(size_t)idx * 16 + hh];
                const float vr = fr * br - fi * bi, vi = fr * bi + fi * br;
                const bf16_t rh = f2bf(vr), ih = f2bf(vi);
                SB_[((size_t)(dg * 4 + 0) * 64 + pp) * 16 + hh] = rh; SB_[((size_t)(dg * 4 + 1) * 64 + pp) * 16 + hh] = f2bf(vr - bf2f(rh));
                SB_[((size_t)(dg * 4 + 2) * 64 + pp) * 16 + hh] = ih; SB_[((size_t)(dg * 4 + 3) * 64 + pp) * 16 + hh] = f2bf(vi - bf2f(ih));
            }
        }
        for (int idx = blockIdx.x * 512 + tid; idx < 2 * 32 * 16 * 128; idx += gridDim.x * 512) {
            const int k = idx & 127, hh = (idx >> 7) & 15, dg = idx >> 11;
            const float v = (k & 1) ? -p.s5_c_im[((size_t)dg * 16 + hh) * 64 + (k >> 1)] : p.s5_c_re[((size_t)dg * 16 + hh) * 64 + (k >> 1)];
            const bf16_t vh = f2bf(v);
            SC_[((size_t)(dg * 2 + 0) * 16 + hh) * 128 + k] = vh; SC_[((size_t)(dg * 2 + 1) * 16 + hh) * 128 + k] = f2bf(v - bf2f(vh));
        }
    }
}

DI void normmod_phase(const int TID, const float* __restrict__ xl, float* __restrict__ xc, const float* __restrict__ g, const float* __restrict__ modl, int i_shift, int i_scale,
                      bf16_t* __restrict__ XN, int nrows, const float* __restrict__ part, int nslice) {
    const int lane = TID & 63, wave = TID >> 6;
    for (int row = blockIdx.x * 8 + wave; row < nrows; row += gridDim.x * 8) {
        const float* xr = row < TL ? xl + (size_t)row * DM : xc + (size_t)(row - TL) * DM;
        const int v = row < TL ? row / SEQ : 4;
        const float* sh = modl + (size_t)v * MODW + i_shift * DM; const float* sc = modl + (size_t)v * MODW + i_scale * DM;
        f32x4 x[4]; float ss = 0.f;
#pragma unroll
        for (int j = 0; j < 4; ++j) x[j] = *(const f32x4*)(xr + 256 * j + 4 * lane);
        if (row >= TL && nslice > 0) {
            for (int sl = 0; sl < nslice; ++sl)
#pragma unroll
                for (int j = 0; j < 4; ++j) x[j] += *(const f32x4*)(part + ((size_t)sl * TC + (row - TL)) * DM + 256 * j + 4 * lane);
#pragma unroll
            for (int j = 0; j < 4; ++j) *(f32x4*)(xc + (size_t)(row - TL) * DM + 256 * j + 4 * lane) = x[j];
        }
#pragma unroll
        for (int j = 0; j < 4; ++j) ss += x[j][0] * x[j][0] + x[j][1] * x[j][1] + x[j][2] * x[j][2] + x[j][3] * x[j][3];
        const float rstd = rsqrtf(wave_sum(ss) * (1.f / DM) + EPSN);
#pragma unroll
        for (int j = 0; j < 4; ++j) {
            const int col = 256 * j + 4 * lane;
            const f32x4 gg = *(const f32x4*)(g + col), s1 = *(const f32x4*)(sc + col), s0 = *(const f32x4*)(sh + col);
            const f32x4 y = (x[j] * rstd * gg) * (s1 + 1.0f) + s0;
            u32x2 w; w.x = pk2(y[0], y[1]); w.y = pk2(y[2], y[3]);
            *(u32x2*)(XN + (size_t)row * DM + col) = w;
        }
    }
}

DI void qkv_post_phase(const int TID, const Params& p, const bf16_t* __restrict__ Z, int ldz, int qcol, int nq, int kcol, int nk, int vcol, int nvh, int dv,
                       const float* __restrict__ gq, const float* __restrict__ gk) {
    extern __shared__ __attribute__((aligned(16))) unsigned char shb[];
    const int tid = TID, lane = tid & 63, wave = tid >> 6;
    bf16_t* Qh = (bf16_t*)(p.ws + OFF_Q); bf16_t* Kh = (bf16_t*)(p.ws + OFF_K); bf16_t* Vt = (bf16_t*)(p.ws + OFF_V);
    const f32x2* ROPE = (const f32x2*)(p.ws + OFF_ROPE);
    {
        const int hsub = lane >> 4, j = lane & 15, ngrp = (nq + nk + 3) >> 2;
        const f32x4 gq4 = *(const f32x4*)(gq + 4 * j) * (0.125f * LOG2E), gk4 = *(const f32x4*)(gk + 4 * j);
        for (int item = blockIdx.x * 8 + wave; item < TT * ngrp; item += gridDim.x * 8) {
            const int row = item / ngrp, hh = (item % ngrp) * 4 + hsub;
            const bool lat = row < TL, valid = hh < nq + nk, isq = hh < nq;
            const int b = lat ? row / SEQ : (row - TL) / CTXL;
            const int key = lat ? row % SEQ : SEQ + (row - TL) % CTXL;
            const int hd = isq ? hh : hh - nq;
            f32x4 x = {0.f, 0.f, 0.f, 0.f};
            if (valid) { const u32x2 w = *(const u32x2*)(Z + (size_t)row * ldz + (isq ? qcol : kcol) + hd * 64 + 4 * j); x = (f32x4){bflo(w.x), bfhi(w.x), bflo(w.y), bfhi(w.y)}; }
            float ss = x[0] * x[0] + x[1] * x[1] + x[2] * x[2] + x[3] * x[3];
            ss += __shfl_xor(ss, 1); ss += __shfl_xor(ss, 2); ss += __shfl_xor(ss, 4); ss += __shfl_xor(ss, 8);
            const float rstd = rsqrtf(ss * (1.f / 64.f) + EPSN);
            f32x4 y = x * rstd * (isq ? gq4 : gk4);
            f32x4 o; o[0] = __shfl_xor(y[0], 8); o[1] = __shfl_xor(y[1], 8); o[2] = __shfl_xor(y[2], 8); o[3] = __shfl_xor(y[3], 8);
            if (lat) {
                const f32x2* cs = ROPE + key * 32 + 4 * (j & 7);
#pragma unroll
                for (int e = 0; e < 4; ++e) { const f32x2 c = cs[e]; y[e] = j < 8 ? y[e] * c[0] - o[e] * c[1] : o[e] * c[1] + y[e] * c[0]; }
            }
            if (valid) {
                bf16_t* dst = (isq ? Qh + ((size_t)(b * nq + hd) * KEYS + key) * 64 : Kh + ((size_t)(b * nk + hd) * KEYS + key) * 64);
                u32x2 w; w.x = pk2(y[0], y[1]); w.y = pk2(y[2], y[3]);
                *(u32x2*)(dst + 4 * j) = w;
            }
        }
    }
    const int vc = nvh * dv, pitch = vc * 2 + 16;
    for (int item = blockIdx.x; item < TT / 64; item += gridDim.x) {
        const int row0 = item * 64;
        const bool lat = row0 < TL;
        const int b = lat ? row0 / SEQ : (row0 - TL) / CTXL;
        const int key0 = lat ? row0 % SEQ : SEQ + (row0 - TL) % CTXL;
        __syncthreads();
        for (int c = tid; c < 64 * (vc / 8); c += 512) {
            const int r = c / (vc / 8), cc = c % (vc / 8);
            *(u32x4*)(shb + r * pitch + cc * 16) = *(const u32x4*)(Z + (size_t)(row0 + r) * ldz + vcol + cc * 8);
        }
        __syncthreads();
        for (int idx = tid; idx < vc * 8; idx += 512) {
            const int tch = idx & 7, col = idx >> 3;
            unsigned short e[8];
#pragma unroll
            for (int k = 0; k < 8; ++k) e[k] = *(const unsigned short*)(shb + (8 * tch + k) * pitch + col * 2);
            u32x4 o; o.x = e[0] | ((unsigned)e[1] << 16); o.y = e[2] | ((unsigned)e[3] << 16); o.z = e[4] | ((unsigned)e[5] << 16); o.w = e[6] | ((unsigned)e[7] << 16);
            const int hd = col / dv, d = col % dv;
            *(u32x4*)(Vt + ((size_t)(b * nvh + hd) * dv + d) * KEYS + key0 + 8 * tch) = o;
        }
    }
}

#define MFMA32(a, b, c) __builtin_amdgcn_mfma_f32_32x32x16_bf16((a), (b), (c), 0, 0, 0)
constexpr int KP = 144, VP = 136;
constexpr int KT_BYTES = 64 * KP;

template <int NDT>
DI void attn_tile(const unsigned char* Kt, const unsigned char* Vtile, const bf16x8 (&qf)[4], f32x16 (&o)[NDT], float& l, float c1, float c2, int r, int h,
                  bool domask, int qk0  ) {
#pragma unroll
    for (int sub = 0; sub < 2; ++sub) {
        f32x16 st;
#pragma unroll
        for (int i = 0; i < 16; ++i) st[i] = -c2;
#pragma unroll
        for (int s = 0; s < 4; ++s) {
            const bf16x8 kf = *(const bf16x8*)(Kt + (32 * sub + r) * KP + (16 * s + 8 * h) * 2);
            st = MFMA32(kf, qf[s], st);
        }
        float pv[16];
#pragma unroll
        for (int i = 0; i < 16; ++i) {
            float e = __builtin_amdgcn_exp2f(st[i]);
            if (domask) { const int dd = qk0 - (32 * sub + (i & 3) + 8 * (i >> 2) + 4 * h); if (dd > 128 || dd < -128) e = 0.f; }
            pv[i] = e; l += e;
        }
        u32x4 w0, w1;
        w0.x = pk2(pv[0], pv[1]); w0.y = pk2(pv[2], pv[3]); w0.z = pk2(pv[4], pv[5]); w0.w = pk2(pv[6], pv[7]);
        w1.x = pk2(pv[8], pv[9]); w1.y = pk2(pv[10], pv[11]); w1.z = pk2(pv[12], pv[13]); w1.w = pk2(pv[14], pv[15]);
        const bf16x8 pf0 = __builtin_bit_cast(bf16x8, w0), pf1 = __builtin_bit_cast(bf16x8, w1);
#pragma unroll
        for (int dt = 0; dt < NDT; ++dt) {
#pragma unroll
            for (int s2 = 0; s2 < 2; ++s2) {
                const unsigned char* vp = Vtile + (32 * dt + r) * VP + (32 * sub + 16 * s2 + 4 * h) * 2;
                const s16x4 lo = *(const s16x4*)vp, hi = *(const s16x4*)(vp + 16);
                const bf16x8 vf = __builtin_shufflevector(lo, hi, 0, 1, 2, 3, 4, 5, 6, 7);
                o[dt] = MFMA32(vf, s2 ? pf1 : pf0, o[dt]);
            }
        }
    }
}

DI void diff_attn_phase(const int TID, const Params& p, bf16_t* __restrict__ MIX, float lam_init) {
    extern __shared__ __attribute__((aligned(16))) unsigned char smb[];
    const int tid = TID, lane = tid & 63, wave = tid >> 6, r = lane & 31, h = lane >> 5, rg = wave & 3, m = wave >> 2;
    const bf16_t* Qh = (const bf16_t*)(p.ws + OFF_Q); const bf16_t* Kh = (const bf16_t*)(p.ws + OFF_K); const bf16_t* Vt = (const bf16_t*)(p.ws + OFF_V);
    const float gqm = wave_max(fabsf(p.diff_qk_g[lane])), gkm = wave_max(fabsf(p.diff_qk_g[64 + lane]));
    const float c1 = 0.125f * LOG2E, c2 = 8.f * gqm * gkm * LOG2E;
    const float lam = expf(wave_sum(p.diff_lam[lane] * p.diff_lam[64 + lane])) - expf(wave_sum(p.diff_lam[128 + lane] * p.diff_lam[192 + lane])) + lam_init;
    constexpr int BUFSZ = 2 * KT_BYTES + 128 * VP;
    for (int unit = blockIdx.x; unit < NB * 4 * (SEQ / 128); unit += gridDim.x) {
        const int b = unit >> 8, rem = unit & 255, qb = rem >> 2, hd = rem & 3;
        bf16x8 qf[4];
        { const bf16_t* qp = Qh + ((size_t)(b * 8 + 2 * hd + m) * KEYS + qb * 128 + rg * 32 + r) * 64;
#pragma unroll
          for (int s = 0; s < 4; ++s) qf[s] = *(const bf16x8*)(qp + 16 * s + 8 * h); }
        const bf16_t* K0g = Kh + (size_t)(b * 8 + 2 * hd) * KEYS * 64;
        const bf16_t* Vg = Vt + (size_t)(b * 4 + hd) * 128 * KEYS;
        f32x16 o[4];
#pragma unroll
        for (int dt = 0; dt < 4; ++dt)
#pragma unroll
            for (int i = 0; i < 16; ++i) o[dt][i] = 0.f;
        float l = 0.f;
        u32x4 pre[4];
        const int kkey = (tid & 511) >> 3, kch = tid & 7;
#define DIFF_LOAD(t) do { const int key0_ = (t) * 64; \
            pre[0] = *(const u32x4*)(K0g + (size_t)(key0_ + kkey) * 64 + kch * 8); \
            pre[1] = *(const u32x4*)(K0g + (size_t)KEYS * 64 + (size_t)(key0_ + kkey) * 64 + kch * 8); \
            pre[2] = *(const u32x4*)(Vg + (size_t)(tid >> 3) * KEYS + key0_ + kch * 8); \
            pre[3] = *(const u32x4*)(Vg + (size_t)((tid >> 3) + 64) * KEYS + key0_ + kch * 8); } while (0)
        DIFF_LOAD(0);
        for (int t = 0; t < KEYS / 64; ++t) {
            unsigned char* buf = smb + (t & 1) * BUFSZ;
            *(u32x4*)(buf + kkey * KP + kch * 16) = pre[0];
            *(u32x4*)(buf + KT_BYTES + kkey * KP + kch * 16) = pre[1];
            { unsigned char* vq = buf + 2 * KT_BYTES + (tid >> 3) * VP + kch * 16;
              *(u32x2*)vq = (u32x2){pre[2].x, pre[2].y}; *(u32x2*)(vq + 8) = (u32x2){pre[2].z, pre[2].w};
              vq += 64 * VP;
              *(u32x2*)vq = (u32x2){pre[3].x, pre[3].y}; *(u32x2*)(vq + 8) = (u32x2){pre[3].z, pre[3].w}; }
            __syncthreads();
            if (t + 1 < KEYS / 64) DIFF_LOAD(t + 1);
            attn_tile<4>(buf + m * KT_BYTES, buf + 2 * KT_BYTES, qf, o, l, c1, c2, r, h, false, 0);
        }
#undef DIFF_LOAD
        l += __shfl_xor(l, 32);
        __syncthreads();
        float* X = (float*)smb;
        if (m == 1) {
            const float inv = lam / l;
#pragma unroll
            for (int dt = 0; dt < 4; ++dt)
#pragma unroll
                for (int i = 0; i < 16; ++i) X[(rg * 64 + lane) * 65 + dt * 16 + i] = o[dt][i] * inv;
        }
        __syncthreads();
        if (m == 0) {
            const float inv = 1.f / l; float ss = 0.f;
#pragma unroll
            for (int dt = 0; dt < 4; ++dt)
#pragma unroll
                for (int i = 0; i < 16; ++i) { const float v = o[dt][i] * inv - X[(rg * 64 + lane) * 65 + dt * 16 + i]; o[dt][i] = v; ss += v * v; }
            ss += __shfl_xor(ss, 32);
            const float rstd = rsqrtf(ss * (1.f / 128.f) + EPSN) * (1.f - lam_init);
            bf16_t* orow = MIX + (size_t)(b * SEQ + qb * 128 + rg * 32 + r) * DM + 512 + hd * 128;
#pragma unroll
            for (int dt = 0; dt < 4; ++dt)
#pragma unroll
                for (int g4 = 0; g4 < 4; ++g4) {
                    const int d = 32 * dt + 8 * g4 + 4 * h;
                    const f32x4 sg = *(const f32x4*)(p.diff_sub_g + d);
                    u32x2 w; w.x = pk2(o[dt][4 * g4] * rstd * sg[0], o[dt][4 * g4 + 1] * rstd * sg[1]); w.y = pk2(o[dt][4 * g4 + 2] * rstd * sg[2], o[dt][4 * g4 + 3] * rstd * sg[3]);
                    *(u32x2*)(orow + d) = w;
                }
        }
        __syncthreads();
    }
}

DI void swa_attn_phase(const int TID, const Params& p, bf16_t* __restrict__ MIX) {
    extern __shared__ __attribute__((aligned(16))) unsigned char smb[];
    const int tid = TID, lane = tid & 63, wave = tid >> 6, r = lane & 31, h = lane >> 5, rg = wave & 3, hh = wave >> 2;
    const bf16_t* Qh = (const bf16_t*)(p.ws + OFF_Q); const bf16_t* Kh = (const bf16_t*)(p.ws + OFF_K); const bf16_t* Vt = (const bf16_t*)(p.ws + OFF_V);
    const float gqm = wave_max(fabsf(p.swa_qk_g[lane])), gkm = wave_max(fabsf(p.swa_qk_g[64 + lane]));
    const float mb = 8.f * gqm * gkm, c1 = 0.125f * LOG2E, c2 = mb * LOG2E;
    constexpr int BUFSZ = KT_BYTES + 64 * VP;
    constexpr int NLAT = NB * (SEQ / 128) * 4, NCTX = NB * (CTXL / 128) * 4;
    const int G_ = (int)gridDim.x, nlat_it = (NLAT + G_ - 1) / G_, nctx_it = G_ >= NCTX ? 1 : (NCTX + G_ - 1) / G_;
    for (int it = 0; it < nlat_it + nctx_it; ++it) {
        int unit;
        if (it < nlat_it) { unit = (int)blockIdx.x + it * G_; if (unit >= NLAT) continue; }
        else {
            const int cb = G_ >= NCTX ? (int)blockIdx.x - (G_ - NCTX) : (int)blockIdx.x + (it - nlat_it) * G_;
            if (cb < 0 || cb >= NCTX) continue;
            unit = NLAT + cb;
        }
        const bool cq = unit >= NLAT;
        int b, qb, kv, pr;
        if (!cq) { b = unit >> 8; const int rem = unit & 255; qb = rem >> 2; kv = (rem >> 1) & 1; pr = rem & 1; }
        else { const int u2 = unit - NLAT; b = u2 >> 3; const int rem = u2 & 7; qb = rem >> 2; kv = (rem >> 1) & 1; pr = rem & 1; }
        const int head = 4 * kv + 2 * pr + hh;
        const int qpos = qb * 128 + rg * 32 + r;
        bf16x8 qf[4];
        { const bf16_t* qp = Qh + ((size_t)(b * 8 + head) * KEYS + (cq ? SEQ : 0) + qpos) * 64;
#pragma unroll
          for (int s = 0; s < 4; ++s) qf[s] = *(const bf16x8*)(qp + 16 * s + 8 * h); }
        const bf16_t* Kg = Kh + (size_t)(b * 2 + kv) * KEYS * 64;
        const bf16_t* Vg = Vt + (size_t)(b * 2 + kv) * 64 * KEYS;
        const int tlo = cq ? 0 : max(0, 2 * qb - 2), thi = cq ? -1 : min(SEQ / 64 - 1, 2 * qb + 3), nloc = thi - tlo + 1, ntile = nloc + CTXL / 64;
        f32x16 o[2];
#pragma unroll
        for (int dt = 0; dt < 2; ++dt)
#pragma unroll
            for (int i = 0; i < 16; ++i) o[dt][i] = 0.f;
        float l = 0.f;
        u32x4 pre[2];
        const int kkey = tid >> 3, kch = tid & 7;
#define SWA_TI(i) ((i) < nloc ? tlo + (i) : SEQ / 64 + ((i) - nloc))
#define SWA_LOAD(i) do { const int key0_ = SWA_TI(i) * 64; \
            pre[0] = *(const u32x4*)(Kg + (size_t)(key0_ + kkey) * 64 + kch * 8); \
            pre[1] = *(const u32x4*)(Vg + (size_t)kkey * KEYS + key0_ + kch * 8); } while (0)
        SWA_LOAD(0);
        for (int t = 0; t < ntile; ++t) {
            unsigned char* buf = smb + (t & 1) * BUFSZ;
            *(u32x4*)(buf + kkey * KP + kch * 16) = pre[0];
            { unsigned char* vq = buf + KT_BYTES + kkey * VP + kch * 16;
              *(u32x2*)vq = (u32x2){pre[1].x, pre[1].y}; *(u32x2*)(vq + 8) = (u32x2){pre[1].z, pre[1].w}; }
            __syncthreads();
            if (t + 1 < ntile) SWA_LOAD(t + 1);
            const int key0t = SWA_TI(t) * 64, qlo = qb * 128 + rg * 32;
            if (!(t < nloc && (key0t > qlo + 31 + 128 || key0t + 63 < qlo - 128)))
                attn_tile<2>(buf, buf + KT_BYTES, qf, o, l, c1, c2, r, h, t < nloc, qpos - key0t);
        }
#undef SWA_LOAD
#undef SWA_TI
        l += __shfl_xor(l, 32);
        l += __builtin_amdgcn_exp2f((p.swa_sink[head] - mb) * LOG2E);
        const float inv = 1.f / l;
        bf16_t* orow = MIX + (size_t)(cq ? TL + b * CTXL + qpos : b * SEQ + qpos) * DM + 512 + head * 64;
#pragma unroll
        for (int dt = 0; dt < 2; ++dt)
#pragma unroll
            for (int g4 = 0; g4 < 4; ++g4) {
                const int d = 32 * dt + 8 * g4 + 4 * h;
                u32x2 w; w.x = pk2(o[dt][4 * g4] * inv, o[dt][4 * g4 + 1] * inv); w.y = pk2(o[dt][4 * g4 + 2] * inv, o[dt][4 * g4 + 3] * inv);
                *(u32x2*)(orow + d) = w;
            }
        __syncthreads();
    }
}

DI float fma_s(float a, float b, float c) { float r; asm volatile("v_fma_f32 %0, %1, %2, %3" : "=v"(r) : "v"(a), "v"(b), "v"(c)); return r; }
DI void cmad(float& xr, float& xi, float ar, float ai, float br, float bi) {
    const float nr = fma_s(-xi, ai, fma_s(xr, ar, br)), ni = fma_s(xi, ar, fma_s(xr, ai, bi));
    xr = nr; xi = ni;
}
template <bool FWD, int Q> DI void s5_quad(const f32x16& br, const f32x16& bi, float ar, float ai, float& Br, float& Bi) {
    constexpr int i0 = FWD ? 4 * Q : 4 * Q + 3, st = FWD ? 1 : -1;
    Br = br[i0]; Bi = bi[i0];
    cmad(Br, Bi, ar, ai, br[i0 + st], bi[i0 + st]); cmad(Br, Bi, ar, ai, br[i0 + 2 * st], bi[i0 + 2 * st]); cmad(Br, Bi, ar, ai, br[i0 + 3 * st], bi[i0 + 3 * st]);
}
DI void s5_bu(const bf16_t* __restrict__ SBq  , bf16x8 af, int pt, int r, int h, f32x16& bur, f32x16& bui) {
#pragma unroll
    for (int i = 0; i < 16; ++i) { bur[i] = 0.f; bui[i] = 0.f; }
    const bf16_t* bp = SBq + (size_t)(pt * 32 + r) * 16 + 8 * h;
    bur = MFMA32(af, *(const bf16x8*)(bp), bur); bur = MFMA32(af, *(const bf16x8*)(bp + 1024), bur);
    bui = MFMA32(af, *(const bf16x8*)(bp + 2048), bui); bui = MFMA32(af, *(const bf16x8*)(bp + 3072), bui);
    float one; asm volatile("v_mov_b32 %0, 1.0" : "=v"(one));
#pragma unroll
    for (int i = 0; i < 16; ++i) { bur[i] *= one; bui[i] *= one; }
}
DI f32x2* s5_cin(unsigned char* ws, int b, int dir, int g) { return (f32x2*)(ws + (dir ? OFF_V : OFF_K) + SZ_QKV / 4) + (size_t)(b * 32 + g) * 264 * 64; }
DI void s5_chunk(int item, int& b, int& g, int& ck, int& row0) {
    ck = item % 264; g = (item / 264) & 31; b = item / (264 * 32);
    row0 = ck < 8 ? TL + b * CTXL + ck * 32 : b * SEQ + (ck - 8) * 32;
}
DI void s5_passA(const int TID, const Params& p, const bf16_t* __restrict__ Z) {
    const int lane = TID & 63, wave = TID >> 6, r = lane & 31, h = lane >> 5;
    const f32x2* SAp = (const f32x2*)(p.ws + OFF_S5A); const bf16_t* SBp = (const bf16_t*)(p.ws + OFF_S5B); f32x2* ST = (f32x2*)(p.ws + OFF_ST);
    for (int item = blockIdx.x * 8 + wave; item < NB * 32 * 264; item += gridDim.x * 8) {
        int b, g, ck, row0; s5_chunk(item, b, g, ck, row0);
        const bf16x8 af = *(const bf16x8*)(Z + (size_t)(row0 + r) * EVEN_IN + g * 16 + 8 * h);
        static_for<0, 2>([&](auto dc) {
            constexpr int dir = decltype(dc)::value;
            static_for<0, 2>([&](auto pc) {
                constexpr int pt = decltype(pc)::value;
                f32x16 bur, bui;
                s5_bu(SBp + (size_t)(dir * 32 + g) * 4096, af, pt, r, h, bur, bui);
                const f32x2 A = SAp[(dir * 32 + g) * 64 + pt * 32 + r];
                float a2r = A[0] * A[0] - A[1] * A[1], a2i = 2.f * A[0] * A[1];
                const float a4r = a2r * a2r - a2i * a2i, a4i = 2.f * a2r * a2i, a8r = a4r * a4r - a4i * a4i, a8i = 2.f * a4r * a4i;
                float Er = 0.f, Ei = 0.f;
                static_for<0, 4>([&](auto kc) {
                    constexpr int q = dir ? 3 - decltype(kc)::value : decltype(kc)::value;
                    float Br, Bi; s5_quad<dir == 0, q>(bur, bui, A[0], A[1], Br, Bi);
                    const float Pr = __shfl_xor(Br, 32), Pi = __shfl_xor(Bi, 32);
                    const bool own_first = (dir == 0) ? (h == 0) : (h == 1);
                    float fr = own_first ? Br : Pr, fi = own_first ? Bi : Pi; const float sr = own_first ? Pr : Br, si = own_first ? Pi : Bi;
                    cmad(fr, fi, a4r, a4i, sr, si);
                    cmad(Er, Ei, a8r, a8i, fr, fi);
                });
                if (h == 0) ST[((size_t)((b * 2 + dir) * 32 + g) * 264 + ck) * 64 + pt * 32 + r] = (f32x2){Er, Ei};
            });
        });
    }
}
DI void s5_passB(const int TID, const Params& p) {
    const f32x2* SAp = (const f32x2*)(p.ws + OFF_S5A); f32x2* ST = (f32x2*)(p.ws + OFF_ST);
    for (int idx = blockIdx.x * 512 + TID; idx < NB * 2 * 32 * 64; idx += gridDim.x * 512) {
        const int pp = idx & 63, bdg = idx >> 6, dir = (bdg >> 5) & 1;
        const f32x2 A = SAp[(bdg & 63) * 64 + pp];
        float ar = A[0], ai = A[1];
#pragma unroll
        for (int q = 0; q < 5; ++q) { const float nr = ar * ar - ai * ai; ai = 2.f * ar * ai; ar = nr; }
        float sr = 0.f, si = 0.f;
        const f32x2* e0 = ST + (size_t)bdg * 264 * 64 + pp;
        f32x2* c0 = s5_cin(p.ws, bdg >> 6, dir, bdg & 31) + pp;
        for (int v0 = 0; v0 < 264; v0 += 44) {
            f32x2 E[44];
#pragma unroll
            for (int k = 0; k < 44; ++k) { const int v = v0 + k; const int ck = dir == 0 ? v : (v < 8 ? 7 - v : 263 - (v - 8)); E[k] = e0[(size_t)ck * 64]; }
#pragma unroll
            for (int k = 0; k < 44; ++k) {
                const int v = v0 + k; const int ck = dir == 0 ? v : (v < 8 ? 7 - v : 263 - (v - 8));
                c0[(size_t)ck * 64] = (f32x2){sr, si};
                cmad(sr, si, ar, ai, E[k][0], E[k][1]);
            }
        }
    }
}
constexpr int HSP = 272;
DI void s5_passC(const int TID, const Params& p, const bf16_t* __restrict__ Z, bf16_t* __restrict__ G) {
    extern __shared__ __attribute__((aligned(16))) unsigned char smb[];
    const int lane = TID & 63, wave = TID >> 6, r = lane & 31, h = lane >> 5, c16 = lane & 15, kg = lane >> 4;
    unsigned char* Hs = smb + wave * (32 * HSP);
    const f32x2* SAp = (const f32x2*)(p.ws + OFF_S5A); const bf16_t* SBp = (const bf16_t*)(p.ws + OFF_S5B); const bf16_t* SCp = (const bf16_t*)(p.ws + OFF_S5C);
    const f32x2* ST = (const f32x2*)(p.ws + OFF_ST);
    for (int item = blockIdx.x * 8 + wave; item < NB * 32 * 264; item += gridDim.x * 8) {
        int b, g, ck, row0; s5_chunk(item, b, g, ck, row0);
        const bf16x8 af = *(const bf16x8*)(Z + (size_t)(row0 + r) * EVEN_IN + g * 16 + 8 * h);
        f32x4 yacc[2] = {{0.f, 0.f, 0.f, 0.f}, {0.f, 0.f, 0.f, 0.f}};
        static_for<0, 2>([&](auto dc) {
            constexpr int dir = decltype(dc)::value;
            static_for<0, 2>([&](auto pc) {
                constexpr int pt = decltype(pc)::value;
                f32x16 bur, bui;
                s5_bu(SBp + (size_t)(dir * 32 + g) * 4096, af, pt, r, h, bur, bui);
                const f32x2 A = SAp[(dir * 32 + g) * 64 + pt * 32 + r];
                float a2r = A[0] * A[0] - A[1] * A[1], a2i = 2.f * A[0] * A[1];
                const float a4r = a2r * a2r - a2i * a2i, a4i = 2.f * a2r * a2i, a8r = a4r * a4r - a4i * a4i, a8i = 2.f * a4r * a4i;
                const f32x2 cin = s5_cin(p.ws, b, dir, g)[(size_t)ck * 64 + pt * 32 + r];
                float Sr = cin[0], Si = cin[1];
                static_for<0, 4>([&](auto kc) {
                    constexpr int q = dir ? 3 - decltype(kc)::value : decltype(kc)::value;
                    float Br, Bi; s5_quad<dir == 0, q>(bur, bui, A[0], A[1], Br, Bi);
                    const float Pr = __shfl_xor(Br, 32), Pi = __shfl_xor(Bi, 32);
                    const bool own_first = (dir == 0) ? (h == 0) : (h == 1);
                    float er = Sr, ei = Si;
                    if (!own_first) cmad(er, ei, a4r, a4i, Pr, Pi);
                    float fr = own_first ? Br : Pr, fi = own_first ? Bi : Pi; const float sr = own_first ? Pr : Br, si = own_first ? Pi : Bi;
                    cmad(fr, fi, a4r, a4i, sr, si);
                    cmad(Sr, Si, a8r, a8i, fr, fi);
                    static_for<0, 4>([&](auto jc) {
                        constexpr int i = dir ? 4 * q + 3 - decltype(jc)::value : 4 * q + decltype(jc)::value;
                        cmad(er, ei, A[0], A[1], bur[i], bui[i]);
                        *(unsigned*)(Hs + (8 * (i >> 2) + 4 * h + (i & 3)) * HSP + (pt * 32 + r) * 4) = pk2(er, ei);
                    });
                });
            });
            LDS_FENCE();
            const bf16_t* cp = SCp + (size_t)(dir * 32 + g) * 2 * 16 * 128 + (size_t)c16 * 128 + 8 * kg;
#pragma unroll
            for (int tt = 0; tt < 2; ++tt)
#pragma unroll
                for (int ks = 0; ks < 4; ++ks) {
                    const bf16x8 hf = *(const bf16x8*)(Hs + (16 * tt + c16) * HSP + (32 * ks + 8 * kg) * 2);
                    yacc[tt] = __builtin_amdgcn_mfma_f32_16x16x32_bf16(hf, *(const bf16x8*)(cp + 32 * ks), yacc[tt], 0, 0, 0);
                    yacc[tt] = __builtin_amdgcn_mfma_f32_16x16x32_bf16(hf, *(const bf16x8*)(cp + 2048 + 32 * ks), yacc[tt], 0, 0, 0);
                }
            LDS_FENCE();
        });
        const float dsk = p.s5_d[g * 16 + c16];
#pragma unroll
        for (int tt = 0; tt < 2; ++tt)
#pragma unroll
            for (int i = 0; i < 4; ++i) {
                const size_t row = (size_t)row0 + 16 * tt + 4 * kg + i;
                const float u = bf2f(Z[row * EVEN_IN + g * 16 + c16]);
                G[row * 512 + g * 16 + c16] = f2bf(gelu_tanh(yacc[tt][i] + dsk * u));
            }
    }
}

constexpr int WLP = 144;
DI void lru_load_wl(const int TID, const Params& p, int n, unsigned char* WL, float* CW) {
    for (int idx = TID; idx < 4 * 4096; idx += 512) {
        const int mat = idx >> 12, de = idx & 4095, d = de >> 6, e = de & 63, dir = mat >> 1;
        const float* src = (mat & 1) ? p.lru_wx : p.lru_wa;
        *(bf16_t*)(WL + mat * 64 * WLP + e * WLP + d * 2) = f2bf(src[(size_t)(dir * 8 + n) * 4096 + de]);
    }
    for (int idx = TID; idx < 4096; idx += 512) { const int e = idx >> 6, d = idx & 63; *(bf16_t*)(WL + 4 * 64 * WLP + e * WLP + d * 2) = (e == d) ? (bf16_t)0x3F80 : (bf16_t)0; }
    if (TID < 320) { const int k = TID >> 6, d = TID & 63; CW[TID] = k < 4 ? p.lru_conv_w[k * 512 + n * 64 + d] : p.lru_conv_b[n * 64 + d]; }
}
DI void lru_afrag(const bf16_t* __restrict__ zr, int t, int seq_len, const float* CW, int h, bf16x8 (&af)[4]) {
#pragma unroll
    for (int s = 0; s < 4; ++s) {
        const int d0 = 16 * s + 8 * h;
        float x[8];
#pragma unroll
        for (int j = 0; j < 8; ++j) x[j] = CW[256 + d0 + j];
#pragma unroll
        for (int k = 0; k < 4; ++k) {
            const int tt = t + k - 2;
            if (tt >= 0 && tt < seq_len) {
                const u32x4 v = *(const u32x4*)(zr + (size_t)tt * ODD_IN + d0);
                const float* w = CW + k * 64 + d0;
                x[0] += bflo(v.x) * w[0]; x[1] += bfhi(v.x) * w[1]; x[2] += bflo(v.y) * w[2]; x[3] += bfhi(v.y) * w[3];
                x[4] += bflo(v.z) * w[4]; x[5] += bfhi(v.z) * w[5]; x[6] += bflo(v.w) * w[6]; x[7] += bfhi(v.w) * w[7];
            }
        }
        u32x4 w4; w4.x = pk2(x[0], x[1]); w4.y = pk2(x[2], x[3]); w4.z = pk2(x[4], x[5]); w4.w = pk2(x[6], x[7]);
        af[s] = __builtin_bit_cast(bf16x8, w4);
    }
}
DI void lru_pre(const unsigned char* WL, const bf16x8 (&af)[4], int et, int r, int h, f32x16 (&pre)[5]) {
#pragma unroll
    for (int mat = 0; mat < 5; ++mat) {
#pragma unroll
        for (int i = 0; i < 16; ++i) pre[mat][i] = 0.f;
#pragma unroll
        for (int s = 0; s < 4; ++s) pre[mat] = MFMA32(af[s], *(const bf16x8*)(WL + mat * 64 * WLP + (et * 32 + r) * WLP + (16 * s + 8 * h) * 2), pre[mat]);
    }
}
DI void lru_gates(const f32x16& pa, const f32x16& px, const f32x16& xcv, float ba, float bx, float sp, float (&a)[16], float (&bq)[16]) {
#pragma unroll
    for (int i = 0; i < 16; ++i) {
        const float rg = sigmoid_f(pa[i] + ba), gi = sigmoid_f(px[i] + bx);
        const float la = -8.f * rg * sp;
        const float av = __builtin_amdgcn_exp2f(la * LOG2E);
        a[i] = av; bq[i] = __builtin_amdgcn_sqrtf(fmaxf(fmaf(-av, av, 1.f), 0.f)) * (gi * xcv[i]);
    }
}
template <bool FWD, int Q> DI void lru_quad(const float (&a)[16], const float (&bq)[16], float& A, float& B) {
    constexpr int i0 = FWD ? 4 * Q : 4 * Q + 3, st = FWD ? 1 : -1;
    A = a[i0] * a[i0 + st] * a[i0 + 2 * st] * a[i0 + 3 * st];
    B = ((bq[i0] * a[i0 + st] + bq[i0 + st]) * a[i0 + 2 * st] + bq[i0 + 2 * st]) * a[i0 + 3 * st] + bq[i0 + 3 * st];
}
DI void lru_passA(const int TID, const Params& p, const bf16_t* __restrict__ Z) {
    extern __shared__ __attribute__((aligned(16))) unsigned char smb[];
    const int lane = TID & 63, wave = TID >> 6, r = lane & 31, h = lane >> 5;
    unsigned char* WL = smb; float* CW = (float*)(smb + 5 * 64 * WLP);
    f32x2* SUM = (f32x2*)(p.ws + OFF_ST);
    const int n = blockIdx.x & 7;
    __syncthreads();
    lru_load_wl(TID, p, n, WL, CW);
    __syncthreads();
    for (int item = (blockIdx.x >> 3) * 8 + wave; item < NB * 264; item += (gridDim.x >> 3) * 8) {
        asm volatile("" ::: "memory");
        const int b = item / 264, ck = item % 264;
        const int seq_len = ck < 8 ? CTXL : SEQ, t0 = ck < 8 ? ck * 32 : (ck - 8) * 32, rowbase = ck < 8 ? TL + b * CTXL : b * SEQ;
        bf16x8 af[4];
        lru_afrag(Z + (size_t)rowbase * ODD_IN + 512 + n * 64, t0 + r, seq_len, CW, h, af);
        static_for<0, 2>([&](auto etc) {
            constexpr int et = decltype(etc)::value;
            const int ch = n * 64 + et * 32 + r;
            f32x16 pre[5];
            lru_pre(WL, af, et, r, h, pre);
            static_for<0, 2>([&](auto dc) {
                constexpr int dir = decltype(dc)::value;
                float a[16], bq[16];
                lru_gates(pre[2 * dir], pre[2 * dir + 1], pre[4], p.lru_ba[dir * 512 + ch], p.lru_bx[dir * 512 + ch], log1pf(__expf(-p.lru_lam[dir * 512 + ch])), a, bq);
                float P = 1.f, E = 0.f;
                static_for<0, 4>([&](auto kc) {
                    constexpr int q = dir ? 3 - decltype(kc)::value : decltype(kc)::value;
                    float A, B;
                    lru_quad<dir == 0, q>(a, bq, A, B);
                    const float Ap = __shfl_xor(A, 32), Bp = __shfl_xor(B, 32);
                    const bool own_first = (dir == 0) ? (h == 0) : (h == 1);
                    const float fA = own_first ? A : Ap, fB = own_first ? B : Bp, sA = own_first ? Ap : A, sB = own_first ? Bp : B;
                    const float pA = fA * sA, pB = sA * fB + sB;
                    E = pA * E + pB; P *= pA;
                });
                if (h == 0) SUM[((size_t)(b * 2 + dir) * 264 + ck) * 512 + ch] = (f32x2){P, E};
            });
        });
    }
}
DI void lru_passB(const int TID, const Params& p) {
    const f32x2* SUM = (const f32x2*)(p.ws + OFF_ST); float* LC = (float*)(p.ws + OFF_LCIN);
    for (int idx = blockIdx.x * 512 + TID; idx < NB * 2 * 512; idx += gridDim.x * 512) {
        const int ch = idx & 511, bd = idx >> 9, dir = bd & 1;
        float s = 0.f;
        for (int v0 = 0; v0 < 264; v0 += 44) {
            f32x2 pe[44];
#pragma unroll
            for (int k = 0; k < 44; ++k) { const int v = v0 + k; const int ck = dir == 0 ? v : (v < 8 ? 7 - v : 263 - (v - 8)); pe[k] = SUM[((size_t)bd * 264 + ck) * 512 + ch]; }
#pragma unroll
            for (int k = 0; k < 44; ++k) { const int v = v0 + k; const int ck = dir == 0 ? v : (v < 8 ? 7 - v : 263 - (v - 8)); LC[((size_t)bd * 264 + ck) * 512 + ch] = s; s = pe[k][0] * s + pe[k][1]; }
        }
    }
}
DI void lru_passC(const int TID, const Params& p, const bf16_t* __restrict__ Z, bf16_t* __restrict__ MIX) {
    extern __shared__ __attribute__((aligned(16))) unsigned char smb[];
    const int lane = TID & 63, wave = TID >> 6, r = lane & 31, h = lane >> 5;
    unsigned char* WL = smb; float* CW = (float*)(smb + 5 * 64 * WLP);
    const float* LC = (const float*)(p.ws + OFF_LCIN);
    const int n = blockIdx.x & 7;
    __syncthreads();
    lru_load_wl(TID, p, n, WL, CW);
    __syncthreads();
    for (int item = (blockIdx.x >> 3) * 8 + wave; item < NB * 256; item += (gridDim.x >> 3) * 8) {
        asm volatile("" ::: "memory");
        const int b = item >> 8, j = item & 255, ck = 8 + j, t0 = j * 32;
        bf16x8 af[4];
        lru_afrag(Z + (size_t)b * SEQ * ODD_IN + 512 + n * 64, t0 + r, SEQ, CW, h, af);
        static_for<0, 2>([&](auto etc) {
            constexpr int et = decltype(etc)::value;
            const int ch = n * 64 + et * 32 + r;
            f32x16 pre[5];
            lru_pre(WL, af, et, r, h, pre);
            float y[16];
            static_for<0, 2>([&](auto dc) {
                constexpr int dir = decltype(dc)::value;
                float a[16], bq[16];
                lru_gates(pre[2 * dir], pre[2 * dir + 1], pre[4], p.lru_ba[dir * 512 + ch], p.lru_bx[dir * 512 + ch], log1pf(__expf(-p.lru_lam[dir * 512 + ch])), a, bq);
                float S = LC[((size_t)(b * 2 + dir) * 264 + ck) * 512 + ch];
                static_for<0, 4>([&](auto kc) {
                    constexpr int q = dir ? 3 - decltype(kc)::value : decltype(kc)::value;
                    float A, B;
                    lru_quad<dir == 0, q>(a, bq, A, B);
                    const float Ap = __shfl_xor(A, 32), Bp = __shfl_xor(B, 32);
                    const bool own_first = (dir == 0) ? (h == 0) : (h == 1);
                    float s = own_first ? S : Ap * S + Bp;
                    const float fA = own_first ? A : Ap, fB = own_first ? B : Bp, sA = own_first ? Ap : A, sB = own_first ? Bp : B;
                    S = (fA * sA) * S + (sA * fB + sB);
                    static_for<0, 4>([&](auto jc) {
                        constexpr int i = dir ? 4 * q + 3 - decltype(jc)::value : 4 * q + decltype(jc)::value;
                        s = a[i] * s + bq[i];
                        if (dir == 0) y[i] = s; else y[i] += s;
                    });
                });
            });
#pragma unroll
            for (int i = 0; i < 16; ++i) {
                const size_t row = (size_t)b * SEQ + t0 + 8 * (i >> 2) + 4 * h + (i & 3);
                const float gz = bf2f(Z[row * ODD_IN + ch]);
                MIX[row * DM + ch] = f2bf(y[i] * gelu_tanh(gz));
            }
        });
    }
}

constexpr int NPHASE = 26;
#ifndef MK_RPT
#define MK_RPT 0ull
#endif
#define RPT(bit, ...) do { __VA_ARGS__; if ((MK_RPT >> (bit)) & 1ull) { __syncthreads(); __VA_ARGS__; } } while (0)
DI void run_phase(const int TID, const Params& p, int ph) {
    if (ph == 0) { RPT(0, prologue_phase(TID, p)); return; }
    const int l = ph >= 14 ? 1 : 0;
    int s = l ? ph - 13 : ph;
    if (l && s >= 9) s += 1;
    const int rb = 16 * l;
    unsigned char* ws = p.ws;
    float* ctxx = (float*)(ws + OFF_CTXX);
    const float* modl = (const float*)(ws + OFF_MOD) + (size_t)l * 5 * MODW;
    bf16_t* XN = (bf16_t*)(ws + OFF_XN); bf16_t* H = (bf16_t*)(ws + OFF_H); bf16_t* G = (bf16_t*)(ws + OFF_G);
    const bool first = (l == 0 && s <= 3);
    const float* srcL = first ? p.x : p.out; const float* srcC = ctxx;
    (void)srcC;
    const int nrows = (l == 1 && s >= 10) ? TL : TT;
    const int f = s >= 11 ? 1 : 0;
    const bf16_t* W13 = (const bf16_t*)(ws + OFF_W + (size_t)(l * 2 + f) * SZ_FFN);
    const bf16_t* W2 = (const bf16_t*)(ws + OFF_W + (size_t)(l * 2 + f) * SZ_FFN + SZ_W13);
    switch (s) {
    case 1: case 4: case 11: {
        const int gi = s == 1 ? 0 : (s == 4 ? 1 : 2);
        const int nsl = (l == 0 && s == 1) ? 0 : (s == 11 ? 4 : 11);
        normmod_phase(TID, srcL, ctxx, p.norm_g + (size_t)(l * 3 + gi) * DM, modl, 3 * gi, 3 * gi + 1, XN, nrows, (const float*)(ws + OFF_Q), nsl);
    } break;
    case 2: case 12: { EpiSwiglu e{H}; RPT(rb + s, gemm_phase(TID, XN, W13, nrows, 2 * DFF, DM, e)); } break;
    case 3: case 13: case 10: {
        const float* gbase = modl + (s == 3 ? 2 : (s == 13 ? 8 : 5)) * DM; const float coef = s == 10 ? 1.0f : 0.5f;
        EpiResid e{srcL, srcC, p.out, ctxx, gbase, coef};
        EpiPartial ea{(float*)(ws + OFF_Q), gbase + (size_t)4 * MODW, coef};
        const bf16_t* Wo = (const bf16_t*)(ws + (l ? OFF_ODOUT : OFF_EVOUT));
        if (s == 10) { gemm_phase(TID, XN, Wo, TL, DM, DM, e); if (nrows == TT) gemm_phase(TID, XN + (size_t)TL * DM, Wo, TC, DM, DM, ea, 4); }
        else { gemm_phase(TID, H, W2, TL, DM, DFF, e); if (nrows == TT) gemm_phase(TID, H + (size_t)TL * DFF, W2, TC, DM, DFF, ea, 11); }
    } break;
    case 5: {
        EpiStoreBf16 e{H, l ? ODD_IN : EVEN_IN};
        RPT(rb + s, gemm_phase(TID, XN, (const bf16_t*)(ws + (l ? OFF_ODIN : OFF_EVIN)), TT, l ? ODD_IN : EVEN_IN, DM, e));
    } break;
    case 6:
        if (l == 0) { RPT(6, qkv_post_phase(TID, p, H, EVEN_IN, 512, 8, 1024, 2, 1152, 2, 64, p.swa_qk_g, p.swa_qk_g + 64)); __syncthreads(); RPT(14, s5_passA(TID, p, H)); }
        else { RPT(22, qkv_post_phase(TID, p, H, ODD_IN, 1024, 8, 1536, 8, 2048, 4, 128, p.diff_qk_g, p.diff_qk_g + 64)); __syncthreads(); RPT(30, lru_passA(TID, p, H)); }
        break;
    case 7:
        if (l == 0) { s5_passB(TID, p); RPT(7, swa_attn_phase(TID, p, XN)); }
        else { lru_passB(TID, p); RPT(23, diff_attn_phase(TID, p, XN, 0.8f - 0.6f * 0.74081822068171788f)); }
        break;
    case 8:
        if (l == 0) RPT(8, s5_passC(TID, p, H, G)); else RPT(24, lru_passC(TID, p, H, XN));
        break;
    case 9: { EpiGlu e{G, p.s5_glu_b, XN}; RPT(9, gemm_phase(TID, G, (const bf16_t*)(ws + OFF_GLUW), TT, 512, 512, e)); } break;
    default: break;
    }
}

DI int mk_tid(int wv) { int l; asm volatile("v_mbcnt_lo_u32_b32 %0, -1, 0\n\tv_mbcnt_hi_u32_b32 %0, -1, %0" : "=v"(l)); return wv * 64 + l; }
#define XB_TMO      128
#define XB_XCNT(j)  (256  + 64 * (j))
#define XB_XSUB(j)  (1280 + 64 * (j))
#define XB_XGEN(j)  (2304 + 64 * (j))
#define XB_TOP      3328
#define XB_TOPGEN   3392
#define XCD_BAR_WORDS 3456
#define XB_SPIN_CAP (1u << 22)
#define LAS __attribute__((address_space(3)))
DI unsigned xb_ld(unsigned* p) { return __hip_atomic_load(p, __ATOMIC_RELAXED, __HIP_MEMORY_SCOPE_AGENT); }
DI unsigned xb_add(unsigned* p, unsigned v) { return __hip_atomic_fetch_add(p, v, __ATOMIC_RELAXED, __HIP_MEMORY_SCOPE_AGENT); }
DI unsigned xb_xcc_id() { return (unsigned)__builtin_amdgcn_s_getreg((3 << 11) | 20) & 0xFu; }
#define XB_SPIN(cond, bar) do { unsigned _sp = 0; while (cond) { __builtin_amdgcn_s_sleep(1); \
    if ((++_sp & 255u) == 0u) { if (xb_ld(&(bar)[XB_TMO])) break; if (_sp > XB_SPIN_CAP) { atomicAdd(&(bar)[XB_TMO], 1u); break; } } } } while (0)
DI void xcd_barrier_complete(unsigned* bar, unsigned x, unsigned& nloc, unsigned& nx) {
    const unsigned G = gridDim.x;
    unsigned sum, cnt, mine, sp = 0u;
    for (;;) {
        sum = 0u; cnt = 0u; mine = 0u;
#pragma unroll
        for (unsigned j = 0; j < 16; ++j) { const unsigned c = xb_ld(&bar[XB_XCNT(j)]); sum += c; cnt += (c > 0u) ? 1u : 0u; mine = (j == x) ? c : mine; }
        if (sum == G) break;
        __builtin_amdgcn_s_sleep(1);
        if ((++sp & 255u) == 0u) { if (xb_ld(&bar[XB_TMO])) break; if (sp > XB_SPIN_CAP) { atomicAdd(&bar[XB_TMO], 1u); break; } }
    }
    nloc = mine > 0u ? mine : 1u; nx = cnt > 0u ? cnt : 1u;
}
DI void xcd_barrier(unsigned* bar, int tid) {
    extern __shared__ __attribute__((aligned(16))) unsigned char smx[];
    volatile LAS unsigned* st = (volatile LAS unsigned*)(smx + 131072);
    asm volatile("s_waitcnt vmcnt(0)" ::: "memory");
    __syncthreads();
    if (tid == 0) {
        const unsigned x = xb_xcc_id();
        __builtin_amdgcn_s_waitcnt(0);
        unsigned nloc = st[0], nx = st[1];
        if (nloc == 0u) { xcd_barrier_complete(bar, x, nloc, nx); st[0] = nloc; st[1] = nx; }
        const unsigned old = xb_add(&bar[XB_XSUB(x)], 1u);
        const unsigned gen = old / nloc;
        if (old + 1u == (gen + 1u) * nloc) {
            __builtin_amdgcn_fence(__ATOMIC_RELEASE, "agent");
            asm volatile("s_waitcnt vmcnt(0)" ::: "memory");
            const unsigned og = xb_add(&bar[XB_TOP], 1u);
            const unsigned tg = og / nx;
            if (og + 1u == (tg + 1u) * nx) xb_add(&bar[XB_TOPGEN], 1u);
            else XB_SPIN(xb_ld(&bar[XB_TOPGEN]) == tg, bar);
            __builtin_amdgcn_fence(__ATOMIC_ACQUIRE, "agent");
            xb_add(&bar[XB_XGEN(x)], 1u);
            asm volatile("s_waitcnt vmcnt(0)" ::: "memory");
        } else {
            XB_SPIN(xb_ld(&bar[XB_XGEN(x)]) == gen, bar);
            __builtin_amdgcn_fence(__ATOMIC_ACQUIRE, "agent");
            asm volatile("s_waitcnt vmcnt(0)" ::: "memory");
        }
    }
    __syncthreads();
}
template <int K>
DI void run_all(const int wv, const Params& p, int lo, int hi) {
    if constexpr (K < NPHASE) {
        if (K >= lo && K < hi) {
            const int tid = mk_tid(wv);
            run_phase(tid, p, K);
            if (K + 1 < hi) { xcd_barrier((unsigned*)(p.ws + OFF_BAR), tid); if ((MK_RPT >> 63) & 1ull) xcd_barrier((unsigned*)(p.ws + OFF_BAR), tid); }
        }
        run_all<K + 1>(wv, p, lo, hi);
    }
}
__global__ void __launch_bounds__(512) mega_fwd(Params p, int ph_lo, int ph_hi) {
    const int wv = __builtin_amdgcn_readfirstlane((int)(threadIdx.x >> 6));
    {
        extern __shared__ __attribute__((aligned(16))) unsigned char smx[];
        if (threadIdx.x == 0) { *(u32x4*)(smx + 131072) = (u32x4){0u, 0u, 0u, 0u}; (void)xb_add((unsigned*)(p.ws + OFF_BAR) + XB_XCNT(xb_xcc_id()), 1u); }
        __syncthreads();
    }
    if (ph_hi - ph_lo > 1) cg::this_grid().sync();
    run_all<0>(wv, p, ph_lo, ph_hi);
}

#ifndef MK_MULTI
#define MK_MULTI 0
#endif
extern "C" void kernel_launch(void* const* d_in, const int* in_sizes, int n_in, void* d_out, int out_size, void* d_ws, size_t ws_size, hipStream_t stream) {
    static int grid = 0;
    if (grid == 0) {
        if (n_in != 37 || in_sizes[0] != TL * DM || out_size != TL * DM || ws_size < WS_END) {
            fprintf(stderr, "kernel_launch: unexpected problem: n_in %d in0 %d out %d ws %zu (need %zu)\n", n_in, n_in > 0 ? in_sizes[0] : -1, out_size, ws_size, (size_t)WS_END);
            grid = -1; return;
        }
        int dev = 0, cus = 0, per_cu = 0;
        (void)hipGetDevice(&dev);
        (void)hipDeviceGetAttribute(&cus, hipDeviceAttributeMultiprocessorCount, dev);
        if (hipFuncSetAttribute((const void*)mega_fwd, hipFuncAttributeMaxDynamicSharedMemorySize, LDS_BYTES) != hipSuccess) { fprintf(stderr, "kernel_launch: hipFuncSetAttribute failed\n"); grid = -1; return; }
        (void)hipOccupancyMaxActiveBlocksPerMultiprocessor(&per_cu, (const void*)mega_fwd, 512, LDS_BYTES);
        if (per_cu < 1) { fprintf(stderr, "kernel_launch: occupancy query says %d blocks per CU\n", per_cu); per_cu = 1; }
        (void)hipGetLastError();
        grid = cus * per_cu;
    }
    if (grid < 0) return;
    if (hipMemsetAsync((unsigned char*)d_ws + OFF_BAR, 0, 16384, stream) != hipSuccess) { fprintf(stderr, "kernel_launch: memset failed\n"); return; }
    Params p{};
    const float** pp = (const float**)&p;
    for (int i = 0; i < 37; ++i) pp[i] = (const float*)d_in[i];
    p.out = (float*)d_out; p.ws = (unsigned char*)d_ws;
#if MK_MULTI
    for (int ph = 0; ph < NPHASE; ++ph) hipLaunchKernelGGL(mega_fwd, dim3(grid), dim3(512), LDS_BYTES, stream, p, ph, ph + 1);
#else
    int lo = 0, hi = NPHASE;
    void* args[] = {&p, &lo, &hi};
    hipError_t e = hipLaunchCooperativeKernel((const void*)mega_fwd, dim3(grid), dim3(512), args, LDS_BYTES, stream);
    if (e != hipSuccess) fprintf(stderr, "kernel_launch: cooperative launch failed: %s (grid %d)\n", hipGetErrorString(e), grid);
#endif
}
```

```cpp
#include <hip/hip_runtime.h>
#include <hip/hip_cooperative_groups.h>
#include <cstdio>
#include <cstdint>
namespace cg = cooperative_groups;

#define DI __device__ __forceinline__
typedef unsigned short bf16_t;
typedef short bf16x8 __attribute__((ext_vector_type(8)));
typedef short s16x4 __attribute__((ext_vector_type(4)));
typedef float f32x2 __attribute__((ext_vector_type(2)));
typedef float f32x4 __attribute__((ext_vector_type(4)));
typedef float f32x16 __attribute__((ext_vector_type(16)));
typedef unsigned u32x2 __attribute__((ext_vector_type(2)));
typedef unsigned u32x4 __attribute__((ext_vector_type(4)));
typedef __bf16 bf16x2_t __attribute__((ext_vector_type(2)));

constexpr int DM = 1024, NB = 4, SEQ = 8192, CTXL = 256, TL = NB * SEQ, TC = NB * CTXL, TT = TL + TC, DFF = 2816, KEYS = SEQ + CTXL;
constexpr int NMOD = 9, MODW = NMOD * DM;
constexpr int EVEN_IN = 1280, ODD_IN = 2560;
constexpr float EPSN = 1e-6f;
constexpr float LOG2E = 1.4426950408889634f;

constexpr size_t SZ_W13 = (size_t)2 * DFF * DM * 2, SZ_W2 = (size_t)DM * DFF * 2, SZ_FFN = SZ_W13 + SZ_W2;
constexpr size_t OFF_W = 0;
constexpr size_t OFF_EVIN = OFF_W + 4 * SZ_FFN;
constexpr size_t OFF_EVOUT = OFF_EVIN + (size_t)EVEN_IN * DM * 2;
constexpr size_t OFF_GLUW = OFF_EVOUT + (size_t)DM * DM * 2;
constexpr size_t OFF_ODIN = OFF_GLUW + (size_t)512 * 512 * 2;
constexpr size_t OFF_ODOUT = OFF_ODIN + (size_t)ODD_IN * DM * 2;
constexpr size_t OFF_XN = OFF_ODOUT + (size_t)DM * DM * 2;
constexpr size_t OFF_H = OFF_XN + (size_t)TT * DM * 2;
constexpr size_t OFF_CTXX = OFF_H + (size_t)TT * DFF * 2;
constexpr size_t OFF_MOD = OFF_CTXX + (size_t)TC * DM * 4;
constexpr size_t OFF_ROPE = OFF_MOD + (size_t)2 * 5 * MODW * 4;
constexpr size_t OFF_S5A = OFF_ROPE + (size_t)SEQ * 32 * 8;
constexpr size_t OFF_S5B = OFF_S5A + (size_t)2 * 32 * 64 * 8;
constexpr size_t OFF_Q = OFF_S5B + (size_t)2 * 32 * 64 * 16 * 8;
constexpr size_t SZ_QKV = (size_t)NB * 8 * KEYS * 64 * 2;
constexpr size_t OFF_K = OFF_Q + SZ_QKV;
constexpr size_t OFF_V = OFF_K + SZ_QKV;
constexpr size_t OFF_G = OFF_V + SZ_QKV;
constexpr size_t OFF_ST = OFF_G + (size_t)TT * 512 * 2;
constexpr size_t SZ_ST = (size_t)NB * 2 * 32 * 264 * 64 * 8;
constexpr size_t OFF_LCIN = OFF_ST + (size_t)NB * 2 * 264 * 512 * 8;
constexpr size_t OFF_BAR = OFF_ST + SZ_ST;
constexpr size_t OFF_S5C = OFF_BAR + 16384;
constexpr size_t WS_END = OFF_S5C + (size_t)2 * 32 * 2 * 16 * 128 * 2;
static_assert(OFF_LCIN + (size_t)NB * 2 * 264 * 512 * 4 <= OFF_BAR, "lru regions");
static_assert(SZ_QKV / 4 + (size_t)NB * 32 * 264 * 64 * 8 <= SZ_QKV, "s5 carry-in regions");
constexpr int LDS_BYTES = 131072 + 16;

struct Params {
    const float *x, *c, *ctx, *c_ctx, *mod_w, *mod_b, *norm_g, *ffn1_w13, *ffn1_w2, *ffn2_w13, *ffn2_w2, *ev_w_in, *ev_w_out;
    const float *s5_lam_re, *s5_lam_im, *s5_log_dt, *s5_b_re, *s5_b_im, *s5_c_re, *s5_c_im, *s5_d, *s5_glu_w, *s5_glu_b, *swa_qk_g, *swa_sink;
    const float *od_w_in, *od_w_out, *lru_conv_w, *lru_conv_b, *lru_wa, *lru_ba, *lru_wx, *lru_bx, *lru_lam, *diff_qk_g, *diff_lam, *diff_sub_g;
    float* out;
    unsigned char* ws;
};

DI unsigned pk2(float lo, float hi) { f32x2 v = {lo, hi}; bf16x2_t r = __builtin_convertvector(v, bf16x2_t); return __builtin_bit_cast(unsigned, r); }
DI bf16_t f2bf(float x) { return (bf16_t)(pk2(x, 0.f) & 0xffffu); }
DI float bf2f(bf16_t v) { return __uint_as_float((unsigned)v << 16); }
DI float bflo(unsigned w) { return __uint_as_float(w << 16); }
DI float bfhi(unsigned w) { return __uint_as_float(w & 0xffff0000u); }
DI float wave_sum(float v) {
#pragma unroll
    for (int o = 32; o; o >>= 1) v += __shfl_xor(v, o);
    return v;
}
DI float wave_max(float v) {
#pragma unroll
    for (int o = 32; o; o >>= 1) v = fmaxf(v, __shfl_xor(v, o));
    return v;
}
DI float sigmoid_f(float x) { return __builtin_amdgcn_rcpf(1.f + __builtin_amdgcn_exp2f(-LOG2E * x)); }
DI float silu_f(float x) { return x * sigmoid_f(x); }
DI float gelu_tanh(float x) { const float u = 0.7978845608028654f * (x + 0.044715f * x * x * x); return x * sigmoid_f(2.f * u); }
#define LDS_FENCE() asm volatile("s_waitcnt lgkmcnt(0)" ::: "memory")
template <int V> struct IC { static constexpr int value = V; };
template <int I, int N, class F> DI void static_for(F&& f) { if constexpr (I < N) { f(IC<I>{}); static_for<I + 1, N>(f); } }

constexpr int BM = 256, BK = 64, HALF = 128, HT = HALF * BK, NXCD = 8, WGM = 8;
DI int lds_byte(int r, int c) { int st = (r >> 4) * 2 + (c >> 5), rr = r & 15, cc = c & 31, ob = rr * 64 + cc * 2; return st * 1024 + (ob ^ (((ob >> 9) & 1) << 5)); }
DI void stage_rc(int b, int& R, int& C) { int st = b / 1024, sb = b % 1024, swz = sb ^ (((sb >> 9) & 1) << 5); R = (st >> 1) * 16 + swz / 64; C = (st & 1) * 32 + (swz % 64) / 2; }

template <class Epi>
DI void gemm_phase(const int TID, const bf16_t* __restrict__ A, const bf16_t* __restrict__ Bt, int M, int N, int K, const Epi& epi, const int S = 1) {
    extern __shared__ __attribute__((aligned(16))) bf16_t shm[];
    int tidx = TID; asm volatile("" : "+v"(tidx));
#define SA(b, h) (shm + ((b) * 2 + (h)) * HT)
#define SB(b, h) (shm + (4 + (b) * 2 + (h)) * HT)
#define STAGE(P, BASE, br, kt) do { const char* _ub = (const char*)(BASE) + ((long)(br) * K + (long)((kt) + kbase) * BK) * 2; \
      __builtin_amdgcn_global_load_lds((const unsigned*)(_ub + voff0), (unsigned*)((char*)(P) + wv_s * 1024), 16, 0, 0); \
      __builtin_amdgcn_global_load_lds((const unsigned*)(_ub + voff1), (unsigned*)((char*)(P) + wv_s * 1024 + 8192), 16, 0, 0); } while (0)
#define LDA(dst, b, h) for (int m = 0; m < 4; ++m) for (int k = 0; k < 2; ++k) \
    dst[m][k] = *reinterpret_cast<const bf16x8*>((char*)SA(b, h) + lds_byte(wr * 64 + m * 16 + fr, k * 32 + fq * 8))
#define LDB(dst, b, h) for (int n = 0; n < 2; ++n) for (int k = 0; k < 2; ++k) \
    dst[n][k] = *reinterpret_cast<const bf16x8*>((char*)SB(b, h) + lds_byte(wc * 32 + n * 16 + fr, k * 32 + fq * 8))
#define MMA(ai, bj, At_, Bt_) do { __builtin_amdgcn_s_setprio(1); \
    for (int m = 0; m < 4; ++m) for (int n = 0; n < 2; ++n) for (int k = 0; k < 2; ++k) \
      acc[ai][bj][m][n] = __builtin_amdgcn_mfma_f32_16x16x32_bf16(Bt_[n][k], At_[m][k], acc[ai][bj][m][n], 0, 0, 0); \
    __builtin_amdgcn_s_setprio(0); } while (0)
#define WAIT_V(n) asm volatile("s_waitcnt vmcnt(" #n ")" ::: "memory")
#define WAIT_L(n) asm volatile("s_waitcnt lgkmcnt(" #n ")" ::: "memory")
#define BAR __builtin_amdgcn_s_barrier()
#define SCHED __builtin_amdgcn_sched_barrier(0)
    const int nM = M / BM, nN = N / BM, ntile = nM * nN, nwg = ntile * S;
    const int wid = tidx >> 6, lane = tidx & 63, wr = wid >> 2, wc = wid & 3, fr = lane & 15, fq = lane >> 4;
    const int nt = K / BK / S;
    const int wv_s = __builtin_amdgcn_readfirstlane(tidx >> 6);
    unsigned voff0, voff1;
    { int r_, c_; stage_rc(tidx * 16, r_, c_); voff0 = (unsigned)(r_ * K + c_) * 2u; stage_rc(tidx * 16 + 8192, r_, c_); voff1 = (unsigned)(r_ * K + c_) * 2u; }
#define TILE_COORDS(L_, pm_, pn_, kb_) do { int wgid = (int)(L_); \
        if (S == 1) { const int q = nwg / NXCD, r = nwg % NXCD, xcd = wgid % NXCD, off = wgid / NXCD; wgid = (xcd < r ? xcd * (q + 1) : r * (q + 1) + (xcd - r) * q) + off; kb_ = 0; } \
        else { kb_ = (wgid % S) * nt; wgid /= S; } \
        const int nig = WGM * nN, gid = wgid / nig, fm = gid * WGM, gsz = min(nM - fm, WGM); \
        pm_ = fm + ((wgid % nig) % gsz); pn_ = (wgid % nig) / gsz; } while (0)
#define STAGE_P1(brow_, bcol_) do { STAGE(SB(0, 0), Bt, bcol_, 0); STAGE(SA(0, 0), A, brow_, 0); STAGE(SB(0, 1), Bt, (bcol_) + HALF, 0); STAGE(SA(0, 1), A, (brow_) + HALF, 0); } while (0)
    long L = blockIdx.x;
    if (L >= nwg) return;
    int pm, pn, kbase;
    TILE_COORDS(L, pm, pn, kbase);
    STAGE_P1(pm * BM, pn * BM);
    for (;;) {
        const int brow = pm * BM, bcol = pn * BM;
        f32x4 acc[2][2][4][2] = {};
        bf16x8 At[4][2], B0[2][2], B1[2][2];
        if (wr == 1) BAR;
        WAIT_V(0); BAR;
        STAGE(SB(1, 0), Bt, bcol, 1); STAGE(SA(1, 0), A, brow, 1); STAGE(SB(1, 1), Bt, bcol + HALF, 1);
        WAIT_V(6); BAR;
        for (int t = 0; t < nt - 2; t += 2) {
            LDB(B0, 0, 0); SCHED; LDA(At, 0, 0); STAGE(SA(1, 1), A, brow + HALF, t + 1);
            WAIT_L(8); BAR; WAIT_L(0); MMA(0, 0, At, B0); BAR; SCHED;
            LDB(B1, 0, 1); STAGE(SB(0, 0), Bt, bcol, t + 2);
            BAR; WAIT_L(0); MMA(0, 1, At, B1); BAR;
            LDA(At, 0, 1); STAGE(SA(0, 0), A, brow, t + 2);
            BAR; WAIT_L(0); MMA(1, 0, At, B0); BAR; SCHED;
            STAGE(SB(0, 1), Bt, bcol + HALF, t + 2);
            WAIT_V(6); BAR; MMA(1, 1, At, B1); BAR;
            LDB(B0, 1, 0); SCHED; LDA(At, 1, 0); STAGE(SA(0, 1), A, brow + HALF, t + 2);
            WAIT_L(8); BAR; WAIT_L(0); MMA(0, 0, At, B0); BAR; SCHED;
            LDB(B1, 1, 1); STAGE(SB(1, 0), Bt, bcol, t + 3);
            BAR; WAIT_L(0); MMA(0, 1, At, B1); BAR;
            LDA(At, 1, 1); STAGE(SA(1, 0), A, brow, t + 3);
            BAR; WAIT_L(0); MMA(1, 0, At, B0); BAR; SCHED;
            STAGE(SB(1, 1), Bt, bcol + HALF, t + 3);
            WAIT_V(6); BAR; MMA(1, 1, At, B1); BAR;
        }
        { LDB(B0, 0, 0); LDA(At, 0, 0); STAGE(SA(1, 1), A, brow + HALF, nt - 1);
          BAR; WAIT_L(0); MMA(0, 0, At, B0); BAR;
          LDB(B1, 0, 1); BAR; WAIT_L(0); MMA(0, 1, At, B1); BAR;
          LDA(At, 0, 1); WAIT_V(4); BAR; WAIT_L(0); MMA(1, 0, At, B0); MMA(1, 1, At, B1); BAR; }
        { LDB(B0, 1, 0); LDA(At, 1, 0); WAIT_V(2); BAR; WAIT_L(0); MMA(0, 0, At, B0); BAR;
          LDB(B1, 1, 1); WAIT_V(0); BAR; WAIT_L(0); MMA(0, 1, At, B1); BAR;
          LDA(At, 1, 1); BAR; WAIT_L(0); MMA(1, 0, At, B0); MMA(1, 1, At, B1); BAR; }
        if (wr == 0) BAR;
        const int kbase_cur = kbase;
        L += gridDim.x;
        const bool has_next = L < nwg;
        int pm_n = 0, pn_n = 0, kb_n = 0;
        if (has_next) { TILE_COORDS(L, pm_n, pn_n, kb_n); kbase = kb_n; STAGE_P1(pm_n * BM, pn_n * BM); }
        asm volatile("" ::: "memory"); SCHED;
        { int t2 = TID; asm volatile("" : "+v"(t2));
          int pm2 = S == 1 ? pm : pm + (kbase_cur / nt) * nM, pn2 = pn; asm volatile("" : "+s"(pm2), "+s"(pn2));
          epi(acc, pm2, pn2, t2 >> 8, (t2 >> 6) & 3, t2 & 15, (t2 & 63) >> 4); }
        asm volatile("" ::: "memory"); SCHED;
        if (!has_next) break;
        pm = pm_n; pn = pn_n;
    }
#undef TILE_COORDS
#undef STAGE_P1
#undef SA
#undef SB
#undef STAGE
#undef LDA
#undef LDB
#undef MMA
}

struct EpiSwiglu {
    bf16_t* H;
    DI void operator()(const f32x4 (&acc)[2][2][4][2], int pm, int pn, int wr, int wc, int fr, int fq) const {
#pragma unroll
        for (int ai = 0; ai < 2; ++ai)
#pragma unroll
            for (int m = 0; m < 4; ++m) {
                const size_t row = (size_t)pm * BM + ai * HALF + wr * 64 + m * 16 + fr;
#pragma unroll
                for (int bj = 0; bj < 2; ++bj) {
                    const int hc = (pn * BM + bj * HALF + wc * 32) / 2 + 4 * fq;
                    const f32x4 g = acc[ai][bj][m][0], u = acc[ai][bj][m][1];
                    u32x2 w; w.x = pk2(silu_f(g[0]) * u[0], silu_f(g[1]) * u[1]); w.y = pk2(silu_f(g[2]) * u[2], silu_f(g[3]) * u[3]);
                    *(u32x2*)(H + row * DFF + hc) = w;
                }
            }
    }
};
struct EpiResid {
    const float *srcL, *srcC; float *dstL, *dstC; const float* gate  ; float coef;
    DI void operator()(const f32x4 (&acc)[2][2][4][2], int pm, int pn, int wr, int wc, int fr, int fq) const {
        const int row0 = pm * BM;
        const bool lat = row0 < TL;
        const float* src = lat ? srcL : srcC - (size_t)TL * DM;
        float* dst = lat ? dstL : dstC - (size_t)TL * DM;
        const int v = lat ? row0 / SEQ : 4;
        const int col0 = pn * BM + wc * 32 + 4 * fq;
        const float* gv = gate + (size_t)v * MODW + col0;
        f32x4 gt[2][2];
#pragma unroll
        for (int bj = 0; bj < 2; ++bj)
#pragma unroll
            for (int n = 0; n < 2; ++n) gt[bj][n] = *(const f32x4*)(gv + bj * HALF + n * 16) * coef;
#pragma unroll
        for (int ai = 0; ai < 2; ++ai)
#pragma unroll
            for (int m = 0; m < 4; ++m) {
                const size_t off = (size_t)(row0 + ai * HALF + wr * 64 + m * 16 + fr) * DM + col0;
                const float* sp = src + off; float* dp = dst + off;
                f32x4 s[2][2];
#pragma unroll
                for (int bj = 0; bj < 2; ++bj)
#pragma unroll
                    for (int n = 0; n < 2; ++n) s[bj][n] = *(const f32x4*)(sp + bj * HALF + n * 16);
#pragma unroll
                for (int bj = 0; bj < 2; ++bj)
#pragma unroll
                    for (int n = 0; n < 2; ++n) *(f32x4*)(dp + bj * HALF + n * 16) = s[bj][n] + gt[bj][n] * acc[ai][bj][m][n];
                asm volatile("" ::: "memory");
            }
    }
};
struct EpiPartial {
    float* part; const float* gate; float coef;
    DI void operator()(const f32x4 (&acc)[2][2][4][2], int pm, int pn, int wr, int wc, int fr, int fq) const {
        const int col0 = pn * BM + wc * 32 + 4 * fq;
        f32x4 gt[2][2];
#pragma unroll
        for (int bj = 0; bj < 2; ++bj)
#pragma unroll
            for (int n = 0; n < 2; ++n) gt[bj][n] = *(const f32x4*)(gate + col0 + bj * HALF + n * 16) * coef;
#pragma unroll
        for (int ai = 0; ai < 2; ++ai)
#pragma unroll
            for (int m = 0; m < 4; ++m) {
                float* dp = part + (size_t)(pm * BM + ai * HALF + wr * 64 + m * 16 + fr) * DM + col0;
#pragma unroll
                for (int bj = 0; bj < 2; ++bj)
#pragma unroll
                    for (int n = 0; n < 2; ++n) *(f32x4*)(dp + bj * HALF + n * 16) = gt[bj][n] * acc[ai][bj][m][n];
                asm volatile("" ::: "memory");
            }
    }
};
struct EpiStoreBf16 {
    bf16_t* Z; int ldz;
    DI void operator()(const f32x4 (&acc)[2][2][4][2], int pm, int pn, int wr, int wc, int fr, int fq) const {
#pragma unroll
        for (int ai = 0; ai < 2; ++ai)
#pragma unroll
            for (int m = 0; m < 4; ++m) {
                const size_t row = (size_t)pm * BM + ai * HALF + wr * 64 + m * 16 + fr;
#pragma unroll
                for (int bj = 0; bj < 2; ++bj)
#pragma unroll
                    for (int n = 0; n < 2; ++n) {
                        const int col = pn * BM + bj * HALF + wc * 32 + n * 16 + 4 * fq;
                        const f32x4 a = acc[ai][bj][m][n];
                        u32x2 w; w.x = pk2(a[0], a[1]); w.y = pk2(a[2], a[3]);
                        *(u32x2*)(Z + row * ldz + col) = w;
                    }
            }
    }
};
struct EpiGlu {
    const bf16_t* G; const float* bias; bf16_t* MIX;
    DI void operator()(const f32x4 (&acc)[2][2][4][2], int pm, int pn, int wr, int wc, int fr, int fq) const {
        const int col0 = pn * BM + wc * 32 + 4 * fq;
        f32x4 bv[2][2];
#pragma unroll
        for (int bj = 0; bj < 2; ++bj)
#pragma unroll
            for (int n = 0; n < 2; ++n) bv[bj][n] = *(const f32x4*)(bias + col0 + bj * HALF + n * 16);
#pragma unroll
        for (int ai = 0; ai < 2; ++ai)
#pragma unroll
            for (int m = 0; m < 4; ++m) {
                const size_t row = (size_t)pm * BM + ai * HALF + wr * 64 + m * 16 + fr;
                const bf16_t* gp = G + row * 512 + col0; bf16_t* mp = MIX + row * DM + col0;
#pragma unroll
                for (int bj = 0; bj < 2; ++bj)
#pragma unroll
                    for (int n = 0; n < 2; ++n) {
                        const u32x2 gw = *(const u32x2*)(gp + bj * HALF + n * 16);
                        const f32x4 a = acc[ai][bj][m][n] + bv[bj][n];
                        u32x2 w; w.x = pk2(bflo(gw.x) * sigmoid_f(a[0]), bfhi(gw.x) * sigmoid_f(a[1])); w.y = pk2(bflo(gw.y) * sigmoid_f(a[2]), bfhi(gw.y) * sigmoid_f(a[3]));
                        *(u32x2*)(mp + bj * HALF + n * 16) = w;
                    }
                asm volatile("" ::: "memory");
            }
    }
};

DI void transpose_item(const float* __restrict__ W, int K, int N, bf16_t* __restrict__ WT, int mode, float* scr, int item, int lane) {
    const int nblk = N / 32, kb = item / nblk, nb = item % nblk, k0 = 64 * kb, n0 = 32 * nb;
#pragma unroll 8
    for (int i = 0; i < 32; ++i) { const int kk = 2 * i + (lane >> 5); scr[kk * 33 + (lane & 31)] = W[(size_t)(k0 + kk) * N + n0 + (lane & 31)]; }
    LDS_FENCE();
    const int c = lane & 7;
#pragma unroll
    for (int j = 0; j < 4; ++j) {
        const int n = (lane >> 3) + 8 * j; const float* s = scr + (8 * c) * 33 + n;
        u32x4 o; o.x = pk2(s[0 * 33], s[1 * 33]); o.y = pk2(s[2 * 33], s[3 * 33]); o.z = pk2(s[4 * 33], s[5 * 33]); o.w = pk2(s[6 * 33], s[7 * 33]);
        const int nn = n0 + n;
        int row = nn;
        if (mode == 1) { const int jj = nn < DFF ? nn : nn - DFF; row = (jj >> 4) * 32 + (jj & 15) + (nn < DFF ? 0 : 16); }
        *(u32x4*)(WT + (size_t)row * K + k0 + 8 * c) = o;
    }
    LDS_FENCE();
}

DI void prologue_phase(const int TID, const Params& p) {
    extern __shared__ __attribute__((aligned(16))) float shf[];
    const int tid = TID, lane = tid & 63, wave = tid >> 6;
    unsigned char* ws = p.ws;
    {
        float* scr = shf + wave * (64 * 33);
        const int gw = blockIdx.x * 8 + wave, ngw = gridDim.x * 8;
        constexpr int I13 = (DM / 64) * (2 * DFF / 32), I2 = (DFF / 64) * (DM / 32);
        constexpr int IEI = (DM / 64) * (EVEN_IN / 32), IEO = (DM / 64) * (DM / 32), IGL = (512 / 64) * (512 / 32), IOI = (DM / 64) * (ODD_IN / 32), IOO = IEO;
        constexpr int NIT = 4 * (I13 + I2) + IEI + IEO + IGL + IOI + IOO;
        for (int it = gw; it < NIT; it += ngw) {
            int r = it;
            if (r < 4 * (I13 + I2)) {
                const int lf = r / (I13 + I2); r -= lf * (I13 + I2);
                const int l = lf >> 1, f = lf & 1;
                bf16_t* base = (bf16_t*)(ws + OFF_W + (size_t)lf * SZ_FFN);
                if (r < I13) transpose_item((f ? p.ffn2_w13 : p.ffn1_w13) + (size_t)l * DM * 2 * DFF, DM, 2 * DFF, base, 1, scr, r, lane);
                else transpose_item((f ? p.ffn2_w2 : p.ffn1_w2) + (size_t)l * DFF * DM, DFF, DM, (bf16_t*)((unsigned char*)base + SZ_W13), 0, scr, r - I13, lane);
                continue;
            }
            r -= 4 * (I13 + I2);
            if (r < IEI) { transpose_item(p.ev_w_in, DM, EVEN_IN, (bf16_t*)(ws + OFF_EVIN), 0, scr, r, lane); continue; } r -= IEI;
            if (r < IEO) { transpose_item(p.ev_w_out, DM, DM, (bf16_t*)(ws + OFF_EVOUT), 0, scr, r, lane); continue; } r -= IEO;
            if (r < IGL) { transpose_item(p.s5_glu_w, 512, 512, (bf16_t*)(ws + OFF_GLUW), 0, scr, r, lane); continue; } r -= IGL;
            if (r < IOI) { transpose_item(p.od_w_in, DM, ODD_IN, (bf16_t*)(ws + OFF_ODIN), 0, scr, r, lane); continue; } r -= IOI;
            transpose_item(p.od_w_out, DM, DM, (bf16_t*)(ws + OFF_ODOUT), 0, scr, r, lane);
        }
    }
    __syncthreads();
    {
        float* red = shf;
        float* MOD = (float*)(ws + OFF_MOD);
        for (int item = blockIdx.x; item < 2 * (MODW / 64); item += gridDim.x) {
            const int i = item / (MODW / 64), col = (item % (MODW / 64)) * 64 + lane;
            const float* W = p.mod_w + (size_t)i * DM * MODW + col;
            float a0 = 0.f, a1 = 0.f, a2 = 0.f, a3 = 0.f, a4 = 0.f;
            for (int k = wave * 128; k < wave * 128 + 128; ++k) {
                const float w = W[(size_t)k * MODW];
                a0 += silu_f(p.c[k]) * w; a1 += silu_f(p.c[DM + k]) * w; a2 += silu_f(p.c[2 * DM + k]) * w; a3 += silu_f(p.c[3 * DM + k]) * w; a4 += silu_f(p.c_ctx[k]) * w;
            }
            __syncthreads();
            red[(wave * 5 + 0) * 64 + lane] = a0; red[(wave * 5 + 1) * 64 + lane] = a1; red[(wave * 5 + 2) * 64 + lane] = a2; red[(wave * 5 + 3) * 64 + lane] = a3; red[(wave * 5 + 4) * 64 + lane] = a4;
            __syncthreads();
            if (tid < 320) {
                const int v = tid >> 6; float s = 0.f;
#pragma unroll
                for (int w8 = 0; w8 < 8; ++w8) s += red[(w8 * 5 + v) * 64 + lane];
                MOD[((size_t)i * 5 + v) * MODW + col] = s + p.mod_b[(size_t)i * MODW + col];
            }
        }
    }
    {
        f32x4* dstc = (f32x4*)(ws + OFF_CTXX); const f32x4* srcc = (const f32x4*)p.ctx;
        for (int idx = blockIdx.x * 512 + tid; idx < TC * DM / 4; idx += gridDim.x * 512) dstc[idx] = srcc[idx];
    }
    {
        f32x2* ROPE = (f32x2*)(ws + OFF_ROPE);
        for (int idx = blockIdx.x * 512 + tid; idx < SEQ * 32; idx += gridDim.x * 512) {
            const int pos = idx >> 5, i = idx & 31;
            const float inv = powf(10000.0f, -(float)(i & 15) / 16.0f);
            const float ang = (float)(i < 16 ? pos / 64 : pos % 64) * inv;
            float sn, cs; sincosf(ang, &sn, &cs);
            ROPE[idx] = (f32x2){cs, sn};
        }
    }
    {
        f32x2* SA_ = (f32x2*)(ws + OFF_S5A); bf16_t* SB_ = (bf16_t*)(ws + OFF_S5B); bf16_t* SC_ = (bf16_t*)(ws + OFF_S5C);
        for (int idx = blockIdx.x * 512 + tid; idx < 2 * 32 * 64; idx += gridDim.x * 512) {
            const int dg = idx >> 6, pp = idx & 63;
            const float lr = p.s5_lam_re[idx], li = p.s5_lam_im[idx], dt = expf(p.s5_log_dt[dg]);
            const float mag = expf(lr * dt); float sn, cs; sincosf(li * dt, &sn, &cs);
            const float ar = mag * cs, ai = mag * sn, den = lr * lr + li * li;
            const float fr = ((ar - 1.f) * lr + ai * li) / den, fi = (ai * lr - (ar - 1.f) * li) / den;
            SA_[idx] = (f32x2){ar, ai};
#pragma unroll
            for (int hh = 0; hh < 16; ++hh) {
                const float br = p.s5_b_re[(size_t)idx * 16 + hh], bi = p.s5_b_im[(size_t)idx * 16 + hh];
                const float vr = fr * br - fi * bi, vi = fr * bi + fi * br;
                const bf16_t rh = f2bf(vr), ih = f2bf(vi);
                SB_[((size_t)(dg * 4 + 0) * 64 + pp) * 16 + hh] = rh; SB_[((size_t)(dg * 4 + 1) * 64 + pp) * 16 + hh] = f2bf(vr - bf2f(rh));
                SB_[((size_t)(dg * 4 + 2) * 64 + pp) * 16 + hh] = ih; SB_[((size_t)(dg * 4 + 3) * 64 + pp) * 16 + hh] = f2bf(vi - bf2f(ih));
            }
        }
        for (int idx = blockIdx.x * 512 + tid; idx < 2 * 32 * 16 * 128; idx += gridDim.x * 512) {
            const int k = idx & 127, hh = (idx >> 7) & 15, dg = idx >> 11;
            const float v = (k & 1) ? -p.s5_c_im[((size_t)dg * 16 + hh) * 64 + (k >> 1)] : p.s5_c_re[((size_t)dg * 16 + hh) * 64 + (k >> 1)];
            const bf16_t vh = f2bf(v);
            SC_[((size_t)(dg * 2 + 0) * 16 + hh) * 128 + k] = vh; SC_[((size_t)(dg * 2 + 1) * 16 + hh) * 128 + k] = f2bf(v - bf2f(vh));
        }
    }
}

DI void normmod_phase(const int TID, const float* __restrict__ xl, float* __restrict__ xc, const float* __restrict__ g, const float* __restrict__ modl, int i_shift, int i_scale,
                      bf16_t* __restrict__ XN, int nrows, const float* __restrict__ part, int nslice) {
    const int lane = TID & 63, wave = TID >> 6;
    for (int row = blockIdx.x * 8 + wave; row < nrows; row += gridDim.x * 8) {
        const float* xr = row < TL ? xl + (size_t)row * DM : xc + (size_t)(row - TL) * DM;
        const int v = row < TL ? row / SEQ : 4;
        const float* sh = modl + (size_t)v * MODW + i_shift * DM; const float* sc = modl + (size_t)v * MODW + i_scale * DM;
        f32x4 x[4]; float ss = 0.f;
#pragma unroll
        for (int j = 0; j < 4; ++j) x[j] = *(const f32x4*)(xr + 256 * j + 4 * lane);
        if (row >= TL && nslice > 0) {
            for (int sl = 0; sl < nslice; ++sl)
#pragma unroll
                for (int j = 0; j < 4; ++j) x[j] += *(const f32x4*)(part + ((size_t)sl * TC + (row - TL)) * DM + 256 * j + 4 * lane);
#pragma unroll
            for (int j = 0; j < 4; ++j) *(f32x4*)(xc + (size_t)(row - TL) * DM + 256 * j + 4 * lane) = x[j];
        }
#pragma unroll
        for (int j = 0; j < 4; ++j) ss += x[j][0] * x[j][0] + x[j][1] * x[j][1] + x[j][2] * x[j][2] + x[j][3] * x[j][3];
        const float rstd = rsqrtf(wave_sum(ss) * (1.f / DM) + EPSN);
#pragma unroll
        for (int j = 0; j < 4; ++j) {
            const int col = 256 * j + 4 * lane;
            const f32x4 gg = *(const f32x4*)(g + col), s1 = *(const f32x4*)(sc + col), s0 = *(const f32x4*)(sh + col);
            const f32x4 y = (x[j] * rstd * gg) * (s1 + 1.0f) + s0;
            u32x2 w; w.x = pk2(y[0], y[1]); w.y = pk2(y[2], y[3]);
            *(u32x2*)(XN + (size_t)row * DM + col) = w;
        }
    }
}

DI void qkv_post_phase(const int TID, const Params& p, const bf16_t* __restrict__ Z, int ldz, int qcol, int nq, int kcol, int nk, int vcol, int nvh, int dv,
                       const float* __restrict__ gq, const float* __restrict__ gk) {
    extern __shared__ __attribute__((aligned(16))) unsigned char shb[];
    const int tid = TID, lane = tid & 63, wave = tid >> 6;
    bf16_t* Qh = (bf16_t*)(p.ws + OFF_Q); bf16_t* Kh = (bf16_t*)(p.ws + OFF_K); bf16_t* Vt = (bf16_t*)(p.ws + OFF_V);
    const f32x2* ROPE = (const f32x2*)(p.ws + OFF_ROPE);
    {
        const int hsub = lane >> 4, j = lane & 15, ngrp = (nk + 3) >> 2;
        const f32x4 gq4 = *(const f32x4*)(gq + 4 * j) * (0.125f * LOG2E), gk4 = *(const f32x4*)(gk + 4 * j);
        for (int item = blockIdx.x * 8 + wave; item < TT * ngrp; item += gridDim.x * 8) {
            const int row = item / ngrp, hh = nq + (item % ngrp) * 4 + hsub;
            const bool lat = row < TL, valid = hh < nq + nk, isq = hh < nq;
            const int b = lat ? row / SEQ : (row - TL) / CTXL;
            const int key = lat ? row % SEQ : SEQ + (row - TL) % CTXL;
            const int hd = isq ? hh : hh - nq;
            f32x4 x = {0.f, 0.f, 0.f, 0.f};
            if (valid) { const u32x2 w = *(const u32x2*)(Z + (size_t)row * ldz + (isq ? qcol : kcol) + hd * 64 + 4 * j); x = (f32x4){bflo(w.x), bfhi(w.x), bflo(w.y), bfhi(w.y)}; }
            float ss = x[0] * x[0] + x[1] * x[1] + x[2] * x[2] + x[3] * x[3];
            ss += __shfl_xor(ss, 1); ss += __shfl_xor(ss, 2); ss += __shfl_xor(ss, 4); ss += __shfl_xor(ss, 8);
            const float rstd = rsqrtf(ss * (1.f / 64.f) + EPSN);
            f32x4 y = x * rstd * (isq ? gq4 : gk4);
            f32x4 o; o[0] = __shfl_xor(y[0], 8); o[1] = __shfl_xor(y[1], 8); o[2] = __shfl_xor(y[2], 8); o[3] = __shfl_xor(y[3], 8);
            if (lat) {
                const f32x2* cs = ROPE + key * 32 + 4 * (j & 7);
#pragma unroll
                for (int e = 0; e < 4; ++e) { const f32x2 c = cs[e]; y[e] = j < 8 ? y[e] * c[0] - o[e] * c[1] : o[e] * c[1] + y[e] * c[0]; }
            }
            if (valid) {
                bf16_t* dst = (isq ? Qh + ((size_t)(b * nq + hd) * KEYS + key) * 64 : Kh + ((size_t)(b * nk + hd) * KEYS + key) * 64);
                u32x2 w; w.x = pk2(y[0], y[1]); w.y = pk2(y[2], y[3]);
                *(u32x2*)(dst + 4 * j) = w;
            }
        }
    }
    const int vc = nvh * dv, pitch = vc * 2 + 16;
    for (int item = blockIdx.x; item < TT / 64; item += gridDim.x) {
        const int row0 = item * 64;
        const bool lat = row0 < TL;
        const int b = lat ? row0 / SEQ : (row0 - TL) / CTXL;
        const int key0 = lat ? row0 % SEQ : SEQ + (row0 - TL) % CTXL;
        __syncthreads();
        for (int c = tid; c < 64 * (vc / 8); c += 512) {
            const int r = c / (vc / 8), cc = c % (vc / 8);
            *(u32x4*)(shb + r * pitch + cc * 16) = *(const u32x4*)(Z + (size_t)(row0 + r) * ldz + vcol + cc * 8);
        }
        __syncthreads();
        for (int idx = tid; idx < vc * 8; idx += 512) {
            const int tch = idx & 7, col = idx >> 3;
            unsigned short e[8];
#pragma unroll
            for (int k = 0; k < 8; ++k) e[k] = *(const unsigned short*)(shb + (8 * tch + k) * pitch + col * 2);
            u32x4 o; o.x = e[0] | ((unsigned)e[1] << 16); o.y = e[2] | ((unsigned)e[3] << 16); o.z = e[4] | ((unsigned)e[5] << 16); o.w = e[6] | ((unsigned)e[7] << 16);
            const int hd = col / dv, d = col % dv;
            *(u32x4*)(Vt + ((size_t)(b * nvh + hd) * dv + d) * KEYS + key0 + 8 * tch) = o;
        }
    }
}

#define MFMA32(a, b, c) __builtin_amdgcn_mfma_f32_32x32x16_bf16((a), (b), (c), 0, 0, 0)
constexpr int KP = 144, VP = 136;
constexpr int KT_BYTES = 64 * KP;

template <int NDT>
DI void attn_tile(const unsigned char* Kt, const unsigned char* Vtile, const bf16x8 (&qf)[4], f32x16 (&o)[NDT], float& l, float c1, float c2, int r, int h,
                  bool domask, int qk0  ) {
#pragma unroll
    for (int sub = 0; sub < 2; ++sub) {
        f32x16 st;
#pragma unroll
        for (int i = 0; i < 16; ++i) st[i] = -c2;
#pragma unroll
        for (int s = 0; s < 4; ++s) {
            const bf16x8 kf = *(const bf16x8*)(Kt + (32 * sub + r) * KP + (16 * s + 8 * h) * 2);
            st = MFMA32(kf, qf[s], st);
        }
        float pv[16];
#pragma unroll
        for (int i = 0; i < 16; ++i) {
            float e = __builtin_amdgcn_exp2f(st[i]);
            if (domask) { const int dd = qk0 - (32 * sub + (i & 3) + 8 * (i >> 2) + 4 * h); if (dd > 128 || dd < -128) e = 0.f; }
            pv[i] = e; l += e;
        }
        u32x4 w0, w1;
        w0.x = pk2(pv[0], pv[1]); w0.y = pk2(pv[2], pv[3]); w0.z = pk2(pv[4], pv[5]); w0.w = pk2(pv[6], pv[7]);
        w1.x = pk2(pv[8], pv[9]); w1.y = pk2(pv[10], pv[11]); w1.z = pk2(pv[12], pv[13]); w1.w = pk2(pv[14], pv[15]);
        const bf16x8 pf0 = __builtin_bit_cast(bf16x8, w0), pf1 = __builtin_bit_cast(bf16x8, w1);
#pragma unroll
        for (int dt = 0; dt < NDT; ++dt) {
#pragma unroll
            for (int s2 = 0; s2 < 2; ++s2) {
                const unsigned char* vp = Vtile + (32 * dt + r) * VP + (32 * sub + 16 * s2 + 4 * h) * 2;
                const s16x4 lo = *(const s16x4*)vp, hi = *(const s16x4*)(vp + 16);
                const bf16x8 vf = __builtin_shufflevector(lo, hi, 0, 1, 2, 3, 4, 5, 6, 7);
                o[dt] = MFMA32(vf, s2 ? pf1 : pf0, o[dt]);
            }
        }
    }
}

DI void load_q_frags(const bf16_t* __restrict__ zq, const float* __restrict__ gq, const f32x2* __restrict__ rope, int h, bf16x8 (&qf)[4]) {
    float x[4][8]; float ss = 0.f;
#pragma unroll
    for (int s = 0; s < 4; ++s) {
        const u32x4 w = *(const u32x4*)(zq + 16 * s + 8 * h);
        x[s][0] = bflo(w.x); x[s][1] = bfhi(w.x); x[s][2] = bflo(w.y); x[s][3] = bfhi(w.y); x[s][4] = bflo(w.z); x[s][5] = bfhi(w.z); x[s][6] = bflo(w.w); x[s][7] = bfhi(w.w);
#pragma unroll
        for (int j = 0; j < 8; ++j) ss += x[s][j] * x[s][j];
    }
    ss += __shfl_xor(ss, 32);
    const float rstd = rsqrtf(ss * (1.f / 64.f) + EPSN);
#pragma unroll
    for (int s = 0; s < 4; ++s)
#pragma unroll
        for (int j = 0; j < 8; ++j) x[s][j] = x[s][j] * rstd * (gq[16 * s + 8 * h + j] * (0.125f * LOG2E));
    if (rope) {
#pragma unroll
        for (int s = 0; s < 2; ++s)
#pragma unroll
            for (int j = 0; j < 8; ++j) {
                const f32x2 c = rope[16 * s + 8 * h + j];
                const float a = x[s][j], bq = x[s + 2][j];
                x[s][j] = a * c[0] - bq * c[1]; x[s + 2][j] = a * c[1] + bq * c[0];
            }
    }
#pragma unroll
    for (int s = 0; s < 4; ++s) {
        u32x4 w; w.x = pk2(x[s][0], x[s][1]); w.y = pk2(x[s][2], x[s][3]); w.z = pk2(x[s][4], x[s][5]); w.w = pk2(x[s][6], x[s][7]);
        qf[s] = __builtin_bit_cast(bf16x8, w);
    }
}

DI void diff_attn_phase(const int TID, const Params& p, const bf16_t* __restrict__ Z, bf16_t* __restrict__ MIX, float lam_init) {
    extern __shared__ __attribute__((aligned(16))) unsigned char smb[];
    const int tid = TID, lane = tid & 63, wave = tid >> 6, r = lane & 31, h = lane >> 5, rg = wave & 3, m = wave >> 2;
    const bf16_t* Qh = (const bf16_t*)(p.ws + OFF_Q); const bf16_t* Kh = (const bf16_t*)(p.ws + OFF_K); const bf16_t* Vt = (const bf16_t*)(p.ws + OFF_V);
    const float gqm = wave_max(fabsf(p.diff_qk_g[lane])), gkm = wave_max(fabsf(p.diff_qk_g[64 + lane]));
    const float c1 = 0.125f * LOG2E, c2 = 8.f * gqm * gkm * LOG2E;
    const float lam = expf(wave_sum(p.diff_lam[lane] * p.diff_lam[64 + lane])) - expf(wave_sum(p.diff_lam[128 + lane] * p.diff_lam[192 + lane])) + lam_init;
    constexpr int BUFSZ = 2 * KT_BYTES + 128 * VP;
    for (int unit = blockIdx.x; unit < NB * 4 * (SEQ / 128); unit += gridDim.x) {
        const int b = unit >> 8, rem = unit & 255, qb = rem >> 2, hd = rem & 3;
        bf16x8 qf[4];
        { const int qpos_ = qb * 128 + rg * 32 + r;
          load_q_frags(Z + (size_t)(b * SEQ + qpos_) * ODD_IN + 1024 + (2 * hd + m) * 64, p.diff_qk_g, (const f32x2*)(p.ws + OFF_ROPE) + qpos_ * 32, h, qf); }
        const bf16_t* K0g = Kh + (size_t)(b * 8 + 2 * hd) * KEYS * 64;
        const bf16_t* Vg = Vt + (size_t)(b * 4 + hd) * 128 * KEYS;
        f32x16 o[4];
#pragma unroll
        for (int dt = 0; dt < 4; ++dt)
#pragma unroll
            for (int i = 0; i < 16; ++i) o[dt][i] = 0.f;
        float l = 0.f;
        u32x4 pre[4];
        const int kkey = (tid & 511) >> 3, kch = tid & 7;
#define DIFF_LOAD(t) do { const int key0_ = (t) * 64; \
            pre[0] = *(const u32x4*)(K0g + (size_t)(key0_ + kkey) * 64 + kch * 8); \
            pre[1] = *(const u32x4*)(K0g + (size_t)KEYS * 64 + (size_t)(key0_ + kkey) * 64 + kch * 8); \
            pre[2] = *(const u32x4*)(Vg + (size_t)(tid >> 3) * KEYS + key0_ + kch * 8); \
            pre[3] = *(const u32x4*)(Vg + (size_t)((tid >> 3) + 64) * KEYS + key0_ + kch * 8); } while (0)
        DIFF_LOAD(0);
        for (int t = 0; t < KEYS / 64; ++t) {
            unsigned char* buf = smb + (t & 1) * BUFSZ;
            *(u32x4*)(buf + kkey * KP + kch * 16) = pre[0];
            *(u32x4*)(buf + KT_BYTES + kkey * KP + kch * 16) = pre[1];
            { unsigned char* vq = buf + 2 * KT_BYTES + (tid >> 3) * VP + kch * 16;
              *(u32x2*)vq = (u32x2){pre[2].x, pre[2].y}; *(u32x2*)(vq + 8) = (u32x2){pre[2].z, pre[2].w};
              vq += 64 * VP;
              *(u32x2*)vq = (u32x2){pre[3].x, pre[3].y}; *(u32x2*)(vq + 8) = (u32x2){pre[3].z, pre[3].w}; }
            __syncthreads();
            if (t + 1 < KEYS / 64) DIFF_LOAD(t + 1);
            attn_tile<4>(buf + m * KT_BYTES, buf + 2 * KT_BYTES, qf, o, l, c1, c2, r, h, false, 0);
        }
#undef DIFF_LOAD
        l += __shfl_xor(l, 32);
        __syncthreads();
        float* X = (float*)smb;
        if (m == 1) {
            const float inv = lam / l;
#pragma unroll
            for (int dt = 0; dt < 4; ++dt)
#pragma unroll
                for (int i = 0; i < 16; ++i) X[(rg * 64 + lane) * 65 + dt * 16 + i] = o[dt][i] * inv;
        }
        __syncthreads();
        if (m == 0) {
            const float inv = 1.f / l; float ss = 0.f;
#pragma unroll
            for (int dt = 0; dt < 4; ++dt)
#pragma unroll
                for (int i = 0; i < 16; ++i) { const float v = o[dt][i] * inv - X[(rg * 64 + lane) * 65 + dt * 16 + i]; o[dt][i] = v; ss += v * v; }
            ss += __shfl_xor(ss, 32);
            const float rstd = rsqrtf(ss * (1.f / 128.f) + EPSN) * (1.f - lam_init);
            bf16_t* orow = MIX + (size_t)(b * SEQ + qb * 128 + rg * 32 + r) * DM + 512 + hd * 128;
#pragma unroll
            for (int dt = 0; dt < 4; ++dt)
#pragma unroll
                for (int g4 = 0; g4 < 4; ++g4) {
                    const int d = 32 * dt + 8 * g4 + 4 * h;
                    const f32x4 sg = *(const f32x4*)(p.diff_sub_g + d);
                    u32x2 w; w.x = pk2(o[dt][4 * g4] * rstd * sg[0], o[dt][4 * g4 + 1] * rstd * sg[1]); w.y = pk2(o[dt][4 * g4 + 2] * rstd * sg[2], o[dt][4 * g4 + 3] * rstd * sg[3]);
                    *(u32x2*)(orow + d) = w;
                }
        }
        __syncthreads();
    }
}

DI void swa_attn_phase(const int TID, const Params& p, const bf16_t* __restrict__ Z, bf16_t* __restrict__ MIX) {
    extern __shared__ __attribute__((aligned(16))) unsigned char smb[];
    const int tid = TID, lane = tid & 63, wave = tid >> 6, r = lane & 31, h = lane >> 5, rg = wave & 3, hh = wave >> 2;
    const bf16_t* Qh = (const bf16_t*)(p.ws + OFF_Q); const bf16_t* Kh = (const bf16_t*)(p.ws + OFF_K); const bf16_t* Vt = (const bf16_t*)(p.ws + OFF_V);
    const float gqm = wave_max(fabsf(p.swa_qk_g[lane])), gkm = wave_max(fabsf(p.swa_qk_g[64 + lane]));
    const float mb = 8.f * gqm * gkm, c1 = 0.125f * LOG2E, c2 = mb * LOG2E;
    constexpr int BUFSZ = KT_BYTES + 64 * VP;
    constexpr int NLAT = NB * (SEQ / 128) * 4, NCTX = NB * (CTXL / 128) * 4;
    for (int unit = blockIdx.x; unit < NLAT + NCTX; unit += gridDim.x) {
        const bool cq = unit >= NLAT;
        int b, qb, kv, pr;
        if (!cq) { b = unit >> 8; const int rem = unit & 255; qb = rem >> 2; kv = (rem >> 1) & 1; pr = rem & 1; }
        else { const int u2 = unit - NLAT; b = u2 >> 3; const int rem = u2 & 7; qb = rem >> 2; kv = (rem >> 1) & 1; pr = rem & 1; }
        const int head = 4 * kv + 2 * pr + hh;
        const int qpos = qb * 128 + rg * 32 + r;
        bf16x8 qf[4];
        load_q_frags(Z + (size_t)(cq ? TL + b * CTXL + qpos : b * SEQ + qpos) * EVEN_IN + 512 + head * 64, p.swa_qk_g, cq ? (const f32x2*)nullptr : (const f32x2*)(p.ws + OFF_ROPE) + qpos * 32, h, qf);
        const bf16_t* Kg = Kh + (size_t)(b * 2 + kv) * KEYS * 64;
        const bf16_t* Vg = Vt + (size_t)(b * 2 + kv) * 64 * KEYS;
        const int tlo = cq ? 0 : max(0, 2 * qb - 2), thi = cq ? -1 : min(SEQ / 64 - 1, 2 * qb + 3), nloc = thi - tlo + 1, ntile = nloc + CTXL / 64;
        f32x16 o[2];
#pragma unroll
        for (int dt = 0; dt < 2; ++dt)
#pragma unroll
            for (int i = 0; i < 16; ++i) o[dt][i] = 0.f;
        float l = 0.f;
        u32x4 pre[2];
        const int kkey = tid >> 3, kch = tid & 7;
#define SWA_TI(i) ((i) < nloc ? tlo + (i) : SEQ / 64 + ((i) - nloc))
#define SWA_LOAD(i) do { const int key0_ = SWA_TI(i) * 64; \
            pre[0] = *(const u32x4*)(Kg + (size_t)(key0_ + kkey) * 64 + kch * 8); \
            pre[1] = *(const u32x4*)(Vg + (size_t)kkey * KEYS + key0_ + kch * 8); } while (0)
        SWA_LOAD(0);
        for (int t = 0; t < ntile; ++t) {
            unsigned char* buf = smb + (t & 1) * BUFSZ;
            *(u32x4*)(buf + kkey * KP + kch * 16) = pre[0];
            { unsigned char* vq = buf + KT_BYTES + kkey * VP + kch * 16;
              *(u32x2*)vq = (u32x2){pre[1].x, pre[1].y}; *(u32x2*)(vq + 8) = (u32x2){pre[1].z, pre[1].w}; }
            __syncthreads();
            if (t + 1 < ntile) SWA_LOAD(t + 1);
            const int key0t = SWA_TI(t) * 64, qlo = qb * 128 + rg * 32;
            if (!(t < nloc && (key0t > qlo + 31 + 128 || key0t + 63 < qlo - 128)))
                attn_tile<2>(buf, buf + KT_BYTES, qf, o, l, c1, c2, r, h, t < nloc, qpos - key0t);
        }
#undef SWA_LOAD
#undef SWA_TI
        l += __shfl_xor(l, 32);
        l += __builtin_amdgcn_exp2f((p.swa_sink[head] - mb) * LOG2E);
        const float inv = 1.f / l;
        bf16_t* orow = MIX + (size_t)(cq ? TL + b * CTXL + qpos : b * SEQ + qpos) * DM + 512 + head * 64;
#pragma unroll
        for (int dt = 0; dt < 2; ++dt)
#pragma unroll
            for (int g4 = 0; g4 < 4; ++g4) {
                const int d = 32 * dt + 8 * g4 + 4 * h;
                u32x2 w; w.x = pk2(o[dt][4 * g4] * inv, o[dt][4 * g4 + 1] * inv); w.y = pk2(o[dt][4 * g4 + 2] * inv, o[dt][4 * g4 + 3] * inv);
                *(u32x2*)(orow + d) = w;
            }
        __syncthreads();
    }
}

DI float fma_s(float a, float b, float c) { float r; asm volatile("v_fma_f32 %0, %1, %2, %3" : "=v"(r) : "v"(a), "v"(b), "v"(c)); return r; }
DI void cmad(float& xr, float& xi, float ar, float ai, float br, float bi) {
    const float nr = fma_s(-xi, ai, fma_s(xr, ar, br)), ni = fma_s(xi, ar, fma_s(xr, ai, bi));
    xr = nr; xi = ni;
}
template <bool FWD, int Q> DI void s5_quad(const f32x16& br, const f32x16& bi, float ar, float ai, float& Br, float& Bi) {
    constexpr int i0 = FWD ? 4 * Q : 4 * Q + 3, st = FWD ? 1 : -1;
    Br = br[i0]; Bi = bi[i0];
    cmad(Br, Bi, ar, ai, br[i0 + st], bi[i0 + st]); cmad(Br, Bi, ar, ai, br[i0 + 2 * st], bi[i0 + 2 * st]); cmad(Br, Bi, ar, ai, br[i0 + 3 * st], bi[i0 + 3 * st]);
}
DI void s5_bu(const bf16_t* __restrict__ SBq  , bf16x8 af, int pt, int r, int h, f32x16& bur, f32x16& bui) {
#pragma unroll
    for (int i = 0; i < 16; ++i) { bur[i] = 0.f; bui[i] = 0.f; }
    const bf16_t* bp = SBq + (size_t)(pt * 32 + r) * 16 + 8 * h;
    bur = MFMA32(af, *(const bf16x8*)(bp), bur); bur = MFMA32(af, *(const bf16x8*)(bp + 1024), bur);
    bui = MFMA32(af, *(const bf16x8*)(bp + 2048), bui); bui = MFMA32(af, *(const bf16x8*)(bp + 3072), bui);
    float one; asm volatile("v_mov_b32 %0, 1.0" : "=v"(one));
#pragma unroll
    for (int i = 0; i < 16; ++i) { bur[i] *= one; bui[i] *= one; }
}
DI f32x2* s5_cin(unsigned char* ws, int b, int dir, int g) { return (f32x2*)(ws + (dir ? OFF_V : OFF_K) + SZ_QKV / 4) + (size_t)(b * 32 + g) * 264 * 64; }
DI void s5_chunk(int item, int& b, int& g, int& ck, int& row0) {
    ck = item % 264; g = (item / 264) & 31; b = item / (264 * 32);
    row0 = ck < 8 ? TL + b * CTXL + ck * 32 : b * SEQ + (ck - 8) * 32;
}
DI void s5_passA(const int TID, const Params& p, const bf16_t* __restrict__ Z) {
    const int lane = TID & 63, wave = TID >> 6, r = lane & 31, h = lane >> 5;
    const f32x2* SAp = (const f32x2*)(p.ws + OFF_S5A); const bf16_t* SBp = (const bf16_t*)(p.ws + OFF_S5B); f32x2* ST = (f32x2*)(p.ws + OFF_ST);
    for (int item = blockIdx.x * 8 + wave; item < NB * 32 * 264; item += gridDim.x * 8) {
        int b, g, ck, row0; s5_chunk(item, b, g, ck, row0);
        const bf16x8 af = *(const bf16x8*)(Z + (size_t)(row0 + r) * EVEN_IN + g * 16 + 8 * h);
        static_for<0, 2>([&](auto dc) {
            constexpr int dir = decltype(dc)::value;
            static_for<0, 2>([&](auto pc) {
                constexpr int pt = decltype(pc)::value;
                f32x16 bur, bui;
                s5_bu(SBp + (size_t)(dir * 32 + g) * 4096, af, pt, r, h, bur, bui);
                const f32x2 A = SAp[(dir * 32 + g) * 64 + pt * 32 + r];
                float a2r = A[0] * A[0] - A[1] * A[1], a2i = 2.f * A[0] * A[1];
                const float a4r = a2r * a2r - a2i * a2i, a4i = 2.f * a2r * a2i, a8r = a4r * a4r - a4i * a4i, a8i = 2.f * a4r * a4i;
                float Er = 0.f, Ei = 0.f;
                static_for<0, 4>([&](auto kc) {
                    constexpr int q = dir ? 3 - decltype(kc)::value : decltype(kc)::value;
                    float Br, Bi; s5_quad<dir == 0, q>(bur, bui, A[0], A[1], Br, Bi);
                    const float Pr = __shfl_xor(Br, 32), Pi = __shfl_xor(Bi, 32);
                    const bool own_first = (dir == 0) ? (h == 0) : (h == 1);
                    float fr = own_first ? Br : Pr, fi = own_first ? Bi : Pi; const float sr = own_first ? Pr : Br, si = own_first ? Pi : Bi;
                    cmad(fr, fi, a4r, a4i, sr, si);
                    cmad(Er, Ei, a8r, a8i, fr, fi);
                });
                if (h == 0) ST[((size_t)((b * 2 + dir) * 32 + g) * 264 + ck) * 64 + pt * 32 + r] = (f32x2){Er, Ei};
            });
        });
    }
}
DI void s5_passB(const int TID, const Params& p) {
    const f32x2* SAp = (const f32x2*)(p.ws + OFF_S5A); f32x2* ST = (f32x2*)(p.ws + OFF_ST);
    for (int idx = blockIdx.x * 512 + TID; idx < NB * 2 * 32 * 64; idx += gridDim.x * 512) {
        const int pp = idx & 63, bdg = idx >> 6, dir = (bdg >> 5) & 1;
        const f32x2 A = SAp[(bdg & 63) * 64 + pp];
        float ar = A[0], ai = A[1];
#pragma unroll
        for (int q = 0; q < 5; ++q) { const float nr = ar * ar - ai * ai; ai = 2.f * ar * ai; ar = nr; }
        float sr = 0.f, si = 0.f;
        const f32x2* e0 = ST + (size_t)bdg * 264 * 64 + pp;
        f32x2* c0 = s5_cin(p.ws, bdg >> 6, dir, bdg & 31) + pp;
        for (int v0 = 0; v0 < 264; v0 += 12) {
            f32x2 E[12];
#pragma unroll
            for (int k = 0; k < 12; ++k) { const int v = v0 + k; const int ck = dir == 0 ? v : (v < 8 ? 7 - v : 263 - (v - 8)); E[k] = e0[(size_t)ck * 64]; }
#pragma unroll
            for (int k = 0; k < 12; ++k) {
                const int v = v0 + k; const int ck = dir == 0 ? v : (v < 8 ? 7 - v : 263 - (v - 8));
                c0[(size_t)ck * 64] = (f32x2){sr, si};
                cmad(sr, si, ar, ai, E[k][0], E[k][1]);
            }
        }
    }
}
constexpr int HSP = 272;
DI void s5_passC(const int TID, const Params& p, const bf16_t* __restrict__ Z, bf16_t* __restrict__ G) {
    extern __shared__ __attribute__((aligned(16))) unsigned char smb[];
    const int lane = TID & 63, wave = TID >> 6, r = lane & 31, h = lane >> 5, c16 = lane & 15, kg = lane >> 4;
    unsigned char* Hs = smb + wave * (32 * HSP);
    const f32x2* SAp = (const f32x2*)(p.ws + OFF_S5A); const bf16_t* SBp = (const bf16_t*)(p.ws + OFF_S5B); const bf16_t* SCp = (const bf16_t*)(p.ws + OFF_S5C);
    const f32x2* ST = (const f32x2*)(p.ws + OFF_ST);
    for (int item = blockIdx.x * 8 + wave; item < NB * 32 * 264; item += gridDim.x * 8) {
        int b, g, ck, row0; s5_chunk(item, b, g, ck, row0);
        const bf16x8 af = *(const bf16x8*)(Z + (size_t)(row0 + r) * EVEN_IN + g * 16 + 8 * h);
        f32x4 yacc[2] = {{0.f, 0.f, 0.f, 0.f}, {0.f, 0.f, 0.f, 0.f}};
        static_for<0, 2>([&](auto dc) {
            constexpr int dir = decltype(dc)::value;
            static_for<0, 2>([&](auto pc) {
                constexpr int pt = decltype(pc)::value;
                f32x16 bur, bui;
                s5_bu(SBp + (size_t)(dir * 32 + g) * 4096, af, pt, r, h, bur, bui);
                const f32x2 A = SAp[(dir * 32 + g) * 64 + pt * 32 + r];
                float a2r = A[0] * A[0] - A[1] * A[1], a2i = 2.f * A[0] * A[1];
                const float a4r = a2r * a2r - a2i * a2i, a4i = 2.f * a2r * a2i, a8r = a4r * a4r - a4i * a4i, a8i = 2.f * a4r * a4i;
                const f32x2 cin = s5_cin(p.ws, b, dir, g)[(size_t)ck * 64 + pt * 32 + r];
                float Sr = cin[0], Si = cin[1];
                static_for<0, 4>([&](auto kc) {
                    constexpr int q = dir ? 3 - decltype(kc)::value : decltype(kc)::value;
                    float Br, Bi; s5_quad<dir == 0, q>(bur, bui, A[0], A[1], Br, Bi);
                    const float Pr = __shfl_xor(Br, 32), Pi = __shfl_xor(Bi, 32);
                    const bool own_first = (dir == 0) ? (h == 0) : (h == 1);
                    float er = Sr, ei = Si;
                    if (!own_first) cmad(er, ei, a4r, a4i, Pr, Pi);
                    float fr = own_first ? Br : Pr, fi = own_first ? Bi : Pi; const float sr = own_first ? Pr : Br, si = own_first ? Pi : Bi;
                    cmad(fr, fi, a4r, a4i, sr, si);
                    cmad(Sr, Si, a8r, a8i, fr, fi);
                    static_for<0, 4>([&](auto jc) {
                        constexpr int i = dir ? 4 * q + 3 - decltype(jc)::value : 4 * q + decltype(jc)::value;
                        cmad(er, ei, A[0], A[1], bur[i], bui[i]);
                        *(unsigned*)(Hs + (8 * (i >> 2) + 4 * h + (i & 3)) * HSP + (pt * 32 + r) * 4) = pk2(er, ei);
                    });
                });
            });
            LDS_FENCE();
            const bf16_t* cp = SCp + (size_t)(dir * 32 + g) * 2 * 16 * 128 + (size_t)c16 * 128 + 8 * kg;
#pragma unroll
            for (int tt = 0; tt < 2; ++tt)
#pragma unroll
                for (int ks = 0; ks < 4; ++ks) {
                    const bf16x8 hf = *(const bf16x8*)(Hs + (16 * tt + c16) * HSP + (32 * ks + 8 * kg) * 2);
                    yacc[tt] = __builtin_amdgcn_mfma_f32_16x16x32_bf16(hf, *(const bf16x8*)(cp + 32 * ks), yacc[tt], 0, 0, 0);
                    yacc[tt] = __builtin_amdgcn_mfma_f32_16x16x32_bf16(hf, *(const bf16x8*)(cp + 2048 + 32 * ks), yacc[tt], 0, 0, 0);
                }
            LDS_FENCE();
        });
        const float dsk = p.s5_d[g * 16 + c16];
#pragma unroll
        for (int tt = 0; tt < 2; ++tt)
#pragma unroll
            for (int i = 0; i < 4; ++i) {
                const size_t row = (size_t)row0 + 16 * tt + 4 * kg + i;
                const float u = bf2f(Z[row * EVEN_IN + g * 16 + c16]);
                G[row * 512 + g * 16 + c16] = f2bf(gelu_tanh(yacc[tt][i] + dsk * u));
            }
    }
}

constexpr int WLP = 144;
DI void lru_load_wl(const int TID, const Params& p, int n, unsigned char* WL, float* CW) {
    for (int idx = TID; idx < 4 * 4096; idx += 512) {
        const int mat = idx >> 12, de = idx & 4095, d = de >> 6, e = de & 63, dir = mat >> 1;
        const float* src = (mat & 1) ? p.lru_wx : p.lru_wa;
        *(bf16_t*)(WL + mat * 64 * WLP + e * WLP + d * 2) = f2bf(src[(size_t)(dir * 8 + n) * 4096 + de]);
    }
    for (int idx = TID; idx < 4096; idx += 512) { const int e = idx >> 6, d = idx & 63; *(bf16_t*)(WL + 4 * 64 * WLP + e * WLP + d * 2) = (e == d) ? (bf16_t)0x3F80 : (bf16_t)0; }
    if (TID < 320) { const int k = TID >> 6, d = TID & 63; CW[TID] = k < 4 ? p.lru_conv_w[k * 512 + n * 64 + d] : p.lru_conv_b[n * 64 + d]; }
}
DI void lru_afrag(const bf16_t* __restrict__ zr, int t, int seq_len, const float* CW, int h, bf16x8 (&af)[4]) {
#pragma unroll
    for (int s = 0; s < 4; ++s) {
        const int d0 = 16 * s + 8 * h;
        float x[8];
#pragma unroll
        for (int j = 0; j < 8; ++j) x[j] = CW[256 + d0 + j];
#pragma unroll
        for (int k = 0; k < 4; ++k) {
            const int tt = t + k - 2;
            if (tt >= 0 && tt < seq_len) {
                const u32x4 v = *(const u32x4*)(zr + (size_t)tt * ODD_IN + d0);
                const float* w = CW + k * 64 + d0;
                x[0] += bflo(v.x) * w[0]; x[1] += bfhi(v.x) * w[1]; x[2] += bflo(v.y) * w[2]; x[3] += bfhi(v.y) * w[3];
                x[4] += bflo(v.z) * w[4]; x[5] += bfhi(v.z) * w[5]; x[6] += bflo(v.w) * w[6]; x[7] += bfhi(v.w) * w[7];
            }
        }
        u32x4 w4; w4.x = pk2(x[0], x[1]); w4.y = pk2(x[2], x[3]); w4.z = pk2(x[4], x[5]); w4.w = pk2(x[6], x[7]);
        af[s] = __builtin_bit_cast(bf16x8, w4);
    }
}
DI void lru_pre(const unsigned char* WL, const bf16x8 (&af)[4], int et, int r, int h, f32x16 (&pre)[5]) {
#pragma unroll
    for (int mat = 0; mat < 5; ++mat) {
#pragma unroll
        for (int i = 0; i < 16; ++i) pre[mat][i] = 0.f;
#pragma unroll
        for (int s = 0; s < 4; ++s) pre[mat] = MFMA32(af[s], *(const bf16x8*)(WL + mat * 64 * WLP + (et * 32 + r) * WLP + (16 * s + 8 * h) * 2), pre[mat]);
    }
}
DI void lru_gates(const f32x16& pa, const f32x16& px, const f32x16& xcv, float ba, float bx, float sp, float (&a)[16], float (&bq)[16]) {
#pragma unroll
    for (int i = 0; i < 16; ++i) {
        const float rg = sigmoid_f(pa[i] + ba), gi = sigmoid_f(px[i] + bx);
        const float la = -8.f * rg * sp;
        const float av = __builtin_amdgcn_exp2f(la * LOG2E);
        a[i] = av; bq[i] = __builtin_amdgcn_sqrtf(fmaxf(fmaf(-av, av, 1.f), 0.f)) * (gi * xcv[i]);
    }
}
template <bool FWD, int Q> DI void lru_quad(const float (&a)[16], const float (&bq)[16], float& A, float& B) {
    constexpr int i0 = FWD ? 4 * Q : 4 * Q + 3, st = FWD ? 1 : -1;
    A = a[i0] * a[i0 + st] * a[i0 + 2 * st] * a[i0 + 3 * st];
    B = ((bq[i0] * a[i0 + st] + bq[i0 + st]) * a[i0 + 2 * st] + bq[i0 + 2 * st]) * a[i0 + 3 * st] + bq[i0 + 3 * st];
}
DI void lru_passA(const int TID, const Params& p, const bf16_t* __restrict__ Z) {
    extern __shared__ __attribute__((aligned(16))) unsigned char smb[];
    const int lane = TID & 63, wave = TID >> 6, r = lane & 31, h = lane >> 5;
    unsigned char* WL = smb; float* CW = (float*)(smb + 5 * 64 * WLP);
    f32x2* SUM = (f32x2*)(p.ws + OFF_ST);
    const int n = blockIdx.x & 7;
    __syncthreads();
    lru_load_wl(TID, p, n, WL, CW);
    __syncthreads();
    for (int item = (blockIdx.x >> 3) * 8 + wave; item < NB * 264; item += (gridDim.x >> 3) * 8) {
        asm volatile("" ::: "memory");
        const int b = item / 264, ck = item % 264;
        const int seq_len = ck < 8 ? CTXL : SEQ, t0 = ck < 8 ? ck * 32 : (ck - 8) * 32, rowbase = ck < 8 ? TL + b * CTXL : b * SEQ;
        bf16x8 af[4];
        lru_afrag(Z + (size_t)rowbase * ODD_IN + 512 + n * 64, t0 + r, seq_len, CW, h, af);
        static_for<0, 2>([&](auto etc) {
            constexpr int et = decltype(etc)::value;
            const int ch = n * 64 + et * 32 + r;
            f32x16 pre[5];
            lru_pre(WL, af, et, r, h, pre);
            static_for<0, 2>([&](auto dc) {
                constexpr int dir = decltype(dc)::value;
                float a[16], bq[16];
                lru_gates(pre[2 * dir], pre[2 * dir + 1], pre[4], p.lru_ba[dir * 512 + ch], p.lru_bx[dir * 512 + ch], log1pf(__expf(-p.lru_lam[dir * 512 + ch])), a, bq);
                float P = 1.f, E = 0.f;
                static_for<0, 4>([&](auto kc) {
                    constexpr int q = dir ? 3 - decltype(kc)::value : decltype(kc)::value;
                    float A, B;
                    lru_quad<dir == 0, q>(a, bq, A, B);
                    const float Ap = __shfl_xor(A, 32), Bp = __shfl_xor(B, 32);
                    const bool own_first = (dir == 0) ? (h == 0) : (h == 1);
                    const float fA = own_first ? A : Ap, fB = own_first ? B : Bp, sA = own_first ? Ap : A, sB = own_first ? Bp : B;
                    const float pA = fA * sA, pB = sA * fB + sB;
                    E = pA * E + pB; P *= pA;
                });
                if (h == 0) SUM[((size_t)(b * 2 + dir) * 264 + ck) * 512 + ch] = (f32x2){P, E};
            });
        });
    }
}
DI void lru_passB(const int TID, const Params& p) {
    const f32x2* SUM = (const f32x2*)(p.ws + OFF_ST); float* LC = (float*)(p.ws + OFF_LCIN);
    for (int idx = blockIdx.x * 512 + TID; idx < NB * 2 * 512; idx += gridDim.x * 512) {
        const int ch = idx & 511, bd = idx >> 9, dir = bd & 1;
        float s = 0.f;
        for (int v0 = 0; v0 < 264; v0 += 24) {
            f32x2 pe[24];
#pragma unroll
            for (int k = 0; k < 24; ++k) { const int v = v0 + k; const int ck = dir == 0 ? v : (v < 8 ? 7 - v : 263 - (v - 8)); pe[k] = SUM[((size_t)bd * 264 + ck) * 512 + ch]; }
#pragma unroll
            for (int k = 0; k < 24; ++k) { const int v = v0 + k; const int ck = dir == 0 ? v : (v < 8 ? 7 - v : 263 - (v - 8)); LC[((size_t)bd * 264 + ck) * 512 + ch] = s; s = pe[k][0] * s + pe[k][1]; }
        }
    }
}
DI void lru_passC(const int TID, const Params& p, const bf16_t* __restrict__ Z, bf16_t* __restrict__ MIX) {
    extern __shared__ __attribute__((aligned(16))) unsigned char smb[];
    const int lane = TID & 63, wave = TID >> 6, r = lane & 31, h = lane >> 5;
    unsigned char* WL = smb; float* CW = (float*)(smb + 5 * 64 * WLP);
    const float* LC = (const float*)(p.ws + OFF_LCIN);
    const int n = blockIdx.x & 7;
    __syncthreads();
    lru_load_wl(TID, p, n, WL, CW);
    __syncthreads();
    for (int item = (blockIdx.x >> 3) * 8 + wave; item < NB * 256; item += (gridDim.x >> 3) * 8) {
        asm volatile("" ::: "memory");
        const int b = item >> 8, j = item & 255, ck = 8 + j, t0 = j * 32;
        bf16x8 af[4];
        lru_afrag(Z + (size_t)b * SEQ * ODD_IN + 512 + n * 64, t0 + r, SEQ, CW, h, af);
        static_for<0, 2>([&](auto etc) {
            constexpr int et = decltype(etc)::value;
            const int ch = n * 64 + et * 32 + r;
            f32x16 pre[5];
            lru_pre(WL, af, et, r, h, pre);
            float y[16];
            static_for<0, 2>([&](auto dc) {
                constexpr int dir = decltype(dc)::value;
                float a[16], bq[16];
                lru_gates(pre[2 * dir], pre[2 * dir + 1], pre[4], p.lru_ba[dir * 512 + ch], p.lru_bx[dir * 512 + ch], log1pf(__expf(-p.lru_lam[dir * 512 + ch])), a, bq);
                float S = LC[((size_t)(b * 2 + dir) * 264 + ck) * 512 + ch];
                static_for<0, 4>([&](auto kc) {
                    constexpr int q = dir ? 3 - decltype(kc)::value : decltype(kc)::value;
                    float A, B;
                    lru_quad<dir == 0, q>(a, bq, A, B);
                    const float Ap = __shfl_xor(A, 32), Bp = __shfl_xor(B, 32);
                    const bool own_first = (dir == 0) ? (h == 0) : (h == 1);
                    float s = own_first ? S : Ap * S + Bp;
                    const float fA = own_first ? A : Ap, fB = own_first ? B : Bp, sA = own_first ? Ap : A, sB = own_first ? Bp : B;
                    S = (fA * sA) * S + (sA * fB + sB);
                    static_for<0, 4>([&](auto jc) {
                        constexpr int i = dir ? 4 * q + 3 - decltype(jc)::value : 4 * q + decltype(jc)::value;
                        s = a[i] * s + bq[i];
                        if (dir == 0) y[i] = s; else y[i] += s;
                    });
                });
            });
#pragma unroll
            for (int i = 0; i < 16; ++i) {
                const size_t row = (size_t)b * SEQ + t0 + 8 * (i >> 2) + 4 * h + (i & 3);
                const float gz = bf2f(Z[row * ODD_IN + ch]);
                MIX[row * DM + ch] = f2bf(y[i] * gelu_tanh(gz));
            }
        });
    }
}

constexpr int NPHASE = 26;
#ifndef MK_RPT
#define MK_RPT 0ull
#endif
#define RPT(bit, ...) do { __VA_ARGS__; if ((MK_RPT >> (bit)) & 1ull) { __syncthreads(); __VA_ARGS__; } } while (0)
DI void run_phase(const int TID, const Params& p, int ph) {
    if (ph == 0) { RPT(0, prologue_phase(TID, p)); return; }
    const int l = ph >= 14 ? 1 : 0;
    int s = l ? ph - 13 : ph;
    if (l && s >= 9) s += 1;
    const int rb = 16 * l;
    unsigned char* ws = p.ws;
    float* ctxx = (float*)(ws + OFF_CTXX);
    const float* modl = (const float*)(ws + OFF_MOD) + (size_t)l * 5 * MODW;
    bf16_t* XN = (bf16_t*)(ws + OFF_XN); bf16_t* H = (bf16_t*)(ws + OFF_H); bf16_t* G = (bf16_t*)(ws + OFF_G);
    const bool first = (l == 0 && s <= 3);
    const float* srcL = first ? p.x : p.out; const float* srcC = ctxx;
    (void)srcC;
    const int nrows = (l == 1 && s >= 10) ? TL : TT;
    const int f = s >= 11 ? 1 : 0;
    const bf16_t* W13 = (const bf16_t*)(ws + OFF_W + (size_t)(l * 2 + f) * SZ_FFN);
    const bf16_t* W2 = (const bf16_t*)(ws + OFF_W + (size_t)(l * 2 + f) * SZ_FFN + SZ_W13);
    switch (s) {
    case 1: case 4: case 11: {
        const int gi = s == 1 ? 0 : (s == 4 ? 1 : 2);
        const int nsl = (l == 0 && s == 1) ? 0 : (s == 11 ? 4 : 11);
        normmod_phase(TID, srcL, ctxx, p.norm_g + (size_t)(l * 3 + gi) * DM, modl, 3 * gi, 3 * gi + 1, XN, nrows, (const float*)(ws + OFF_Q), nsl);
    } break;
    case 2: case 12: { EpiSwiglu e{H}; RPT(rb + s, gemm_phase(TID, XN, W13, nrows, 2 * DFF, DM, e)); } break;
    case 3: case 13: case 10: {
        const float* gbase = modl + (s == 3 ? 2 : (s == 13 ? 8 : 5)) * DM; const float coef = s == 10 ? 1.0f : 0.5f;
        EpiResid e{srcL, srcC, p.out, ctxx, gbase, coef};
        EpiPartial ea{(float*)(ws + OFF_Q), gbase + (size_t)4 * MODW, coef};
        const bf16_t* Wo = (const bf16_t*)(ws + (l ? OFF_ODOUT : OFF_EVOUT));
        if (s == 10) { gemm_phase(TID, XN, Wo, TL, DM, DM, e); if (nrows == TT) gemm_phase(TID, XN + (size_t)TL * DM, Wo, TC, DM, DM, ea, 4); }
        else { gemm_phase(TID, H, W2, TL, DM, DFF, e); if (nrows == TT) gemm_phase(TID, H + (size_t)TL * DFF, W2, TC, DM, DFF, ea, 11); }
    } break;
    case 5: {
        EpiStoreBf16 e{H, l ? ODD_IN : EVEN_IN};
        RPT(rb + s, gemm_phase(TID, XN, (const bf16_t*)(ws + (l ? OFF_ODIN : OFF_EVIN)), TT, l ? ODD_IN : EVEN_IN, DM, e));
    } break;
    case 6:
        if (l == 0) { RPT(6, qkv_post_phase(TID, p, H, EVEN_IN, 512, 8, 1024, 2, 1152, 2, 64, p.swa_qk_g, p.swa_qk_g + 64)); __syncthreads(); RPT(14, s5_passA(TID, p, H)); }
        else { RPT(22, qkv_post_phase(TID, p, H, ODD_IN, 1024, 8, 1536, 8, 2048, 4, 128, p.diff_qk_g, p.diff_qk_g + 64)); __syncthreads(); RPT(30, lru_passA(TID, p, H)); }
        break;
    case 7:
        if (l == 0) { s5_passB(TID, p); RPT(7, swa_attn_phase(TID, p, H, XN)); }
        else { lru_passB(TID, p); RPT(23, diff_attn_phase(TID, p, H, XN, 0.8f - 0.6f * 0.74081822068171788f)); }
        break;
    case 8:
        if (l == 0) RPT(8, s5_passC(TID, p, H, G)); else RPT(24, lru_passC(TID, p, H, XN));
        break;
    case 9: { EpiGlu e{G, p.s5_glu_b, XN}; RPT(9, gemm_phase(TID, G, (const bf16_t*)(ws + OFF_GLUW), TT, 512, 512, e)); } break;
    default: break;
    }
}

DI int mk_tid(int wv) { int l; asm volatile("v_mbcnt_lo_u32_b32 %0, -1, 0\n\tv_mbcnt_hi_u32_b32 %0, -1, %0" : "=v"(l)); return wv * 64 + l; }
#define XB_TMO      128
#define XB_XCNT(j)  (256  + 64 * (j))
#define XB_XSUB(j)  (1280 + 64 * (j))
#define XB_XGEN(j)  (2304 + 64 * (j))
#define XB_TOP      3328
#define XB_TOPGEN   3392
#define XCD_BAR_WORDS 3456
#define XB_SPIN_CAP (1u << 22)
#define LAS __attribute__((address_space(3)))
DI unsigned xb_ld(unsigned* p) { return __hip_atomic_load(p, __ATOMIC_RELAXED, __HIP_MEMORY_SCOPE_AGENT); }
DI unsigned xb_add(unsigned* p, unsigned v) { return __hip_atomic_fetch_add(p, v, __ATOMIC_RELAXED, __HIP_MEMORY_SCOPE_AGENT); }
DI unsigned xb_xcc_id() { return (unsigned)__builtin_amdgcn_s_getreg((3 << 11) | 20) & 0xFu; }
#define XB_SPIN(cond, bar) do { unsigned _sp = 0; while (cond) { __builtin_amdgcn_s_sleep(1); \
    if ((++_sp & 255u) == 0u) { if (xb_ld(&(bar)[XB_TMO])) break; if (_sp > XB_SPIN_CAP) { atomicAdd(&(bar)[XB_TMO], 1u); break; } } } } while (0)
DI void xcd_barrier_complete(unsigned* bar, unsigned x, unsigned& nloc, unsigned& nx) {
    const unsigned G = gridDim.x;
    unsigned sum, cnt, mine, sp = 0u;
    for (;;) {
        sum = 0u; cnt = 0u; mine = 0u;
#pragma unroll
        for (unsigned j = 0; j < 16; ++j) { const unsigned c = xb_ld(&bar[XB_XCNT(j)]); sum += c; cnt += (c > 0u) ? 1u : 0u; mine = (j == x) ? c : mine; }
        if (sum == G) break;
        __builtin_amdgcn_s_sleep(1);
        if ((++sp & 255u) == 0u) { if (xb_ld(&bar[XB_TMO])) break; if (sp > XB_SPIN_CAP) { atomicAdd(&bar[XB_TMO], 1u); break; } }
    }
    nloc = mine > 0u ? mine : 1u; nx = cnt > 0u ? cnt : 1u;
}
DI void xcd_barrier(unsigned* bar, int tid) {
    extern __shared__ __attribute__((aligned(16))) unsigned char smx[];
    volatile LAS unsigned* st = (volatile LAS unsigned*)(smx + 131072);
    asm volatile("s_waitcnt vmcnt(0)" ::: "memory");
    __syncthreads();
    if (tid == 0) {
        const unsigned x = xb_xcc_id();
        __builtin_amdgcn_s_waitcnt(0);
        unsigned nloc = st[0], nx = st[1];
        if (nloc == 0u) { xcd_barrier_complete(bar, x, nloc, nx); st[0] = nloc; st[1] = nx; }
        const unsigned old = xb_add(&bar[XB_XSUB(x)], 1u);
        const unsigned gen = old / nloc;
        if (old + 1u == (gen + 1u) * nloc) {
            __builtin_amdgcn_fence(__ATOMIC_RELEASE, "agent");
            asm volatile("s_waitcnt vmcnt(0)" ::: "memory");
            const unsigned og = xb_add(&bar[XB_TOP], 1u);
            const unsigned tg = og / nx;
            if (og + 1u == (tg + 1u) * nx) xb_add(&bar[XB_TOPGEN], 1u);
            else XB_SPIN(xb_ld(&bar[XB_TOPGEN]) == tg, bar);
            __builtin_amdgcn_fence(__ATOMIC_ACQUIRE, "agent");
            xb_add(&bar[XB_XGEN(x)], 1u);
            asm volatile("s_waitcnt vmcnt(0)" ::: "memory");
        } else {
            XB_SPIN(xb_ld(&bar[XB_XGEN(x)]) == gen, bar);
            __builtin_amdgcn_fence(__ATOMIC_ACQUIRE, "agent");
            asm volatile("s_waitcnt vmcnt(0)" ::: "memory");
        }
    }
    __syncthreads();
}
template <int K>
DI void run_all(const int wv, const Params& p, int lo, int hi) {
    if constexpr (K < NPHASE) {
        if (K >= lo && K < hi) {
            const int tid = mk_tid(wv);
            run_phase(tid, p, K);
            if (K + 1 < hi) { xcd_barrier((unsigned*)(p.ws + OFF_BAR), tid); if ((MK_RPT >> 63) & 1ull) xcd_barrier((unsigned*)(p.ws + OFF_BAR), tid); }
        }
        run_all<K + 1>(wv, p, lo, hi);
    }
}
__global__ void __launch_bounds__(512) mega_fwd(Params p, int ph_lo, int ph_hi) {
    const int wv = __builtin_amdgcn_readfirstlane((int)(threadIdx.x >> 6));
    {
        extern __shared__ __attribute__((aligned(16))) unsigned char smx[];
        if (threadIdx.x == 0) { *(u32x4*)(smx + 131072) = (u32x4){0u, 0u, 0u, 0u}; (void)xb_add((unsigned*)(p.ws + OFF_BAR) + XB_XCNT(xb_xcc_id()), 1u); }
        __syncthreads();
    }
    if (ph_hi - ph_lo > 1) cg::this_grid().sync();
    run_all<0>(wv, p, ph_lo, ph_hi);
}

#ifndef MK_MULTI
#define MK_MULTI 0
#endif
extern "C" void kernel_launch(void* const* d_in, const int* in_sizes, int n_in, void* d_out, int out_size, void* d_ws, size_t ws_size, hipStream_t stream) {
    static int grid = 0;
    if (grid == 0) {
        if (n_in != 37 || in_sizes[0] != TL * DM || out_size != TL * DM || ws_size < WS_END) {
            fprintf(stderr, "kernel_launch: unexpected problem: n_in %d in0 %d out %d ws %zu (need %zu)\n", n_in, n_in > 0 ? in_sizes[0] : -1, out_size, ws_size, (size_t)WS_END);
            grid = -1; return;
        }
        int dev = 0, cus = 0, per_cu = 0;
        (void)hipGetDevice(&dev);
        (void)hipDeviceGetAttribute(&cus, hipDeviceAttributeMultiprocessorCount, dev);
        if (hipFuncSetAttribute((const void*)mega_fwd, hipFuncAttributeMaxDynamicSharedMemorySize, LDS_BYTES) != hipSuccess) { fprintf(stderr, "kernel_launch: hipFuncSetAttribute failed\n"); grid = -1; return; }
        (void)hipOccupancyMaxActiveBlocksPerMultiprocessor(&per_cu, (const void*)mega_fwd, 512, LDS_BYTES);
        if (per_cu < 1) { fprintf(stderr, "kernel_launch: occupancy query says %d blocks per CU\n", per_cu); per_cu = 1; }
        (void)hipGetLastError();
        grid = cus * per_cu;
    }
    if (grid < 0) return;
    if (hipMemsetAsync((unsigned char*)d_ws + OFF_BAR, 0, 16384, stream) != hipSuccess) { fprintf(stderr, "kernel_launch: memset failed\n"); return; }
    Params p{};
    const float** pp = (const float**)&p;
    for (int i = 0; i < 37; ++i) pp[i] = (const float*)d_in[i];
    p.out = (float*)d_out; p.ws = (unsigned char*)d_ws;
#if MK_MULTI
    for (int ph = 0; ph < NPHASE; ++ph) hipLaunchKernelGGL(mega_fwd, dim3(grid), dim3(512), LDS_BYTES, stream, p, ph, ph + 1);
#else
    int lo = 0, hi = NPHASE;
    void* args[] = {&p, &lo, &hi};
    hipError_t e = hipLaunchCooperativeKernel((const void*)mega_fwd, dim3(grid), dim3(512), args, LDS_BYTES, stream);
    if (e != hipSuccess) fprintf(stderr, "kernel_launch: cooperative launch failed: %s (grid %d)\n", hipGetErrorString(e), grid);
#endif
}
```

```cpp
#include <hip/hip_runtime.h>
#include <hip/hip_cooperative_groups.h>
#include <cstdio>
#include <cstdint>
namespace cg = cooperative_groups;

#define DI __device__ __forceinline__
typedef unsigned short bf16_t;
typedef short bf16x8 __attribute__((ext_vector_type(8)));
typedef short s16x4 __attribute__((ext_vector_type(4)));
typedef float f32x2 __attribute__((ext_vector_type(2)));
typedef float f32x4 __attribute__((ext_vector_type(4)));
typedef float f32x16 __attribute__((ext_vector_type(16)));
typedef unsigned u32x2 __attribute__((ext_vector_type(2)));
typedef unsigned u32x4 __attribute__((ext_vector_type(4)));
typedef __bf16 bf16x2_t __attribute__((ext_vector_type(2)));

constexpr int DM = 1024, NB = 4, SEQ = 8192, CTXL = 256, TL = NB * SEQ, TC = NB * CTXL, TT = TL + TC, DFF = 2816, KEYS = SEQ + CTXL;
constexpr int NMOD = 9, MODW = NMOD * DM;
constexpr int EVEN_IN = 1280, ODD_IN = 2560;
constexpr float EPSN = 1e-6f;
constexpr float LOG2E = 1.4426950408889634f;

constexpr size_t SZ_W13 = (size_t)2 * DFF * DM * 2, SZ_W2 = (size_t)DM * DFF * 2, SZ_FFN = SZ_W13 + SZ_W2;
constexpr size_t OFF_W = 0;
constexpr size_t OFF_EVIN = OFF_W + 4 * SZ_FFN;
constexpr size_t OFF_EVOUT = OFF_EVIN + (size_t)EVEN_IN * DM * 2;
constexpr size_t OFF_GLUW = OFF_EVOUT + (size_t)DM * DM * 2;
constexpr size_t OFF_ODIN = OFF_GLUW + (size_t)512 * 512 * 2;
constexpr size_t OFF_ODOUT = OFF_ODIN + (size_t)ODD_IN * DM * 2;
constexpr size_t OFF_XN = OFF_ODOUT + (size_t)DM * DM * 2;
constexpr size_t OFF_H = OFF_XN + (size_t)TT * DM * 2;
constexpr size_t OFF_CTXX = OFF_H + (size_t)TT * DFF * 2;
constexpr size_t OFF_MOD = OFF_CTXX + (size_t)TC * DM * 4;
constexpr size_t OFF_ROPE = OFF_MOD + (size_t)2 * 5 * MODW * 4;
constexpr size_t OFF_S5A = OFF_ROPE + (size_t)SEQ * 32 * 8;
constexpr size_t OFF_S5B = OFF_S5A + (size_t)2 * 32 * 64 * 8;
constexpr size_t OFF_Q = OFF_S5B + (size_t)2 * 32 * 64 * 16 * 8;
constexpr size_t SZ_QKV = (size_t)NB * 8 * KEYS * 64 * 2;
constexpr size_t OFF_K = OFF_Q + SZ_QKV;
constexpr size_t OFF_V = OFF_K + SZ_QKV;
constexpr size_t OFF_G = OFF_V + SZ_QKV;
constexpr size_t OFF_ST = OFF_G + (size_t)TT * 512 * 2;
constexpr size_t SZ_ST = (size_t)NB * 2 * 32 * 264 * 64 * 8;
constexpr size_t OFF_LCIN = OFF_ST + (size_t)NB * 2 * 264 * 512 * 8;
constexpr size_t OFF_BAR = OFF_ST + SZ_ST;
constexpr size_t OFF_S5C = OFF_BAR + 16384;
constexpr size_t WS_END = OFF_S5C + (size_t)2 * 32 * 2 * 16 * 128 * 2;
static_assert(OFF_LCIN + (size_t)NB * 2 * 264 * 512 * 4 <= OFF_BAR, "lru regions");
static_assert(SZ_QKV / 4 + (size_t)NB * 32 * 264 * 64 * 8 <= SZ_QKV, "s5 carry-in regions");
constexpr int LDS_BYTES = 131072 + 16;

struct Params {
    const float *x, *c, *ctx, *c_ctx, *mod_w, *mod_b, *norm_g, *ffn1_w13, *ffn1_w2, *ffn2_w13, *ffn2_w2, *ev_w_in, *ev_w_out;
    const float *s5_lam_re, *s5_lam_im, *s5_log_dt, *s5_b_re, *s5_b_im, *s5_c_re, *s5_c_im, *s5_d, *s5_glu_w, *s5_glu_b, *swa_qk_g, *swa_sink;
    const float *od_w_in, *od_w_out, *lru_conv_w, *lru_conv_b, *lru_wa, *lru_ba, *lru_wx, *lru_bx, *lru_lam, *diff_qk_g, *diff_lam, *diff_sub_g;
    float* out;
    unsigned char* ws;
};

DI unsigned pk2(float lo, float hi) { f32x2 v = {lo, hi}; bf16x2_t r = __builtin_convertvector(v, bf16x2_t); return __builtin_bit_cast(unsigned, r); }
DI bf16_t f2bf(float x) { return (bf16_t)(pk2(x, 0.f) & 0xffffu); }
DI float bf2f(bf16_t v) { return __uint_as_float((unsigned)v << 16); }
DI float bflo(unsigned w) { return __uint_as_float(w << 16); }
DI float bfhi(unsigned w) { return __uint_as_float(w & 0xffff0000u); }
DI float wave_sum(float v) {
#pragma unroll
    for (int o = 32; o; o >>= 1) v += __shfl_xor(v, o);
    return v;
}
DI float wave_max(float v) {
#pragma unroll
    for (int o = 32; o; o >>= 1) v = fmaxf(v, __shfl_xor(v, o));
    return v;
}
DI float sigmoid_f(float x) { return __builtin_amdgcn_rcpf(1.f + __builtin_amdgcn_exp2f(-LOG2E * x)); }
DI float silu_f(float x) { return x * sigmoid_f(x); }
DI float gelu_tanh(float x) { const float u = 0.7978845608028654f * (x + 0.044715f * x * x * x); return x * sigmoid_f(2.f * u); }
#define LDS_FENCE() asm volatile("s_waitcnt lgkmcnt(0)" ::: "memory")
template <int V> struct IC { static constexpr int value = V; };
template <int I, int N, class F> DI void static_for(F&& f) { if constexpr (I < N) { f(IC<I>{}); static_for<I + 1, N>(f); } }

constexpr int BM = 256, BK = 64, HALF = 128, HT = HALF * BK, NXCD = 8, WGM = 8;
DI int lds_byte(int r, int c) { int st = (r >> 4) * 2 + (c >> 5), rr = r & 15, cc = c & 31, ob = rr * 64 + cc * 2; return st * 1024 + (ob ^ (((ob >> 9) & 1) << 5)); }
DI void stage_rc(int b, int& R, int& C) { int st = b / 1024, sb = b % 1024, swz = sb ^ (((sb >> 9) & 1) << 5); R = (st >> 1) * 16 + swz / 64; C = (st & 1) * 32 + (swz % 64) / 2; }

template <class Epi>
DI void gemm_phase(const int TID, const bf16_t* __restrict__ A, const bf16_t* __restrict__ Bt, int M, int N, int K, const Epi& epi, const int S = 1) {
    extern __shared__ __attribute__((aligned(16))) bf16_t shm[];
    int tidx = TID; asm volatile("" : "+v"(tidx));
#define SA(b, h) (shm + ((b) * 2 + (h)) * HT)
#define SB(b, h) (shm + (4 + (b) * 2 + (h)) * HT)
#define STAGE(P, BASE, br, kt) do { const char* _ub = (const char*)(BASE) + ((long)(br) * K + (long)((kt) + kbase) * BK) * 2; \
      __builtin_amdgcn_global_load_lds((const unsigned*)(_ub + voff0), (unsigned*)((char*)(P) + wv_s * 1024), 16, 0, 0); \
      __builtin_amdgcn_global_load_lds((const unsigned*)(_ub + voff1), (unsigned*)((char*)(P) + wv_s * 1024 + 8192), 16, 0, 0); } while (0)
#define LDA(dst, b, h) for (int m = 0; m < 4; ++m) for (int k = 0; k < 2; ++k) \
    dst[m][k] = *reinterpret_cast<const bf16x8*>((char*)SA(b, h) + lds_byte(wr * 64 + m * 16 + fr, k * 32 + fq * 8))
#define LDB(dst, b, h) for (int n = 0; n < 2; ++n) for (int k = 0; k < 2; ++k) \
    dst[n][k] = *reinterpret_cast<const bf16x8*>((char*)SB(b, h) + lds_byte(wc * 32 + n * 16 + fr, k * 32 + fq * 8))
#define MMA(ai, bj, At_, Bt_) do { __builtin_amdgcn_s_setprio(1); \
    for (int m = 0; m < 4; ++m) for (int n = 0; n < 2; ++n) for (int k = 0; k < 2; ++k) \
      acc[ai][bj][m][n] = __builtin_amdgcn_mfma_f32_16x16x32_bf16(Bt_[n][k], At_[m][k], acc[ai][bj][m][n], 0, 0, 0); \
    __builtin_amdgcn_s_setprio(0); } while (0)
#define WAIT_V(n) asm volatile("s_waitcnt vmcnt(" #n ")" ::: "memory")
#define WAIT_L(n) asm volatile("s_waitcnt lgkmcnt(" #n ")" ::: "memory")
#define BAR __builtin_amdgcn_s_barrier()
#define SCHED __builtin_amdgcn_sched_barrier(0)
    const int nM = M / BM, nN = N / BM, ntile = nM * nN, nwg = ntile * S;
    const int wid = tidx >> 6, lane = tidx & 63, wr = wid >> 2, wc = wid & 3, fr = lane & 15, fq = lane >> 4;
    const int nt = K / BK / S;
    const int wv_s = __builtin_amdgcn_readfirstlane(tidx >> 6);
    unsigned voff0, voff1;
    { int r_, c_; stage_rc(tidx * 16, r_, c_); voff0 = (unsigned)(r_ * K + c_) * 2u; stage_rc(tidx * 16 + 8192, r_, c_); voff1 = (unsigned)(r_ * K + c_) * 2u; }
#define TILE_COORDS(L_, pm_, pn_, kb_) do { int wgid = (int)(L_); \
        if (S == 1) { const int q = nwg / NXCD, r = nwg % NXCD, xcd = wgid % NXCD, off = wgid / NXCD; wgid = (xcd < r ? xcd * (q + 1) : r * (q + 1) + (xcd - r) * q) + off; kb_ = 0; } \
        else { kb_ = (wgid % S) * nt; wgid /= S; } \
        const int nig = WGM * nN, gid = wgid / nig, fm = gid * WGM, gsz = min(nM - fm, WGM); \
        pm_ = fm + ((wgid % nig) % gsz); pn_ = (wgid % nig) / gsz; } while (0)
#define STAGE_P1(brow_, bcol_) do { STAGE(SB(0, 0), Bt, bcol_, 0); STAGE(SA(0, 0), A, brow_, 0); STAGE(SB(0, 1), Bt, (bcol_) + HALF, 0); STAGE(SA(0, 1), A, (brow_) + HALF, 0); } while (0)
    long L = blockIdx.x;
    if (L >= nwg) return;
    int pm, pn, kbase;
    TILE_COORDS(L, pm, pn, kbase);
    STAGE_P1(pm * BM, pn * BM);
    for (;;) {
        const int brow = pm * BM, bcol = pn * BM;
        f32x4 acc[2][2][4][2] = {};
        bf16x8 At[4][2], B0[2][2], B1[2][2];
        if (wr == 1) BAR;
        WAIT_V(0); BAR;
        STAGE(SB(1, 0), Bt, bcol, 1); STAGE(SA(1, 0), A, brow, 1); STAGE(SB(1, 1), Bt, bcol + HALF, 1);
        WAIT_V(6); BAR;
        for (int t = 0; t < nt - 2; t += 2) {
            LDB(B0, 0, 0); SCHED; LDA(At, 0, 0); STAGE(SA(1, 1), A, brow + HALF, t + 1);
            WAIT_L(8); BAR; WAIT_L(0); MMA(0, 0, At, B0); BAR; SCHED;
            LDB(B1, 0, 1); STAGE(SB(0, 0), Bt, bcol, t + 2);
            BAR; WAIT_L(0); MMA(0, 1, At, B1); BAR;
            LDA(At, 0, 1); STAGE(SA(0, 0), A, brow, t + 2);
            BAR; WAIT_L(0); MMA(1, 0, At, B0); BAR; SCHED;
            STAGE(SB(0, 1), Bt, bcol + HALF, t + 2);
            WAIT_V(6); BAR; MMA(1, 1, At, B1); BAR;
            LDB(B0, 1, 0); SCHED; LDA(At, 1, 0); STAGE(SA(0, 1), A, brow + HALF, t + 2);
            WAIT_L(8); BAR; WAIT_L(0); MMA(0, 0, At, B0); BAR; SCHED;
            LDB(B1, 1, 1); STAGE(SB(1, 0), Bt, bcol, t + 3);
            BAR; WAIT_L(0); MMA(0, 1, At, B1); BAR;
            LDA(At, 1, 1); STAGE(SA(1, 0), A, brow, t + 3);
            BAR; WAIT_L(0); MMA(1, 0, At, B0); BAR; SCHED;
            STAGE(SB(1, 1), Bt, bcol + HALF, t + 3);
            WAIT_V(6); BAR; MMA(1, 1, At, B1); BAR;
        }
        { LDB(B0, 0, 0); LDA(At, 0, 0); STAGE(SA(1, 1), A, brow + HALF, nt - 1);
          BAR; WAIT_L(0); MMA(0, 0, At, B0); BAR;
          LDB(B1, 0, 1); BAR; WAIT_L(0); MMA(0, 1, At, B1); BAR;
          LDA(At, 0, 1); WAIT_V(4); BAR; WAIT_L(0); MMA(1, 0, At, B0); MMA(1, 1, At, B1); BAR; }
        { LDB(B0, 1, 0); LDA(At, 1, 0); WAIT_V(2); BAR; WAIT_L(0); MMA(0, 0, At, B0); BAR;
          LDB(B1, 1, 1); WAIT_V(0); BAR; WAIT_L(0); MMA(0, 1, At, B1); BAR;
          LDA(At, 1, 1); BAR; WAIT_L(0); MMA(1, 0, At, B0); MMA(1, 1, At, B1); BAR; }
        if (wr == 0) BAR;
        const int kbase_cur = kbase;
        L += gridDim.x;
        const bool has_next = L < nwg;
        int pm_n = 0, pn_n = 0, kb_n = 0;
        if (has_next) { TILE_COORDS(L, pm_n, pn_n, kb_n); kbase = kb_n; STAGE_P1(pm_n * BM, pn_n * BM); }
        asm volatile("" ::: "memory"); SCHED;
        { int t2 = TID; asm volatile("" : "+v"(t2));
          int pm2 = S == 1 ? pm : pm + (kbase_cur / nt) * nM, pn2 = pn; asm volatile("" : "+s"(pm2), "+s"(pn2));
          epi(acc, pm2, pn2, t2 >> 8, (t2 >> 6) & 3, t2 & 15, (t2 & 63) >> 4); }
        asm volatile("" ::: "memory"); SCHED;
        if (!has_next) break;
        pm = pm_n; pn = pn_n;
    }
#undef TILE_COORDS
#undef STAGE_P1
#undef SA
#undef SB
#undef STAGE
#undef LDA
#undef LDB
#undef MMA
}

struct EpiSwiglu {
    bf16_t* H;
    DI void operator()(const f32x4 (&acc)[2][2][4][2], int pm, int pn, int wr, int wc, int fr, int fq) const {
#pragma unroll
        for (int ai = 0; ai < 2; ++ai)
#pragma unroll
            for (int m = 0; m < 4; ++m) {
                const size_t row = (size_t)pm * BM + ai * HALF + wr * 64 + m * 16 + fr;
#pragma unroll
                for (int bj = 0; bj < 2; ++bj) {
                    const int hc = (pn * BM + bj * HALF + wc * 32) / 2 + 4 * fq;
                    const f32x4 g = acc[ai][bj][m][0], u = acc[ai][bj][m][1];
                    u32x2 w; w.x = pk2(silu_f(g[0]) * u[0], silu_f(g[1]) * u[1]); w.y = pk2(silu_f(g[2]) * u[2], silu_f(g[3]) * u[3]);
                    *(u32x2*)(H + row * DFF + hc) = w;
                }
            }
    }
};
struct EpiResid {
    const float *srcL, *srcC; float *dstL, *dstC; const float* gate  ; float coef;
    DI void operator()(const f32x4 (&acc)[2][2][4][2], int pm, int pn, int wr, int wc, int fr, int fq) const {
        const int row0 = pm * BM;
        const bool lat = row0 < TL;
        const float* src = lat ? srcL : srcC - (size_t)TL * DM;
        float* dst = lat ? dstL : dstC - (size_t)TL * DM;
        const int v = lat ? row0 / SEQ : 4;
        const int col0 = pn * BM + wc * 32 + 4 * fq;
        const float* gv = gate + (size_t)v * MODW + col0;
        f32x4 gt[2][2];
#pragma unroll
        for (int bj = 0; bj < 2; ++bj)
#pragma unroll
            for (int n = 0; n < 2; ++n) gt[bj][n] = *(const f32x4*)(gv + bj * HALF + n * 16) * coef;
#pragma unroll
        for (int ai = 0; ai < 2; ++ai)
#pragma unroll
            for (int m = 0; m < 4; ++m) {
                const size_t off = (size_t)(row0 + ai * HALF + wr * 64 + m * 16 + fr) * DM + col0;
                const float* sp = src + off; float* dp = dst + off;
                f32x4 s[2][2];
#pragma unroll
                for (int bj = 0; bj < 2; ++bj)
#pragma unroll
                    for (int n = 0; n < 2; ++n) s[bj][n] = *(const f32x4*)(sp + bj * HALF + n * 16);
#pragma unroll
                for (int bj = 0; bj < 2; ++bj)
#pragma unroll
                    for (int n = 0; n < 2; ++n) *(f32x4*)(dp + bj * HALF + n * 16) = s[bj][n] + gt[bj][n] * acc[ai][bj][m][n];
                asm volatile("" ::: "memory");
            }
    }
};
struct EpiPartial {
    float* part; const float* gate; float coef;
    DI void operator()(const f32x4 (&acc)[2][2][4][2], int pm, int pn, int wr, int wc, int fr, int fq) const {
        const int col0 = pn * BM + wc * 32 + 4 * fq;
        f32x4 gt[2][2];
#pragma unroll
        for (int bj = 0; bj < 2; ++bj)
#pragma unroll
            for (int n = 0; n < 2; ++n) gt[bj][n] = *(const f32x4*)(gate + col0 + bj * HALF + n * 16) * coef;
#pragma unroll
        for (int ai = 0; ai < 2; ++ai)
#pragma unroll
            for (int m = 0; m < 4; ++m) {
                float* dp = part + (size_t)(pm * BM + ai * HALF + wr * 64 + m * 16 + fr) * DM + col0;
#pragma unroll
                for (int bj = 0; bj < 2; ++bj)
#pragma unroll
                    for (int n = 0; n < 2; ++n) *(f32x4*)(dp + bj * HALF + n * 16) = gt[bj][n] * acc[ai][bj][m][n];
                asm volatile("" ::: "memory");
            }
    }
};
struct EpiStoreBf16 {
    bf16_t* Z; int ldz;
    DI void operator()(const f32x4 (&acc)[2][2][4][2], int pm, int pn, int wr, int wc, int fr, int fq) const {
#pragma unroll
        for (int ai = 0; ai < 2; ++ai)
#pragma unroll
            for (int m = 0; m < 4; ++m) {
                const size_t row = (size_t)pm * BM + ai * HALF + wr * 64 + m * 16 + fr;
#pragma unroll
                for (int bj = 0; bj < 2; ++bj)
#pragma unroll
                    for (int n = 0; n < 2; ++n) {
                        const int col = pn * BM + bj * HALF + wc * 32 + n * 16 + 4 * fq;
                        const f32x4 a = acc[ai][bj][m][n];
                        u32x2 w; w.x = pk2(a[0], a[1]); w.y = pk2(a[2], a[3]);
                        *(u32x2*)(Z + row * ldz + col) = w;
                    }
            }
    }
};
struct EpiGlu {
    const bf16_t* G; const float* bias; bf16_t* MIX;
    DI void operator()(const f32x4 (&acc)[2][2][4][2], int pm, int pn, int wr, int wc, int fr, int fq) const {
        const int col0 = pn * BM + wc * 32 + 4 * fq;
        f32x4 bv[2][2];
#pragma unroll
        for (int bj = 0; bj < 2; ++bj)
#pragma unroll
            for (int n = 0; n < 2; ++n) bv[bj][n] = *(const f32x4*)(bias + col0 + bj * HALF + n * 16);
#pragma unroll
        for (int ai = 0; ai < 2; ++ai)
#pragma unroll
            for (int m = 0; m < 4; ++m) {
                const size_t row = (size_t)pm * BM + ai * HALF + wr * 64 + m * 16 + fr;
                const bf16_t* gp = G + row * 512 + col0; bf16_t* mp = MIX + row * DM + col0;
#pragma unroll
                for (int bj = 0; bj < 2; ++bj)
#pragma unroll
                    for (int n = 0; n < 2; ++n) {
                        const u32x2 gw = *(const u32x2*)(gp + bj * HALF + n * 16);
                        const f32x4 a = acc[ai][bj][m][n] + bv[bj][n];
                        u32x2 w; w.x = pk2(bflo(gw.x) * sigmoid_f(a[0]), bfhi(gw.x) * sigmoid_f(a[1])); w.y = pk2(bflo(gw.y) * sigmoid_f(a[2]), bfhi(gw.y) * sigmoid_f(a[3]));
                        *(u32x2*)(mp + bj * HALF + n * 16) = w;
                    }
                asm volatile("" ::: "memory");
            }
    }
};

DI void transpose_item(const float* __restrict__ W, int K, int N, bf16_t* __restrict__ WT, int mode, float* scr, int item, int lane) {
    const int nblk = N / 32, kb = item / nblk, nb = item % nblk, k0 = 64 * kb, n0 = 32 * nb;
#pragma unroll 8
    for (int i = 0; i < 32; ++i) { const int kk = 2 * i + (lane >> 5); scr[kk * 33 + (lane & 31)] = W[(size_t)(k0 + kk) * N + n0 + (lane & 31)]; }
    LDS_FENCE();
    const int c = lane & 7;
#pragma unroll
    for (int j = 0; j < 4; ++j) {
        const int n = (lane >> 3) + 8 * j; const float* s = scr + (8 * c) * 33 + n;
        u32x4 o; o.x = pk2(s[0 * 33], s[1 * 33]); o.y = pk2(s[2 * 33], s[3 * 33]); o.z = pk2(s[4 * 33], s[5 * 33]); o.w = pk2(s[6 * 33], s[7 * 33]);
        const int nn = n0 + n;
        int row = nn;
        if (mode == 1) { const int jj = nn < DFF ? nn : nn - DFF; row = (jj >> 4) * 32 + (jj & 15) + (nn < DFF ? 0 : 16); }
        *(u32x4*)(WT + (size_t)row * K + k0 + 8 * c) = o;
    }
    LDS_FENCE();
}

DI void prologue_phase(const int TID, const Params& p) {
    extern __shared__ __attribute__((aligned(16))) float shf[];
    const int tid = TID, lane = tid & 63, wave = tid >> 6;
    unsigned char* ws = p.ws;
    {
        float* scr = shf + wave * (64 * 33);
        const int gw = blockIdx.x * 8 + wave, ngw = gridDim.x * 8;
        constexpr int I13 = (DM / 64) * (2 * DFF / 32), I2 = (DFF / 64) * (DM / 32);
        constexpr int IEI = (DM / 64) * (EVEN_IN / 32), IEO = (DM / 64) * (DM / 32), IGL = (512 / 64) * (512 / 32), IOI = (DM / 64) * (ODD_IN / 32), IOO = IEO;
        constexpr int NIT = 4 * (I13 + I2) + IEI + IEO + IGL + IOI + IOO;
        for (int it = gw; it < NIT; it += ngw) {
            int r = it;
            if (r < 4 * (I13 + I2)) {
                const int lf = r / (I13 + I2); r -= lf * (I13 + I2);
                const int l = lf >> 1, f = lf & 1;
                bf16_t* base = (bf16_t*)(ws + OFF_W + (size_t)lf * SZ_FFN);
                if (r < I13) transpose_item((f ? p.ffn2_w13 : p.ffn1_w13) + (size_t)l * DM * 2 * DFF, DM, 2 * DFF, base, 1, scr, r, lane);
                else transpose_item((f ? p.ffn2_w2 : p.ffn1_w2) + (size_t)l * DFF * DM, DFF, DM, (bf16_t*)((unsigned char*)base + SZ_W13), 0, scr, r - I13, lane);
                continue;
            }
            r -= 4 * (I13 + I2);
            if (r < IEI) { transpose_item(p.ev_w_in, DM, EVEN_IN, (bf16_t*)(ws + OFF_EVIN), 0, scr, r, lane); continue; } r -= IEI;
            if (r < IEO) { transpose_item(p.ev_w_out, DM, DM, (bf16_t*)(ws + OFF_EVOUT), 0, scr, r, lane); continue; } r -= IEO;
            if (r < IGL) { transpose_item(p.s5_glu_w, 512, 512, (bf16_t*)(ws + OFF_GLUW), 0, scr, r, lane); continue; } r -= IGL;
            if (r < IOI) { transpose_item(p.od_w_in, DM, ODD_IN, (bf16_t*)(ws + OFF_ODIN), 0, scr, r, lane); continue; } r -= IOI;
            transpose_item(p.od_w_out, DM, DM, (bf16_t*)(ws + OFF_ODOUT), 0, scr, r, lane);
        }
    }
    __syncthreads();
    {
        float* red = shf;
        float* sl = shf + 8 * 5 * 64;
        for (int idx = tid; idx < 5 * DM; idx += 512) { const int v = idx >> 10, k = idx & (DM - 1); sl[idx] = silu_f(v < 4 ? p.c[v * DM + k] : p.c_ctx[k]); }
        __syncthreads();
        float* MOD = (float*)(ws + OFF_MOD);
        for (int item = blockIdx.x; item < 2 * (MODW / 64); item += gridDim.x) {
            const int i = item / (MODW / 64), col = (item % (MODW / 64)) * 64 + lane;
            const float* W = p.mod_w + (size_t)i * DM * MODW + col;
            float a0 = 0.f, a1 = 0.f, a2 = 0.f, a3 = 0.f, a4 = 0.f;
            for (int k = wave * 128; k < wave * 128 + 128; ++k) {
                const float w = W[(size_t)k * MODW];
                a0 += sl[k] * w; a1 += sl[DM + k] * w; a2 += sl[2 * DM + k] * w; a3 += sl[3 * DM + k] * w; a4 += sl[4 * DM + k] * w;
            }
            __syncthreads();
            red[(wave * 5 + 0) * 64 + lane] = a0; red[(wave * 5 + 1) * 64 + lane] = a1; red[(wave * 5 + 2) * 64 + lane] = a2; red[(wave * 5 + 3) * 64 + lane] = a3; red[(wave * 5 + 4) * 64 + lane] = a4;
            __syncthreads();
            if (tid < 320) {
                const int v = tid >> 6; float s = 0.f;
#pragma unroll
                for (int w8 = 0; w8 < 8; ++w8) s += red[(w8 * 5 + v) * 64 + lane];
                MOD[((size_t)i * 5 + v) * MODW + col] = s + p.mod_b[(size_t)i * MODW + col];
            }
        }
    }
    {
        f32x4* dstc = (f32x4*)(ws + OFF_CTXX); const f32x4* srcc = (const f32x4*)p.ctx;
        for (int idx = blockIdx.x * 512 + tid; idx < TC * DM / 4; idx += gridDim.x * 512) dstc[idx] = srcc[idx];
    }
    {
        f32x2* ROPE = (f32x2*)(ws + OFF_ROPE);
        for (int idx = blockIdx.x * 512 + tid; idx < SEQ * 32; idx += gridDim.x * 512) {
            const int pos = idx >> 5, i = idx & 31;
            const float inv = powf(10000.0f, -(float)(i & 15) / 16.0f);
            const float ang = (float)(i < 16 ? pos / 64 : pos % 64) * inv;
            float sn, cs; sincosf(ang, &sn, &cs);
            ROPE[idx] = (f32x2){cs, sn};
        }
    }
    {
        f32x2* SA_ = (f32x2*)(ws + OFF_S5A); bf16_t* SB_ = (bf16_t*)(ws + OFF_S5B); bf16_t* SC_ = (bf16_t*)(ws + OFF_S5C);
        for (int idx = blockIdx.x * 512 + tid; idx < 2 * 32 * 64; idx += gridDim.x * 512) {
            const int dg = idx >> 6, pp = idx & 63;
            const float lr = p.s5_lam_re[idx], li = p.s5_lam_im[idx], dt = expf(p.s5_log_dt[dg]);
            const float mag = expf(lr * dt); float sn, cs; sincosf(li * dt, &sn, &cs);
            const float ar = mag * cs, ai = mag * sn, den = lr * lr + li * li;
            const float fr = ((ar - 1.f) * lr + ai * li) / den, fi = (ai * lr - (ar - 1.f) * li) / den;
            SA_[idx] = (f32x2){ar, ai};
#pragma unroll
            for (int hh = 0; hh < 16; ++hh) {
                const float br = p.s5_b_re[(size_t)idx * 16 + hh], bi = p.s5_b_im[(size_t)idx * 16 + hh];
                const float vr = fr * br - fi * bi, vi = fr * bi + fi * br;
                const bf16_t rh = f2bf(vr), ih = f2bf(vi);
                SB_[((size_t)(dg * 4 + 0) * 64 + pp) * 16 + hh] = rh; SB_[((size_t)(dg * 4 + 1) * 64 + pp) * 16 + hh] = f2bf(vr - bf2f(rh));
                SB_[((size_t)(dg * 4 + 2) * 64 + pp) * 16 + hh] = ih; SB_[((size_t)(dg * 4 + 3) * 64 + pp) * 16 + hh] = f2bf(vi - bf2f(ih));
            }
        }
        for (int idx = blockIdx.x * 512 + tid; idx < 2 * 32 * 16 * 128; idx += gridDim.x * 512) {
            const int k = idx & 127, hh = (idx >> 7) & 15, dg = idx >> 11;
            const float v = (k & 1) ? -p.s5_c_im[((size_t)dg * 16 + hh) * 64 + (k >> 1)] : p.s5_c_re[((size_t)dg * 16 + hh) * 64 + (k >> 1)];
            const bf16_t vh = f2bf(v);
            SC_[((size_t)(dg * 2 + 0) * 16 + hh) * 128 + k] = vh; SC_[((size_t)(dg * 2 + 1) * 16 + hh) * 128 + k] = f2bf(v - bf2f(vh));
        }
    }
}

DI void normmod_phase(const int TID, const float* __restrict__ xl, float* __restrict__ xc, const float* __restrict__ g, const float* __restrict__ modl, int i_shift, int i_scale,
                      bf16_t* __restrict__ XN, int nrows, const float* __restrict__ part, int nslice) {
    const int lane = TID & 63, wave = TID >> 6;
    for (int row = blockIdx.x * 8 + wave; row < nrows; row += gridDim.x * 8) {
        const float* xr = row < TL ? xl + (size_t)row * DM : xc + (size_t)(row - TL) * DM;
        const int v = row < TL ? row / SEQ : 4;
        const float* sh = modl + (size_t)v * MODW + i_shift * DM; const float* sc = modl + (size_t)v * MODW + i_scale * DM;
        f32x4 x[4]; float ss = 0.f;
#pragma unroll
        for (int j = 0; j < 4; ++j) x[j] = *(const f32x4*)(xr + 256 * j + 4 * lane);
        if (row >= TL && nslice > 0) {
            for (int sl = 0; sl < nslice; ++sl)
#pragma unroll
                for (int j = 0; j < 4; ++j) x[j] += *(const f32x4*)(part + ((size_t)sl * TC + (row - TL)) * DM + 256 * j + 4 * lane);
#pragma unroll
            for (int j = 0; j < 4; ++j) *(f32x4*)(xc + (size_t)(row - TL) * DM + 256 * j + 4 * lane) = x[j];
        }
#pragma unroll
        for (int j = 0; j < 4; ++j) ss += x[j][0] * x[j][0] + x[j][1] * x[j][1] + x[j][2] * x[j][2] + x[j][3] * x[j][3];
        const float rstd = rsqrtf(wave_sum(ss) * (1.f / DM) + EPSN);
#pragma unroll
        for (int j = 0; j < 4; ++j) {
            const int col = 256 * j + 4 * lane;
            const f32x4 gg = *(const f32x4*)(g + col), s1 = *(const f32x4*)(sc + col), s0 = *(const f32x4*)(sh + col);
            const f32x4 y = (x[j] * rstd * gg) * (s1 + 1.0f) + s0;
            u32x2 w; w.x = pk2(y[0], y[1]); w.y = pk2(y[2], y[3]);
            *(u32x2*)(XN + (size_t)row * DM + col) = w;
        }
    }
}

DI void qkv_post_phase(const int TID, const Params& p, const bf16_t* __restrict__ Z, int ldz, int qcol, int nq, int kcol, int nk, int vcol, int nvh, int dv,
                       const float* __restrict__ gq, const float* __restrict__ gk) {
    extern __shared__ __attribute__((aligned(16))) unsigned char shb[];
    const int tid = TID, lane = tid & 63, wave = tid >> 6;
    bf16_t* Qh = (bf16_t*)(p.ws + OFF_Q); bf16_t* Kh = (bf16_t*)(p.ws + OFF_K); bf16_t* Vt = (bf16_t*)(p.ws + OFF_V);
    const f32x2* ROPE = (const f32x2*)(p.ws + OFF_ROPE);
    {
        const int hsub = lane >> 4, j = lane & 15, ngrp = (nk + 3) >> 2;
        const f32x4 gq4 = *(const f32x4*)(gq + 4 * j) * (0.125f * LOG2E), gk4 = *(const f32x4*)(gk + 4 * j);
        for (int item = blockIdx.x * 8 + wave; item < TT * ngrp; item += gridDim.x * 8) {
            const int row = item / ngrp, hh = nq + (item % ngrp) * 4 + hsub;
            const bool lat = row < TL, valid = hh < nq + nk, isq = hh < nq;
            const int b = lat ? row / SEQ : (row - TL) / CTXL;
            const int key = lat ? row % SEQ : SEQ + (row - TL) % CTXL;
            const int hd = isq ? hh : hh - nq;
            f32x4 x = {0.f, 0.f, 0.f, 0.f};
            if (valid) { const u32x2 w = *(const u32x2*)(Z + (size_t)row * ldz + (isq ? qcol : kcol) + hd * 64 + 4 * j); x = (f32x4){bflo(w.x), bfhi(w.x), bflo(w.y), bfhi(w.y)}; }
            float ss = x[0] * x[0] + x[1] * x[1] + x[2] * x[2] + x[3] * x[3];
            ss += __shfl_xor(ss, 1); ss += __shfl_xor(ss, 2); ss += __shfl_xor(ss, 4); ss += __shfl_xor(ss, 8);
            const float rstd = rsqrtf(ss * (1.f / 64.f) + EPSN);
            f32x4 y = x * rstd * (isq ? gq4 : gk4);
            f32x4 o; o[0] = __shfl_xor(y[0], 8); o[1] = __shfl_xor(y[1], 8); o[2] = __shfl_xor(y[2], 8); o[3] = __shfl_xor(y[3], 8);
            if (lat) {
                const f32x2* cs = ROPE + key * 32 + 4 * (j & 7);
#pragma unroll
                for (int e = 0; e < 4; ++e) { const f32x2 c = cs[e]; y[e] = j < 8 ? y[e] * c[0] - o[e] * c[1] : o[e] * c[1] + y[e] * c[0]; }
            }
            if (valid) {
                bf16_t* dst = (isq ? Qh + ((size_t)(b * nq + hd) * KEYS + key) * 64 : Kh + ((size_t)(b * nk + hd) * KEYS + key) * 64);
                u32x2 w; w.x = pk2(y[0], y[1]); w.y = pk2(y[2], y[3]);
                *(u32x2*)(dst + 4 * j) = w;
            }
        }
    }
    const int vc = nvh * dv, pitch = vc * 2 + 16;
    for (int item = blockIdx.x; item < TT / 64; item += gridDim.x) {
        const int row0 = item * 64;
        const bool lat = row0 < TL;
        const int b = lat ? row0 / SEQ : (row0 - TL) / CTXL;
        const int key0 = lat ? row0 % SEQ : SEQ + (row0 - TL) % CTXL;
        __syncthreads();
        for (int c = tid; c < 64 * (vc / 8); c += 512) {
            const int r = c / (vc / 8), cc = c % (vc / 8);
            *(u32x4*)(shb + r * pitch + cc * 16) = *(const u32x4*)(Z + (size_t)(row0 + r) * ldz + vcol + cc * 8);
        }
        __syncthreads();
        for (int idx = tid; idx < vc * 8; idx += 512) {
            const int tch = idx & 7, col = idx >> 3;
            unsigned short e[8];
#pragma unroll
            for (int k = 0; k < 8; ++k) e[k] = *(const unsigned short*)(shb + (8 * tch + k) * pitch + col * 2);
            u32x4 o; o.x = e[0] | ((unsigned)e[1] << 16); o.y = e[2] | ((unsigned)e[3] << 16); o.z = e[4] | ((unsigned)e[5] << 16); o.w = e[6] | ((unsigned)e[7] << 16);
            const int hd = col / dv, d = col % dv;
            *(u32x4*)(Vt + ((size_t)(b * nvh + hd) * dv + d) * KEYS + key0 + 8 * tch) = o;
        }
    }
}

#define MFMA32(a, b, c) __builtin_amdgcn_mfma_f32_32x32x16_bf16((a), (b), (c), 0, 0, 0)
constexpr int KP = 144, VP = 136;
constexpr int KT_BYTES = 64 * KP;

template <int NDT>
DI void attn_tile(const unsigned char* Kt, const unsigned char* Vtile, const bf16x8 (&qf)[4], f32x16 (&o)[NDT], float& l, float c1, float c2, int r, int h,
                  bool domask, int qk0  ) {
#pragma unroll
    for (int sub = 0; sub < 2; ++sub) {
        f32x16 st;
#pragma unroll
        for (int i = 0; i < 16; ++i) st[i] = -c2;
#pragma unroll
        for (int s = 0; s < 4; ++s) {
            const bf16x8 kf = *(const bf16x8*)(Kt + (32 * sub + r) * KP + (16 * s + 8 * h) * 2);
            st = MFMA32(kf, qf[s], st);
        }
        float pv[16];
#pragma unroll
        for (int i = 0; i < 16; ++i) {
            float e = __builtin_amdgcn_exp2f(st[i]);
            if (domask) { const int dd = qk0 - (32 * sub + (i & 3) + 8 * (i >> 2) + 4 * h); if (dd > 128 || dd < -128) e = 0.f; }
            pv[i] = e; l += e;
        }
        u32x4 w0, w1;
        w0.x = pk2(pv[0], pv[1]); w0.y = pk2(pv[2], pv[3]); w0.z = pk2(pv[4], pv[5]); w0.w = pk2(pv[6], pv[7]);
        w1.x = pk2(pv[8], pv[9]); w1.y = pk2(pv[10], pv[11]); w1.z = pk2(pv[12], pv[13]); w1.w = pk2(pv[14], pv[15]);
        const bf16x8 pf0 = __builtin_bit_cast(bf16x8, w0), pf1 = __builtin_bit_cast(bf16x8, w1);
#pragma unroll
        for (int dt = 0; dt < NDT; ++dt) {
#pragma unroll
            for (int s2 = 0; s2 < 2; ++s2) {
                const unsigned char* vp = Vtile + (32 * dt + r) * VP + (32 * sub + 16 * s2 + 4 * h) * 2;
                const s16x4 lo = *(const s16x4*)vp, hi = *(const s16x4*)(vp + 16);
                const bf16x8 vf = __builtin_shufflevector(lo, hi, 0, 1, 2, 3, 4, 5, 6, 7);
                o[dt] = MFMA32(vf, s2 ? pf1 : pf0, o[dt]);
            }
        }
    }
}

DI void load_q_frags(const bf16_t* __restrict__ zq, const float* __restrict__ gq, const f32x2* __restrict__ rope, int h, bf16x8 (&qf)[4]) {
    float x[4][8]; float ss = 0.f;
#pragma unroll
    for (int s = 0; s < 4; ++s) {
        const u32x4 w = *(const u32x4*)(zq + 16 * s + 8 * h);
        x[s][0] = bflo(w.x); x[s][1] = bfhi(w.x); x[s][2] = bflo(w.y); x[s][3] = bfhi(w.y); x[s][4] = bflo(w.z); x[s][5] = bfhi(w.z); x[s][6] = bflo(w.w); x[s][7] = bfhi(w.w);
#pragma unroll
        for (int j = 0; j < 8; ++j) ss += x[s][j] * x[s][j];
    }
    ss += __shfl_xor(ss, 32);
    const float rstd = rsqrtf(ss * (1.f / 64.f) + EPSN);
#pragma unroll
    for (int s = 0; s < 4; ++s)
#pragma unroll
        for (int j = 0; j < 8; ++j) x[s][j] = x[s][j] * rstd * (gq[16 * s + 8 * h + j] * (0.125f * LOG2E));
    if (rope) {
#pragma unroll
        for (int s = 0; s < 2; ++s)
#pragma unroll
            for (int j = 0; j < 8; ++j) {
                const f32x2 c = rope[16 * s + 8 * h + j];
                const float a = x[s][j], bq = x[s + 2][j];
                x[s][j] = a * c[0] - bq * c[1]; x[s + 2][j] = a * c[1] + bq * c[0];
            }
    }
#pragma unroll
    for (int s = 0; s < 4; ++s) {
        u32x4 w; w.x = pk2(x[s][0], x[s][1]); w.y = pk2(x[s][2], x[s][3]); w.z = pk2(x[s][4], x[s][5]); w.w = pk2(x[s][6], x[s][7]);
        qf[s] = __builtin_bit_cast(bf16x8, w);
    }
}

DI void diff_attn_phase(const int TID, const Params& p, const bf16_t* __restrict__ Z, bf16_t* __restrict__ MIX, float lam_init) {
    extern __shared__ __attribute__((aligned(16))) unsigned char smb[];
    const int tid = TID, lane = tid & 63, wave = tid >> 6, r = lane & 31, h = lane >> 5, rg = wave & 3, m = wave >> 2;
    const bf16_t* Qh = (const bf16_t*)(p.ws + OFF_Q); const bf16_t* Kh = (const bf16_t*)(p.ws + OFF_K); const bf16_t* Vt = (const bf16_t*)(p.ws + OFF_V);
    const float gqm = wave_max(fabsf(p.diff_qk_g[lane])), gkm = wave_max(fabsf(p.diff_qk_g[64 + lane]));
    const float c1 = 0.125f * LOG2E, c2 = 8.f * gqm * gkm * LOG2E;
    const float lam = expf(wave_sum(p.diff_lam[lane] * p.diff_lam[64 + lane])) - expf(wave_sum(p.diff_lam[128 + lane] * p.diff_lam[192 + lane])) + lam_init;
    constexpr int BUFSZ = 2 * KT_BYTES + 128 * VP;
    for (int unit = blockIdx.x; unit < NB * 4 * (SEQ / 128); unit += gridDim.x) {
        const int b = unit >> 8, rem = unit & 255, qb = rem >> 2, hd = rem & 3;
        bf16x8 qf[4];
        { const int qpos_ = qb * 128 + rg * 32 + r;
          load_q_frags(Z + (size_t)(b * SEQ + qpos_) * ODD_IN + 1024 + (2 * hd + m) * 64, p.diff_qk_g, (const f32x2*)(p.ws + OFF_ROPE) + qpos_ * 32, h, qf); }
        const bf16_t* K0g = Kh + (size_t)(b * 8 + 2 * hd) * KEYS * 64;
        const bf16_t* Vg = Vt + (size_t)(b * 4 + hd) * 128 * KEYS;
        f32x16 o[4];
#pragma unroll
        for (int dt = 0; dt < 4; ++dt)
#pragma unroll
            for (int i = 0; i < 16; ++i) o[dt][i] = 0.f;
        float l = 0.f;
        u32x4 pre[4];
        const int kkey = (tid & 511) >> 3, kch = tid & 7;
#define DIFF_LOAD(t) do { const int key0_ = (t) * 64; \
            pre[0] = *(const u32x4*)(K0g + (size_t)(key0_ + kkey) * 64 + kch * 8); \
            pre[1] = *(const u32x4*)(K0g + (size_t)KEYS * 64 + (size_t)(key0_ + kkey) * 64 + kch * 8); \
            pre[2] = *(const u32x4*)(Vg + (size_t)(tid >> 3) * KEYS + key0_ + kch * 8); \
            pre[3] = *(const u32x4*)(Vg + (size_t)((tid >> 3) + 64) * KEYS + key0_ + kch * 8); } while (0)
        DIFF_LOAD(0);
        for (int t = 0; t < KEYS / 64; ++t) {
            unsigned char* buf = smb + (t & 1) * BUFSZ;
            *(u32x4*)(buf + kkey * KP + kch * 16) = pre[0];
            *(u32x4*)(buf + KT_BYTES + kkey * KP + kch * 16) = pre[1];
            { unsigned char* vq = buf + 2 * KT_BYTES + (tid >> 3) * VP + kch * 16;
              *(u32x2*)vq = (u32x2){pre[2].x, pre[2].y}; *(u32x2*)(vq + 8) = (u32x2){pre[2].z, pre[2].w};
              vq += 64 * VP;
              *(u32x2*)vq = (u32x2){pre[3].x, pre[3].y}; *(u32x2*)(vq + 8) = (u32x2){pre[3].z, pre[3].w}; }
            __syncthreads();
            if (t + 1 < KEYS / 64) DIFF_LOAD(t + 1);
            attn_tile<4>(buf + m * KT_BYTES, buf + 2 * KT_BYTES, qf, o, l, c1, c2, r, h, false, 0);
        }
#undef DIFF_LOAD
        l += __shfl_xor(l, 32);
        __syncthreads();
        float* X = (float*)smb;
        if (m == 1) {
            const float inv = lam / l;
#pragma unroll
            for (int dt = 0; dt < 4; ++dt)
#pragma unroll
                for (int i = 0; i < 16; ++i) X[(rg * 64 + lane) * 65 + dt * 16 + i] = o[dt][i] * inv;
        }
        __syncthreads();
        if (m == 0) {
            const float inv = 1.f / l; float ss = 0.f;
#pragma unroll
            for (int dt = 0; dt < 4; ++dt)
#pragma unroll
                for (int i = 0; i < 16; ++i) { const float v = o[dt][i] * inv - X[(rg * 64 + lane) * 65 + dt * 16 + i]; o[dt][i] = v; ss += v * v; }
            ss += __shfl_xor(ss, 32);
            const float rstd = rsqrtf(ss * (1.f / 128.f) + EPSN) * (1.f - lam_init);
            bf16_t* orow = MIX + (size_t)(b * SEQ + qb * 128 + rg * 32 + r) * DM + 512 + hd * 128;
#pragma unroll
            for (int dt = 0; dt < 4; ++dt)
#pragma unroll
                for (int g4 = 0; g4 < 4; ++g4) {
                    const int d = 32 * dt + 8 * g4 + 4 * h;
                    const f32x4 sg = *(const f32x4*)(p.diff_sub_g + d);
                    u32x2 w; w.x = pk2(o[dt][4 * g4] * rstd * sg[0], o[dt][4 * g4 + 1] * rstd * sg[1]); w.y = pk2(o[dt][4 * g4 + 2] * rstd * sg[2], o[dt][4 * g4 + 3] * rstd * sg[3]);
                    *(u32x2*)(orow + d) = w;
                }
        }
        __syncthreads();
    }
}

DI void swa_attn_phase(const int TID, const Params& p, const bf16_t* __restrict__ Z, bf16_t* __restrict__ MIX) {
    extern __shared__ __attribute__((aligned(16))) unsigned char smb[];
    const int tid = TID, lane = tid & 63, wave = tid >> 6, r = lane & 31, h = lane >> 5, rg = wave & 3, hh = wave >> 2;
    const bf16_t* Qh = (const bf16_t*)(p.ws + OFF_Q); const bf16_t* Kh = (const bf16_t*)(p.ws + OFF_K); const bf16_t* Vt = (const bf16_t*)(p.ws + OFF_V);
    const float gqm = wave_max(fabsf(p.swa_qk_g[lane])), gkm = wave_max(fabsf(p.swa_qk_g[64 + lane]));
    const float mb = 8.f * gqm * gkm, c1 = 0.125f * LOG2E, c2 = mb * LOG2E;
    constexpr int BUFSZ = KT_BYTES + 64 * VP;
    constexpr int NLAT = NB * (SEQ / 128) * 4, NCTX = NB * (CTXL / 128) * 4;
    for (int unit = blockIdx.x; unit < NLAT + NCTX; unit += gridDim.x) {
        const bool cq = unit >= NLAT;
        int b, qb, kv, pr;
        if (!cq) { b = unit >> 8; const int rem = unit & 255; qb = rem >> 2; kv = (rem >> 1) & 1; pr = rem & 1; }
        else { const int u2 = unit - NLAT; b = u2 >> 3; const int rem = u2 & 7; qb = rem >> 2; kv = (rem >> 1) & 1; pr = rem & 1; }
        const int head = 4 * kv + 2 * pr + hh;
        const int qpos = qb * 128 + rg * 32 + r;
        bf16x8 qf[4];
        load_q_frags(Z + (size_t)(cq ? TL + b * CTXL + qpos : b * SEQ + qpos) * EVEN_IN + 512 + head * 64, p.swa_qk_g, cq ? (const f32x2*)nullptr : (const f32x2*)(p.ws + OFF_ROPE) + qpos * 32, h, qf);
        const bf16_t* Kg = Kh + (size_t)(b * 2 + kv) * KEYS * 64;
        const bf16_t* Vg = Vt + (size_t)(b * 2 + kv) * 64 * KEYS;
        const int tlo = cq ? 0 : max(0, 2 * qb - 2), thi = cq ? -1 : min(SEQ / 64 - 1, 2 * qb + 3), nloc = thi - tlo + 1, ntile = nloc + CTXL / 64;
        f32x16 o[2];
#pragma unroll
        for (int dt = 0; dt < 2; ++dt)
#pragma unroll
            for (int i = 0; i < 16; ++i) o[dt][i] = 0.f;
        float l = 0.f;
        u32x4 pre[2];
        const int kkey = tid >> 3, kch = tid & 7;
#define SWA_TI(i) ((i) < nloc ? tlo + (i) : SEQ / 64 + ((i) - nloc))
#define SWA_LOAD(i) do { const int key0_ = SWA_TI(i) * 64; \
            pre[0] = *(const u32x4*)(Kg + (size_t)(key0_ + kkey) * 64 + kch * 8); \
            pre[1] = *(const u32x4*)(Vg + (size_t)kkey * KEYS + key0_ + kch * 8); } while (0)
        SWA_LOAD(0);
        for (int t = 0; t < ntile; ++t) {
            unsigned char* buf = smb + (t & 1) * BUFSZ;
            *(u32x4*)(buf + kkey * KP + kch * 16) = pre[0];
            { unsigned char* vq = buf + KT_BYTES + kkey * VP + kch * 16;
              *(u32x2*)vq = (u32x2){pre[1].x, pre[1].y}; *(u32x2*)(vq + 8) = (u32x2){pre[1].z, pre[1].w}; }
            __syncthreads();
            if (t + 1 < ntile) SWA_LOAD(t + 1);
            const int key0t = SWA_TI(t) * 64, qlo = qb * 128 + rg * 32;
            if (!(t < nloc && (key0t > qlo + 31 + 128 || key0t + 63 < qlo - 128)))
                attn_tile<2>(buf, buf + KT_BYTES, qf, o, l, c1, c2, r, h, t < nloc, qpos - key0t);
        }
#undef SWA_LOAD
#undef SWA_TI
        l += __shfl_xor(l, 32);
        l += __builtin_amdgcn_exp2f((p.swa_sink[head] - mb) * LOG2E);
        const float inv = 1.f / l;
        bf16_t* orow = MIX + (size_t)(cq ? TL + b * CTXL + qpos : b * SEQ + qpos) * DM + 512 + head * 64;
#pragma unroll
        for (int dt = 0; dt < 2; ++dt)
#pragma unroll
            for (int g4 = 0; g4 < 4; ++g4) {
                const int d = 32 * dt + 8 * g4 + 4 * h;
                u32x2 w; w.x = pk2(o[dt][4 * g4] * inv, o[dt][4 * g4 + 1] * inv); w.y = pk2(o[dt][4 * g4 + 2] * inv, o[dt][4 * g4 + 3] * inv);
                *(u32x2*)(orow + d) = w;
            }
        __syncthreads();
    }
}

DI float fma_s(float a, float b, float c) { float r; asm volatile("v_fma_f32 %0, %1, %2, %3" : "=v"(r) : "v"(a), "v"(b), "v"(c)); return r; }
DI void cmad(float& xr, float& xi, float ar, float ai, float br, float bi) {
    const float nr = fma_s(-xi, ai, fma_s(xr, ar, br)), ni = fma_s(xi, ar, fma_s(xr, ai, bi));
    xr = nr; xi = ni;
}
template <bool FWD, int Q> DI void s5_quad(const f32x16& br, const f32x16& bi, float ar, float ai, float& Br, float& Bi) {
    constexpr int i0 = FWD ? 4 * Q : 4 * Q + 3, st = FWD ? 1 : -1;
    Br = br[i0]; Bi = bi[i0];
    cmad(Br, Bi, ar, ai, br[i0 + st], bi[i0 + st]); cmad(Br, Bi, ar, ai, br[i0 + 2 * st], bi[i0 + 2 * st]); cmad(Br, Bi, ar, ai, br[i0 + 3 * st], bi[i0 + 3 * st]);
}
DI void s5_bu(const bf16_t* __restrict__ SBq  , bf16x8 af, int pt, int r, int h, f32x16& bur, f32x16& bui) {
#pragma unroll
    for (int i = 0; i < 16; ++i) { bur[i] = 0.f; bui[i] = 0.f; }
    const bf16_t* bp = SBq + (size_t)(pt * 32 + r) * 16 + 8 * h;
    bur = MFMA32(af, *(const bf16x8*)(bp), bur); bur = MFMA32(af, *(const bf16x8*)(bp + 1024), bur);
    bui = MFMA32(af, *(const bf16x8*)(bp + 2048), bui); bui = MFMA32(af, *(const bf16x8*)(bp + 3072), bui);
    float one; asm volatile("v_mov_b32 %0, 1.0" : "=v"(one));
#pragma unroll
    for (int i = 0; i < 16; ++i) { bur[i] *= one; bui[i] *= one; }
}
DI f32x2* s5_cin(unsigned char* ws, int b, int dir, int g) { return (f32x2*)(ws + (dir ? OFF_V : OFF_K) + SZ_QKV / 4) + (size_t)(b * 32 + g) * 264 * 64; }
DI void s5_chunk(int item, int& b, int& g, int& ck, int& row0) {
    ck = item % 264; g = (item / 264) & 31; b = item / (264 * 32);
    row0 = ck < 8 ? TL + b * CTXL + ck * 32 : b * SEQ + (ck - 8) * 32;
}
DI void s5_passA(const int TID, const Params& p, const bf16_t* __restrict__ Z) {
    const int lane = TID & 63, wave = TID >> 6, r = lane & 31, h = lane >> 5;
    const f32x2* SAp = (const f32x2*)(p.ws + OFF_S5A); const bf16_t* SBp = (const bf16_t*)(p.ws + OFF_S5B); f32x2* ST = (f32x2*)(p.ws + OFF_ST);
    for (int item = blockIdx.x * 8 + wave; item < NB * 32 * 264; item += gridDim.x * 8) {
        int b, g, ck, row0; s5_chunk(item, b, g, ck, row0);
        const bf16x8 af = *(const bf16x8*)(Z + (size_t)(row0 + r) * EVEN_IN + g * 16 + 8 * h);
        static_for<0, 2>([&](auto dc) {
            constexpr int dir = decltype(dc)::value;
            static_for<0, 2>([&](auto pc) {
                constexpr int pt = decltype(pc)::value;
                f32x16 bur, bui;
                s5_bu(SBp + (size_t)(dir * 32 + g) * 4096, af, pt, r, h, bur, bui);
                const f32x2 A = SAp[(dir * 32 + g) * 64 + pt * 32 + r];
                float a2r = A[0] * A[0] - A[1] * A[1], a2i = 2.f * A[0] * A[1];
                const float a4r = a2r * a2r - a2i * a2i, a4i = 2.f * a2r * a2i, a8r = a4r * a4r - a4i * a4i, a8i = 2.f * a4r * a4i;
                float Er = 0.f, Ei = 0.f;
                static_for<0, 4>([&](auto kc) {
                    constexpr int q = dir ? 3 - decltype(kc)::value : decltype(kc)::value;
                    float Br, Bi; s5_quad<dir == 0, q>(bur, bui, A[0], A[1], Br, Bi);
                    const float Pr = __shfl_xor(Br, 32), Pi = __shfl_xor(Bi, 32);
                    const bool own_first = (dir == 0) ? (h == 0) : (h == 1);
                    float fr = own_first ? Br : Pr, fi = own_first ? Bi : Pi; const float sr = own_first ? Pr : Br, si = own_first ? Pi : Bi;
                    cmad(fr, fi, a4r, a4i, sr, si);
                    cmad(Er, Ei, a8r, a8i, fr, fi);
                });
                if (h == 0) ST[((size_t)((b * 2 + dir) * 32 + g) * 264 + ck) * 64 + pt * 32 + r] = (f32x2){Er, Ei};
            });
        });
    }
}
DI void s5_passB(const int TID, const Params& p) {
    const f32x2* SAp = (const f32x2*)(p.ws + OFF_S5A); f32x2* ST = (f32x2*)(p.ws + OFF_ST);
    for (int idx = blockIdx.x * 512 + TID; idx < NB * 2 * 32 * 64; idx += gridDim.x * 512) {
        const int pp = idx & 63, bdg = idx >> 6, dir = (bdg >> 5) & 1;
        const f32x2 A = SAp[(bdg & 63) * 64 + pp];
        float ar = A[0], ai = A[1];
#pragma unroll
        for (int q = 0; q < 5; ++q) { const float nr = ar * ar - ai * ai; ai = 2.f * ar * ai; ar = nr; }
        float sr = 0.f, si = 0.f;
        const f32x2* e0 = ST + (size_t)bdg * 264 * 64 + pp;
        f32x2* c0 = s5_cin(p.ws, bdg >> 6, dir, bdg & 31) + pp;
        for (int v0 = 0; v0 < 264; v0 += 12) {
            f32x2 E[12];
#pragma unroll
            for (int k = 0; k < 12; ++k) { const int v = v0 + k; const int ck = dir == 0 ? v : (v < 8 ? 7 - v : 263 - (v - 8)); E[k] = e0[(size_t)ck * 64]; }
#pragma unroll
            for (int k = 0; k < 12; ++k) {
                const int v = v0 + k; const int ck = dir == 0 ? v : (v < 8 ? 7 - v : 263 - (v - 8));
                c0[(size_t)ck * 64] = (f32x2){sr, si};
                cmad(sr, si, ar, ai, E[k][0], E[k][1]);
            }
        }
    }
}
constexpr int HSP = 272;
DI void s5_passC(const int TID, const Params& p, const bf16_t* __restrict__ Z, bf16_t* __restrict__ G) {
    extern __shared__ __attribute__((aligned(16))) unsigned char smb[];
    const int lane = TID & 63, wave = TID >> 6, r = lane & 31, h = lane >> 5, c16 = lane & 15, kg = lane >> 4;
    unsigned char* Hs = smb + wave * (32 * HSP);
    const f32x2* SAp = (const f32x2*)(p.ws + OFF_S5A); const bf16_t* SBp = (const bf16_t*)(p.ws + OFF_S5B); const bf16_t* SCp = (const bf16_t*)(p.ws + OFF_S5C);
    const f32x2* ST = (const f32x2*)(p.ws + OFF_ST);
    for (int item = blockIdx.x * 8 + wave; item < NB * 32 * 264; item += gridDim.x * 8) {
        int b, g, ck, row0; s5_chunk(item, b, g, ck, row0);
        const bf16x8 af = *(const bf16x8*)(Z + (size_t)(row0 + r) * EVEN_IN + g * 16 + 8 * h);
        f32x4 yacc[2] = {{0.f, 0.f, 0.f, 0.f}, {0.f, 0.f, 0.f, 0.f}};
        static_for<0, 2>([&](auto dc) {
            constexpr int dir = decltype(dc)::value;
            static_for<0, 2>([&](auto pc) {
                constexpr int pt = decltype(pc)::value;
                f32x16 bur, bui;
                s5_bu(SBp + (size_t)(dir * 32 + g) * 4096, af, pt, r, h, bur, bui);
                const f32x2 A = SAp[(dir * 32 + g) * 64 + pt * 32 + r];
                float a2r = A[0] * A[0] - A[1] * A[1], a2i = 2.f * A[0] * A[1];
                const float a4r = a2r * a2r - a2i * a2i, a4i = 2.f * a2r * a2i, a8r = a4r * a4r - a4i * a4i, a8i = 2.f * a4r * a4i;
                const f32x2 cin = s5_cin(p.ws, b, dir, g)[(size_t)ck * 64 + pt * 32 + r];
                float Sr = cin[0], Si = cin[1];
                static_for<0, 4>([&](auto kc) {
                    constexpr int q = dir ? 3 - decltype(kc)::value : decltype(kc)::value;
                    float Br, Bi; s5_quad<dir == 0, q>(bur, bui, A[0], A[1], Br, Bi);
                    const float Pr = __shfl_xor(Br, 32), Pi = __shfl_xor(Bi, 32);
                    const bool own_first = (dir == 0) ? (h == 0) : (h == 1);
                    float er = Sr, ei = Si;
                    if (!own_first) cmad(er, ei, a4r, a4i, Pr, Pi);
                    float fr = own_first ? Br : Pr, fi = own_first ? Bi : Pi; const float sr = own_first ? Pr : Br, si = own_first ? Pi : Bi;
                    cmad(fr, fi, a4r, a4i, sr, si);
                    cmad(Sr, Si, a8r, a8i, fr, fi);
                    static_for<0, 4>([&](auto jc) {
                        constexpr int i = dir ? 4 * q + 3 - decltype(jc)::value : 4 * q + decltype(jc)::value;
                        cmad(er, ei, A[0], A[1], bur[i], bui[i]);
                        *(unsigned*)(Hs + (8 * (i >> 2) + 4 * h + (i & 3)) * HSP + (pt * 32 + r) * 4) = pk2(er, ei);
                    });
                });
            });
            LDS_FENCE();
            const bf16_t* cp = SCp + (size_t)(dir * 32 + g) * 2 * 16 * 128 + (size_t)c16 * 128 + 8 * kg;
#pragma unroll
            for (int tt = 0; tt < 2; ++tt)
#pragma unroll
                for (int ks = 0; ks < 4; ++ks) {
                    const bf16x8 hf = *(const bf16x8*)(Hs + (16 * tt + c16) * HSP + (32 * ks + 8 * kg) * 2);
                    yacc[tt] = __builtin_amdgcn_mfma_f32_16x16x32_bf16(hf, *(const bf16x8*)(cp + 32 * ks), yacc[tt], 0, 0, 0);
                    yacc[tt] = __builtin_amdgcn_mfma_f32_16x16x32_bf16(hf, *(const bf16x8*)(cp + 2048 + 32 * ks), yacc[tt], 0, 0, 0);
                }
            LDS_FENCE();
        });
        const float dsk = p.s5_d[g * 16 + c16];
#pragma unroll
        for (int tt = 0; tt < 2; ++tt)
#pragma unroll
            for (int i = 0; i < 4; ++i) {
                const size_t row = (size_t)row0 + 16 * tt + 4 * kg + i;
                const float u = bf2f(Z[row * EVEN_IN + g * 16 + c16]);
                G[row * 512 + g * 16 + c16] = f2bf(gelu_tanh(yacc[tt][i] + dsk * u));
            }
    }
}

constexpr int WLP = 144;
DI void lru_load_wl(const int TID, const Params& p, int n, unsigned char* WL, float* CW) {
    for (int idx = TID; idx < 4 * 4096; idx += 512) {
        const int mat = idx >> 12, de = idx & 4095, d = de >> 6, e = de & 63, dir = mat >> 1;
        const float* src = (mat & 1) ? p.lru_wx : p.lru_wa;
        *(bf16_t*)(WL + mat * 64 * WLP + e * WLP + d * 2) = f2bf(src[(size_t)(dir * 8 + n) * 4096 + de]);
    }
    for (int idx = TID; idx < 4096; idx += 512) { const int e = idx >> 6, d = idx & 63; *(bf16_t*)(WL + 4 * 64 * WLP + e * WLP + d * 2) = (e == d) ? (bf16_t)0x3F80 : (bf16_t)0; }
    if (TID < 320) { const int k = TID >> 6, d = TID & 63; CW[TID] = k < 4 ? p.lru_conv_w[k * 512 + n * 64 + d] : p.lru_conv_b[n * 64 + d]; }
}
DI void lru_afrag(const bf16_t* __restrict__ zr, int t, int seq_len, const float* CW, int h, bf16x8 (&af)[4]) {
#pragma unroll
    for (int s = 0; s < 4; ++s) {
        const int d0 = 16 * s + 8 * h;
        float x[8];
#pragma unroll
        for (int j = 0; j < 8; ++j) x[j] = CW[256 + d0 + j];
#pragma unroll
        for (int k = 0; k < 4; ++k) {
            const int tt = t + k - 2;
            if (tt >= 0 && tt < seq_len) {
                const u32x4 v = *(const u32x4*)(zr + (size_t)tt * ODD_IN + d0);
                const float* w = CW + k * 64 + d0;
                x[0] += bflo(v.x) * w[0]; x[1] += bfhi(v.x) * w[1]; x[2] += bflo(v.y) * w[2]; x[3] += bfhi(v.y) * w[3];
                x[4] += bflo(v.z) * w[4]; x[5] += bfhi(v.z) * w[5]; x[6] += bflo(v.w) * w[6]; x[7] += bfhi(v.w) * w[7];
            }
        }
        u32x4 w4; w4.x = pk2(x[0], x[1]); w4.y = pk2(x[2], x[3]); w4.z = pk2(x[4], x[5]); w4.w = pk2(x[6], x[7]);
        af[s] = __builtin_bit_cast(bf16x8, w4);
    }
}
DI void lru_pre(const unsigned char* WL, const bf16x8 (&af)[4], int et, int r, int h, f32x16 (&pre)[5]) {
#pragma unroll
    for (int mat = 0; mat < 5; ++mat) {
#pragma unroll
        for (int i = 0; i < 16; ++i) pre[mat][i] = 0.f;
#pragma unroll
        for (int s = 0; s < 4; ++s) pre[mat] = MFMA32(af[s], *(const bf16x8*)(WL + mat * 64 * WLP + (et * 32 + r) * WLP + (16 * s + 8 * h) * 2), pre[mat]);
    }
}
DI void lru_gates(const f32x16& pa, const f32x16& px, const f32x16& xcv, float ba, float bx, float sp, float (&a)[16], float (&bq)[16]) {
#pragma unroll
    for (int i = 0; i < 16; ++i) {
        const float rg = sigmoid_f(pa[i] + ba), gi = sigmoid_f(px[i] + bx);
        const float la = -8.f * rg * sp;
        const float av = __builtin_amdgcn_exp2f(la * LOG2E);
        a[i] = av; bq[i] = __builtin_amdgcn_sqrtf(fmaxf(fmaf(-av, av, 1.f), 0.f)) * (gi * xcv[i]);
    }
}
template <bool FWD, int Q> DI void lru_quad(const float (&a)[16], const float (&bq)[16], float& A, float& B) {
    constexpr int i0 = FWD ? 4 * Q : 4 * Q + 3, st = FWD ? 1 : -1;
    A = a[i0] * a[i0 + st] * a[i0 + 2 * st] * a[i0 + 3 * st];
    B = ((bq[i0] * a[i0 + st] + bq[i0 + st]) * a[i0 + 2 * st] + bq[i0 + 2 * st]) * a[i0 + 3 * st] + bq[i0 + 3 * st];
}
DI void lru_passA(const int TID, const Params& p, const bf16_t* __restrict__ Z) {
    extern __shared__ __attribute__((aligned(16))) unsigned char smb[];
    const int lane = TID & 63, wave = TID >> 6, r = lane & 31, h = lane >> 5;
    unsigned char* WL = smb; float* CW = (float*)(smb + 5 * 64 * WLP);
    f32x2* SUM = (f32x2*)(p.ws + OFF_ST);
    const int n = blockIdx.x & 7;
    __syncthreads();
    lru_load_wl(TID, p, n, WL, CW);
    __syncthreads();
    for (int item = (blockIdx.x >> 3) * 8 + wave; item < NB * 264; item += (gridDim.x >> 3) * 8) {
        asm volatile("" ::: "memory");
        const int b = item / 264, ck = item % 264;
        const int seq_len = ck < 8 ? CTXL : SEQ, t0 = ck < 8 ? ck * 32 : (ck - 8) * 32, rowbase = ck < 8 ? TL + b * CTXL : b * SEQ;
        bf16x8 af[4];
        lru_afrag(Z + (size_t)rowbase * ODD_IN + 512 + n * 64, t0 + r, seq_len, CW, h, af);
        static_for<0, 2>([&](auto etc) {
            constexpr int et = decltype(etc)::value;
            const int ch = n * 64 + et * 32 + r;
            f32x16 pre[5];
            lru_pre(WL, af, et, r, h, pre);
            static_for<0, 2>([&](auto dc) {
                constexpr int dir = decltype(dc)::value;
                float a[16], bq[16];
                lru_gates(pre[2 * dir], pre[2 * dir + 1], pre[4], p.lru_ba[dir * 512 + ch], p.lru_bx[dir * 512 + ch], log1pf(__expf(-p.lru_lam[dir * 512 + ch])), a, bq);
                float P = 1.f, E = 0.f;
                static_for<0, 4>([&](auto kc) {
                    constexpr int q = dir ? 3 - decltype(kc)::value : decltype(kc)::value;
                    float A, B;
                    lru_quad<dir == 0, q>(a, bq, A, B);
                    const float Ap = __shfl_xor(A, 32), Bp = __shfl_xor(B, 32);
                    const bool own_first = (dir == 0) ? (h == 0) : (h == 1);
                    const float fA = own_first ? A : Ap, fB = own_first ? B : Bp, sA = own_first ? Ap : A, sB = own_first ? Bp : B;
                    const float pA = fA * sA, pB = sA * fB + sB;
                    E = pA * E + pB; P *= pA;
                });
                if (h == 0) SUM[((size_t)(b * 2 + dir) * 264 + ck) * 512 + ch] = (f32x2){P, E};
            });
        });
    }
}
DI void lru_passB(const int TID, const Params& p) {
    const f32x2* SUM = (const f32x2*)(p.ws + OFF_ST); float* LC = (float*)(p.ws + OFF_LCIN);
    for (int idx = blockIdx.x * 512 + TID; idx < NB * 2 * 512; idx += gridDim.x * 512) {
        const int ch = idx & 511, bd = idx >> 9, dir = bd & 1;
        float s = 0.f;
        for (int v0 = 0; v0 < 264; v0 += 24) {
            f32x2 pe[24];
#pragma unroll
            for (int k = 0; k < 24; ++k) { const int v = v0 + k; const int ck = dir == 0 ? v : (v < 8 ? 7 - v : 263 - (v - 8)); pe[k] = SUM[((size_t)bd * 264 + ck) * 512 + ch]; }
#pragma unroll
            for (int k = 0; k < 24; ++k) { const int v = v0 + k; const int ck = dir == 0 ? v : (v < 8 ? 7 - v : 263 - (v - 8)); LC[((size_t)bd * 264 + ck) * 512 + ch] = s; s = pe[k][0] * s + pe[k][1]; }
        }
    }
}
DI void lru_passC(const int TID, const Params& p, const bf16_t* __restrict__ Z, bf16_t* __restrict__ MIX) {
    extern __shared__ __attribute__((aligned(16))) unsigned char smb[];
    const int lane = TID & 63, wave = TID >> 6, r = lane & 31, h = lane >> 5;
    unsigned char* WL = smb; float* CW = (float*)(smb + 5 * 64 * WLP);
    const float* LC = (const float*)(p.ws + OFF_LCIN);
    const int n = blockIdx.x & 7;
    __syncthreads();
    lru_load_wl(TID, p, n, WL, CW);
    __syncthreads();
    for (int item = (blockIdx.x >> 3) * 8 + wave; item < NB * 256; item += (gridDim.x >> 3) * 8) {
        asm volatile("" ::: "memory");
        const int b = item >> 8, j = item & 255, ck = 8 + j, t0 = j * 32;
        bf16x8 af[4];
        lru_afrag(Z + (size_t)b * SEQ * ODD_IN + 512 + n * 64, t0 + r, SEQ, CW, h, af);
        static_for<0, 2>([&](auto etc) {
            constexpr int et = decltype(etc)::value;
            const int ch = n * 64 + et * 32 + r;
            f32x16 pre[5];
            lru_pre(WL, af, et, r, h, pre);
            float y[16];
            static_for<0, 2>([&](auto dc) {
                constexpr int dir = decltype(dc)::value;
                float a[16], bq[16];
                lru_gates(pre[2 * dir], pre[2 * dir + 1], pre[4], p.lru_ba[dir * 512 + ch], p.lru_bx[dir * 512 + ch], log1pf(__expf(-p.lru_lam[dir * 512 + ch])), a, bq);
                float S = LC[((size_t)(b * 2 + dir) * 264 + ck) * 512 + ch];
                static_for<0, 4>([&](auto kc) {
                    constexpr int q = dir ? 3 - decltype(kc)::value : decltype(kc)::value;
                    float A, B;
                    lru_quad<dir == 0, q>(a, bq, A, B);
                    const float Ap = __shfl_xor(A, 32), Bp = __shfl_xor(B, 32);
                    const bool own_first = (dir == 0) ? (h == 0) : (h == 1);
                    float s = own_first ? S : Ap * S + Bp;
                    const float fA = own_first ? A : Ap, fB = own_first ? B : Bp, sA = own_first ? Ap : A, sB = own_first ? Bp : B;
                    S = (fA * sA) * S + (sA * fB + sB);
                    static_for<0, 4>([&](auto jc) {
                        constexpr int i = dir ? 4 * q + 3 - decltype(jc)::value : 4 * q + decltype(jc)::value;
                        s = a[i] * s + bq[i];
                        if (dir == 0) y[i] = s; else y[i] += s;
                    });
                });
            });
#pragma unroll
            for (int i = 0; i < 16; ++i) {
                const size_t row = (size_t)b * SEQ + t0 + 8 * (i >> 2) + 4 * h + (i & 3);
                const float gz = bf2f(Z[row * ODD_IN + ch]);
                MIX[row * DM + ch] = f2bf(y[i] * gelu_tanh(gz));
            }
        });
    }
}

constexpr int NPHASE = 26;
#ifndef MK_RPT
#define MK_RPT 0ull
#endif
#define RPT(bit, ...) do { __VA_ARGS__; if ((MK_RPT >> (bit)) & 1ull) { __syncthreads(); __VA_ARGS__; } } while (0)
DI void run_phase(const int TID, const Params& p, int ph) {
    if (ph == 0) { RPT(0, prologue_phase(TID, p)); return; }
    const int l = ph >= 14 ? 1 : 0;
    int s = l ? ph - 13 : ph;
    if (l && s >= 9) s += 1;
    const int rb = 16 * l;
    unsigned char* ws = p.ws;
    float* ctxx = (float*)(ws + OFF_CTXX);
    const float* modl = (const float*)(ws + OFF_MOD) + (size_t)l * 5 * MODW;
    bf16_t* XN = (bf16_t*)(ws + OFF_XN); bf16_t* H = (bf16_t*)(ws + OFF_H); bf16_t* G = (bf16_t*)(ws + OFF_G);
    const bool first = (l == 0 && s <= 3);
    const float* srcL = first ? p.x : p.out; const float* srcC = ctxx;
    (void)srcC;
    const int nrows = (l == 1 && s >= 10) ? TL : TT;
    const int f = s >= 11 ? 1 : 0;
    const bf16_t* W13 = (const bf16_t*)(ws + OFF_W + (size_t)(l * 2 + f) * SZ_FFN);
    const bf16_t* W2 = (const bf16_t*)(ws + OFF_W + (size_t)(l * 2 + f) * SZ_FFN + SZ_W13);
    switch (s) {
    case 1: case 4: case 11: {
        const int gi = s == 1 ? 0 : (s == 4 ? 1 : 2);
        const int nsl = (l == 0 && s == 1) ? 0 : (s == 11 ? 4 : 11);
        normmod_phase(TID, srcL, ctxx, p.norm_g + (size_t)(l * 3 + gi) * DM, modl, 3 * gi, 3 * gi + 1, XN, nrows, (const float*)(ws + OFF_Q), nsl);
    } break;
    case 2: case 12: { EpiSwiglu e{H}; RPT(rb + s, gemm_phase(TID, XN, W13, nrows, 2 * DFF, DM, e)); } break;
    case 3: case 13: case 10: {
        const float* gbase = modl + (s == 3 ? 2 : (s == 13 ? 8 : 5)) * DM; const float coef = s == 10 ? 1.0f : 0.5f;
        EpiResid e{srcL, srcC, p.out, ctxx, gbase, coef};
        EpiPartial ea{(float*)(ws + OFF_Q), gbase + (size_t)4 * MODW, coef};
        const bf16_t* Wo = (const bf16_t*)(ws + (l ? OFF_ODOUT : OFF_EVOUT));
        if (s == 10) { gemm_phase(TID, XN, Wo, TL, DM, DM, e); if (nrows == TT) gemm_phase(TID, XN + (size_t)TL * DM, Wo, TC, DM, DM, ea, 4); }
        else { gemm_phase(TID, H, W2, TL, DM, DFF, e); if (nrows == TT) gemm_phase(TID, H + (size_t)TL * DFF, W2, TC, DM, DFF, ea, 11); }
    } break;
    case 5: {
        EpiStoreBf16 e{H, l ? ODD_IN : EVEN_IN};
        RPT(rb + s, gemm_phase(TID, XN, (const bf16_t*)(ws + (l ? OFF_ODIN : OFF_EVIN)), TT, l ? ODD_IN : EVEN_IN, DM, e));
    } break;
    case 6:
        if (l == 0) { RPT(6, qkv_post_phase(TID, p, H, EVEN_IN, 512, 8, 1024, 2, 1152, 2, 64, p.swa_qk_g, p.swa_qk_g + 64)); __syncthreads(); RPT(14, s5_passA(TID, p, H)); }
        else { RPT(22, qkv_post_phase(TID, p, H, ODD_IN, 1024, 8, 1536, 8, 2048, 4, 128, p.diff_qk_g, p.diff_qk_g + 64)); __syncthreads(); RPT(30, lru_passA(TID, p, H)); }
        break;
    case 7:
        if (l == 0) { s5_passB(TID, p); RPT(7, swa_attn_phase(TID, p, H, XN)); }
        else { lru_passB(TID, p); RPT(23, diff_attn_phase(TID, p, H, XN, 0.8f - 0.6f * 0.74081822068171788f)); }
        break;
    case 8:
        if (l == 0) RPT(8, s5_passC(TID, p, H, G)); else RPT(24, lru_passC(TID, p, H, XN));
        break;
    case 9: { EpiGlu e{G, p.s5_glu_b, XN}; RPT(9, gemm_phase(TID, G, (const bf16_t*)(ws + OFF_GLUW), TT, 512, 512, e)); } break;
    default: break;
    }
}

DI int mk_tid(int wv) { int l; asm volatile("v_mbcnt_lo_u32_b32 %0, -1, 0\n\tv_mbcnt_hi_u32_b32 %0, -1, %0" : "=v"(l)); return wv * 64 + l; }
#define XB_TMO      128
#define XB_XCNT(j)  (256  + 64 * (j))
#define XB_XSUB(j)  (1280 + 64 * (j))
#define XB_XGEN(j)  (2304 + 64 * (j))
#define XB_TOP      3328
#define XB_TOPGEN   3392
#define XCD_BAR_WORDS 3456
#define XB_SPIN_CAP (1u << 22)
#define LAS __attribute__((address_space(3)))
DI unsigned xb_ld(unsigned* p) { return __hip_atomic_load(p, __ATOMIC_RELAXED, __HIP_MEMORY_SCOPE_AGENT); }
DI unsigned xb_add(unsigned* p, unsigned v) { return __hip_atomic_fetch_add(p, v, __ATOMIC_RELAXED, __HIP_MEMORY_SCOPE_AGENT); }
DI unsigned xb_xcc_id() { return (unsigned)__builtin_amdgcn_s_getreg((3 << 11) | 20) & 0xFu; }
#define XB_SPIN(cond, bar) do { unsigned _sp = 0; while (cond) { __builtin_amdgcn_s_sleep(1); \
    if ((++_sp & 255u) == 0u) { if (xb_ld(&(bar)[XB_TMO])) break; if (_sp > XB_SPIN_CAP) { atomicAdd(&(bar)[XB_TMO], 1u); break; } } } } while (0)
DI void xcd_barrier_complete(unsigned* bar, unsigned x, unsigned& nloc, unsigned& nx) {
    const unsigned G = gridDim.x;
    unsigned sum, cnt, mine, sp = 0u;
    for (;;) {
        sum = 0u; cnt = 0u; mine = 0u;
#pragma unroll
        for (unsigned j = 0; j < 16; ++j) { const unsigned c = xb_ld(&bar[XB_XCNT(j)]); sum += c; cnt += (c > 0u) ? 1u : 0u; mine = (j == x) ? c : mine; }
        if (sum == G) break;
        __builtin_amdgcn_s_sleep(1);
        if ((++sp & 255u) == 0u) { if (xb_ld(&bar[XB_TMO])) break; if (sp > XB_SPIN_CAP) { atomicAdd(&bar[XB_TMO], 1u); break; } }
    }
    nloc = mine > 0u ? mine : 1u; nx = cnt > 0u ? cnt : 1u;
}
DI void xcd_barrier(unsigned* bar, int tid) {
    extern __shared__ __attribute__((aligned(16))) unsigned char smx[];
    volatile LAS unsigned* st = (volatile LAS unsigned*)(smx + 131072);
    asm volatile("s_waitcnt vmcnt(0)" ::: "memory");
    __syncthreads();
    if (tid == 0) {
        const unsigned x = xb_xcc_id();
        __builtin_amdgcn_s_waitcnt(0);
        unsigned nloc = st[0], nx = st[1];
        if (nloc == 0u) { xcd_barrier_complete(bar, x, nloc, nx); st[0] = nloc; st[1] = nx; }
        const unsigned old = xb_add(&bar[XB_XSUB(x)], 1u);
        const unsigned gen = old / nloc;
        if (old + 1u == (gen + 1u) * nloc) {
            __builtin_amdgcn_fence(__ATOMIC_RELEASE, "agent");
            asm volatile("s_waitcnt vmcnt(0)" ::: "memory");
            const unsigned og = xb_add(&bar[XB_TOP], 1u);
            const unsigned tg = og / nx;
            if (og + 1u == (tg + 1u) * nx) xb_add(&bar[XB_TOPGEN], 1u);
            else XB_SPIN(xb_ld(&bar[XB_TOPGEN]) == tg, bar);
            __builtin_amdgcn_fence(__ATOMIC_ACQUIRE, "agent");
            xb_add(&bar[XB_XGEN(x)], 1u);
            asm volatile("s_waitcnt vmcnt(0)" ::: "memory");
        } else {
            XB_SPIN(xb_ld(&bar[XB_XGEN(x)]) == gen, bar);
            __builtin_amdgcn_fence(__ATOMIC_ACQUIRE, "agent");
            asm volatile("s_waitcnt vmcnt(0)" ::: "memory");
        }
    }
    __syncthreads();
}
template <int K>
DI void run_all(const int wv, const Params& p, int lo, int hi) {
    if constexpr (K < NPHASE) {
        if (K >= lo && K < hi) {
            const int tid = mk_tid(wv);
            run_phase(tid, p, K);
            if (K + 1 < hi) { xcd_barrier((unsigned*)(p.ws + OFF_BAR), tid); if ((MK_RPT >> 63) & 1ull) xcd_barrier((unsigned*)(p.ws + OFF_BAR), tid); }
        }
        run_all<K + 1>(wv, p, lo, hi);
    }
}
__global__ void __launch_bounds__(512) mega_fwd(Params p, int ph_lo, int ph_hi) {
    const int wv = __builtin_amdgcn_readfirstlane((int)(threadIdx.x >> 6));
    {
        extern __shared__ __attribute__((aligned(16))) unsigned char smx[];
        if (threadIdx.x == 0) { *(u32x4*)(smx + 131072) = (u32x4){0u, 0u, 0u, 0u}; (void)xb_add((unsigned*)(p.ws + OFF_BAR) + XB_XCNT(xb_xcc_id()), 1u); }
        __syncthreads();
    }
    if (ph_hi - ph_lo > 1) cg::this_grid().sync();
    run_all<0>(wv, p, ph_lo, ph_hi);
}

#ifndef MK_MULTI
#define MK_MULTI 0
#endif
extern "C" void kernel_launch(void* const* d_in, const int* in_sizes, int n_in, void* d_out, int out_size, void* d_ws, size_t ws_size, hipStream_t stream) {
    static int grid = 0;
    if (grid == 0) {
        if (n_in != 37 || in_sizes[0] != TL * DM || out_size != TL * DM || ws_size < WS_END) {
            fprintf(stderr, "kernel_launch: unexpected problem: n_in %d in0 %d out %d ws %zu (need %zu)\n", n_in, n_in > 0 ? in_sizes[0] : -1, out_size, ws_size, (size_t)WS_END);
            grid = -1; return;
        }
        int dev = 0, cus = 0, per_cu = 0;
        (void)hipGetDevice(&dev);
        (void)hipDeviceGetAttribute(&cus, hipDeviceAttributeMultiprocessorCount, dev);
        if (hipFuncSetAttribute((const void*)mega_fwd, hipFuncAttributeMaxDynamicSharedMemorySize, LDS_BYTES) != hipSuccess) { fprintf(stderr, "kernel_launch: hipFuncSetAttribute failed\n"); grid = -1; return; }
        (void)hipOccupancyMaxActiveBlocksPerMultiprocessor(&per_cu, (const void*)mega_fwd, 512, LDS_BYTES);
        if (per_cu < 1) { fprintf(stderr, "kernel_launch: occupancy query says %d blocks per CU\n", per_cu); per_cu = 1; }
        (void)hipGetLastError();
        grid = cus * per_cu;
    }
    if (grid < 0) return;
    if (hipMemsetAsync((unsigned char*)d_ws + OFF_BAR, 0, 16384, stream) != hipSuccess) { fprintf(stderr, "kernel_launch: memset failed\n"); return; }
    Params p{};
    const float** pp = (const float**)&p;
    for (int i = 0; i < 37; ++i) pp[i] = (const float*)d_in[i];
    p.out = (float*)d_out; p.ws = (unsigned char*)d_ws;
#if MK_MULTI
    for (int ph = 0; ph < NPHASE; ++ph) hipLaunchKernelGGL(mega_fwd, dim3(grid), dim3(512), LDS_BYTES, stream, p, ph, ph + 1);
#else
    int lo = 0, hi = NPHASE;
    void* args[] = {&p, &lo, &hi};
    hipError_t e = hipLaunchCooperativeKernel((const void*)mega_fwd, dim3(grid), dim3(512), args, LDS_BYTES, stream);
    if (e != hipSuccess) fprintf(stderr, "kernel_launch: cooperative launch failed: %s (grid %d)\n", hipGetErrorString(e), grid);
#endif
}
```

```cpp
#include <hip/hip_runtime.h>
#include <hip/hip_cooperative_groups.h>
#include <cstdio>
#include <cstdint>
namespace cg = cooperative_groups;

#define DI __device__ __forceinline__
typedef unsigned short bf16_t;
typedef short bf16x8 __attribute__((ext_vector_type(8)));
typedef short s16x4 __attribute__((ext_vector_type(4)));
typedef float f32x2 __attribute__((ext_vector_type(2)));
typedef float f32x4 __attribute__((ext_vector_type(4)));
typedef float f32x16 __attribute__((ext_vector_type(16)));
typedef unsigned u32x2 __attribute__((ext_vector_type(2)));
typedef unsigned u32x4 __attribute__((ext_vector_type(4)));
typedef __bf16 bf16x2_t __attribute__((ext_vector_type(2)));

constexpr int DM = 1024, NB = 4, SEQ = 8192, CTXL = 256, TL = NB * SEQ, TC = NB * CTXL, TT = TL + TC, DFF = 2816, KEYS = SEQ + CTXL;
constexpr int NMOD = 9, MODW = NMOD * DM;
constexpr int EVEN_IN = 1280, ODD_IN = 2560;
constexpr float EPSN = 1e-6f;
constexpr float LOG2E = 1.4426950408889634f;

constexpr size_t SZ_W13 = (size_t)2 * DFF * DM * 2, SZ_W2 = (size_t)DM * DFF * 2, SZ_FFN = SZ_W13 + SZ_W2;
constexpr size_t OFF_W = 0;
constexpr size_t OFF_EVIN = OFF_W + 4 * SZ_FFN;
constexpr size_t OFF_EVOUT = OFF_EVIN + (size_t)EVEN_IN * DM * 2;
constexpr size_t OFF_GLUW = OFF_EVOUT + (size_t)DM * DM * 2;
constexpr size_t OFF_ODIN = OFF_GLUW + (size_t)512 * 512 * 2;
constexpr size_t OFF_ODOUT = OFF_ODIN + (size_t)ODD_IN * DM * 2;
constexpr size_t OFF_XN = OFF_ODOUT + (size_t)DM * DM * 2;
constexpr size_t OFF_H = OFF_XN + (size_t)TT * DM * 2;
constexpr size_t OFF_CTXX = OFF_H + (size_t)TT * DFF * 2;
constexpr size_t OFF_MOD = OFF_CTXX + (size_t)TC * DM * 4;
constexpr size_t OFF_ROPE = OFF_MOD + (size_t)2 * 5 * MODW * 4;
constexpr size_t OFF_S5A = OFF_ROPE + (size_t)SEQ * 32 * 8;
constexpr size_t OFF_S5B = OFF_S5A + (size_t)2 * 32 * 64 * 8;
constexpr size_t OFF_Q = OFF_S5B + (size_t)2 * 32 * 64 * 16 * 8;
constexpr size_t SZ_QKV = (size_t)NB * 8 * KEYS * 64 * 2;
constexpr size_t OFF_K = OFF_Q + SZ_QKV;
constexpr size_t OFF_V = OFF_K + SZ_QKV;
constexpr size_t OFF_G = OFF_V + SZ_QKV;
constexpr size_t OFF_ST = OFF_G + (size_t)TT * 512 * 2;
constexpr size_t SZ_ST = (size_t)NB * 2 * 32 * 264 * 64 * 8;
constexpr size_t OFF_LCIN = OFF_ST + (size_t)NB * 2 * 264 * 512 * 8;
constexpr size_t OFF_BAR = OFF_ST + SZ_ST;
constexpr size_t OFF_S5C = OFF_BAR + 16384;
constexpr size_t WS_END = OFF_S5C + (size_t)2 * 32 * 2 * 16 * 128 * 2;
static_assert(OFF_LCIN + (size_t)NB * 2 * 264 * 512 * 4 <= OFF_BAR, "lru regions");
static_assert(SZ_QKV / 4 + (size_t)NB * 32 * 264 * 64 * 8 <= SZ_QKV, "s5 carry-in regions");
constexpr int LDS_BYTES = 131072 + 16;

struct Params {
    const float *x, *c, *ctx, *c_ctx, *mod_w, *mod_b, *norm_g, *ffn1_w13, *ffn1_w2, *ffn2_w13, *ffn2_w2, *ev_w_in, *ev_w_out;
    const float *s5_lam_re, *s5_lam_im, *s5_log_dt, *s5_b_re, *s5_b_im, *s5_c_re, *s5_c_im, *s5_d, *s5_glu_w, *s5_glu_b, *swa_qk_g, *swa_sink;
    const float *od_w_in, *od_w_out, *lru_conv_w, *lru_conv_b, *lru_wa, *lru_ba, *lru_wx, *lru_bx, *lru_lam, *diff_qk_g, *diff_lam, *diff_sub_g;
    float* out;
    unsigned char* ws;
};

DI unsigned pk2(float lo, float hi) { f32x2 v = {lo, hi}; bf16x2_t r = __builtin_convertvector(v, bf16x2_t); return __builtin_bit_cast(unsigned, r); }
DI bf16_t f2bf(float x) { return (bf16_t)(pk2(x, 0.f) & 0xffffu); }
DI float bf2f(bf16_t v) { return __uint_as_float((unsigned)v << 16); }
DI float bflo(unsigned w) { return __uint_as_float(w << 16); }
DI float bfhi(unsigned w) { return __uint_as_float(w & 0xffff0000u); }
DI float wave_sum(float v) {
#pragma unroll
    for (int o = 32; o; o >>= 1) v += __shfl_xor(v, o);
    return v;
}
DI float wave_max(float v) {
#pragma unroll
    for (int o = 32; o; o >>= 1) v = fmaxf(v, __shfl_xor(v, o));
    return v;
}
DI float sigmoid_f(float x) { return __builtin_amdgcn_rcpf(1.f + __builtin_amdgcn_exp2f(-LOG2E * x)); }
DI float silu_f(float x) { return x * sigmoid_f(x); }
DI float gelu_tanh(float x) { const float u = 0.7978845608028654f * (x + 0.044715f * x * x * x); return x * sigmoid_f(2.f * u); }
#define LDS_FENCE() asm volatile("s_waitcnt lgkmcnt(0)" ::: "memory")
template <int V> struct IC { static constexpr int value = V; };
template <int I, int N, class F> DI void static_for(F&& f) { if constexpr (I < N) { f(IC<I>{}); static_for<I + 1, N>(f); } }

constexpr int BM = 256, BK = 64, HALF = 128, HT = HALF * BK, NXCD = 8, WGM = 8;
DI int lds_byte(int r, int c) { int st = (r >> 4) * 2 + (c >> 5), rr = r & 15, cc = c & 31, ob = rr * 64 + cc * 2; return st * 1024 + (ob ^ (((ob >> 9) & 1) << 5)); }
DI void stage_rc(int b, int& R, int& C) { int st = b / 1024, sb = b % 1024, swz = sb ^ (((sb >> 9) & 1) << 5); R = (st >> 1) * 16 + swz / 64; C = (st & 1) * 32 + (swz % 64) / 2; }

template <class Epi>
DI void gemm_phase(const int TID, const bf16_t* __restrict__ A, const bf16_t* __restrict__ Bt, int M, int N, int K, const Epi& epi, const int S = 1) {
    extern __shared__ __attribute__((aligned(16))) bf16_t shm[];
    int tidx = TID; asm volatile("" : "+v"(tidx));
#define SA(b, h) (shm + ((b) * 2 + (h)) * HT)
#define SB(b, h) (shm + (4 + (b) * 2 + (h)) * HT)
#define STAGE(P, BASE, br, kt) do { const char* _ub = (const char*)(BASE) + ((long)(br) * K + (long)((kt) + kbase) * BK) * 2; \
      __builtin_amdgcn_global_load_lds((const unsigned*)(_ub + voff0), (unsigned*)((char*)(P) + wv_s * 1024), 16, 0, 0); \
      __builtin_amdgcn_global_load_lds((const unsigned*)(_ub + voff1), (unsigned*)((char*)(P) + wv_s * 1024 + 8192), 16, 0, 0); } while (0)
#define LDA(dst, b, h) for (int m = 0; m < 4; ++m) for (int k = 0; k < 2; ++k) \
    dst[m][k] = *reinterpret_cast<const bf16x8*>((char*)SA(b, h) + lds_byte(wr * 64 + m * 16 + fr, k * 32 + fq * 8))
#define LDB(dst, b, h) for (int n = 0; n < 2; ++n) for (int k = 0; k < 2; ++k) \
    dst[n][k] = *reinterpret_cast<const bf16x8*>((char*)SB(b, h) + lds_byte(wc * 32 + n * 16 + fr, k * 32 + fq * 8))
#define MMA(ai, bj, At_, Bt_) do { __builtin_amdgcn_s_setprio(1); \
    for (int m = 0; m < 4; ++m) for (int n = 0; n < 2; ++n) for (int k = 0; k < 2; ++k) \
      acc[ai][bj][m][n] = __builtin_amdgcn_mfma_f32_16x16x32_bf16(Bt_[n][k], At_[m][k], acc[ai][bj][m][n], 0, 0, 0); \
    __builtin_amdgcn_s_setprio(0); } while (0)
#define WAIT_V(n) asm volatile("s_waitcnt vmcnt(" #n ")" ::: "memory")
#define WAIT_L(n) asm volatile("s_waitcnt lgkmcnt(" #n ")" ::: "memory")
#define BAR __builtin_amdgcn_s_barrier()
#define SCHED __builtin_amdgcn_sched_barrier(0)
    const int nM = M / BM, nN = N / BM, ntile = nM * nN, nwg = ntile * S;
    const int wid = tidx >> 6, lane = tidx & 63, wr = wid >> 2, wc = wid & 3, fr = lane & 15, fq = lane >> 4;
    const int nt = K / BK / S;
    const int wv_s = __builtin_amdgcn_readfirstlane(tidx >> 6);
    unsigned voff0, voff1;
    { int r_, c_; stage_rc(tidx * 16, r_, c_); voff0 = (unsigned)(r_ * K + c_) * 2u; stage_rc(tidx * 16 + 8192, r_, c_); voff1 = (unsigned)(r_ * K + c_) * 2u; }
#define TILE_COORDS(L_, pm_, pn_, kb_) do { int wgid = (int)(L_); \
        if (S == 1) { const int q = nwg / NXCD, r = nwg % NXCD, xcd = wgid % NXCD, off = wgid / NXCD; wgid = (xcd < r ? xcd * (q + 1) : r * (q + 1) + (xcd - r) * q) + off; kb_ = 0; } \
        else { kb_ = (wgid % S) * nt; wgid /= S; } \
        const int nig = WGM * nN, gid = wgid / nig, fm = gid * WGM, gsz = min(nM - fm, WGM); \
        pm_ = fm + ((wgid % nig) % gsz); pn_ = (wgid % nig) / gsz; } while (0)
#define STAGE_P1(brow_, bcol_) do { STAGE(SB(0, 0), Bt, bcol_, 0); STAGE(SA(0, 0), A, brow_, 0); STAGE(SB(0, 1), Bt, (bcol_) + HALF, 0); STAGE(SA(0, 1), A, (brow_) + HALF, 0); } while (0)
    long L = blockIdx.x;
    if (L >= nwg) return;
    int pm, pn, kbase;
    TILE_COORDS(L, pm, pn, kbase);
    STAGE_P1(pm * BM, pn * BM);
    for (;;) {
        const int brow = pm * BM, bcol = pn * BM;
        f32x4 acc[2][2][4][2] = {};
        bf16x8 At[4][2], B0[2][2], B1[2][2];
        if (wr == 1) BAR;
        WAIT_V(0); BAR;
        STAGE(SB(1, 0), Bt, bcol, 1); STAGE(SA(1, 0), A, brow, 1); STAGE(SB(1, 1), Bt, bcol + HALF, 1);
        WAIT_V(6); BAR;
        for (int t = 0; t < nt - 2; t += 2) {
            LDB(B0, 0, 0); SCHED; LDA(At, 0, 0); STAGE(SA(1, 1), A, brow + HALF, t + 1);
            WAIT_L(8); BAR; WAIT_L(0); MMA(0, 0, At, B0); BAR; SCHED;
            LDB(B1, 0, 1); STAGE(SB(0, 0), Bt, bcol, t + 2);
            BAR; WAIT_L(0); MMA(0, 1, At, B1); BAR;
            LDA(At, 0, 1); STAGE(SA(0, 0), A, brow, t + 2);
            BAR; WAIT_L(0); MMA(1, 0, At, B0); BAR; SCHED;
            STAGE(SB(0, 1), Bt, bcol + HALF, t + 2);
            WAIT_V(6); BAR; MMA(1, 1, At, B1); BAR;
            LDB(B0, 1, 0); SCHED; LDA(At, 1, 0); STAGE(SA(0, 1), A, brow + HALF, t + 2);
            WAIT_L(8); BAR; WAIT_L(0); MMA(0, 0, At, B0); BAR; SCHED;
            LDB(B1, 1, 1); STAGE(SB(1, 0), Bt, bcol, t + 3);
            BAR; WAIT_L(0); MMA(0, 1, At, B1); BAR;
            LDA(At, 1, 1); STAGE(SA(1, 0), A, brow, t + 3);
            BAR; WAIT_L(0); MMA(1, 0, At, B0); BAR; SCHED;
            STAGE(SB(1, 1), Bt, bcol + HALF, t + 3);
            WAIT_V(6); BAR; MMA(1, 1, At, B1); BAR;
        }
        { LDB(B0, 0, 0); LDA(At, 0, 0); STAGE(SA(1, 1), A, brow + HALF, nt - 1);
          BAR; WAIT_L(0); MMA(0, 0, At, B0); BAR;
          LDB(B1, 0, 1); BAR; WAIT_L(0); MMA(0, 1, At, B1); BAR;
          LDA(At, 0, 1); WAIT_V(4); BAR; WAIT_L(0); MMA(1, 0, At, B0); MMA(1, 1, At, B1); BAR; }
        { LDB(B0, 1, 0); LDA(At, 1, 0); WAIT_V(2); BAR; WAIT_L(0); MMA(0, 0, At, B0); BAR;
          LDB(B1, 1, 1); WAIT_V(0); BAR; WAIT_L(0); MMA(0, 1, At, B1); BAR;
          LDA(At, 1, 1); BAR; WAIT_L(0); MMA(1, 0, At, B0); MMA(1, 1, At, B1); BAR; }
        if (wr == 0) BAR;
        const int kbase_cur = kbase;
        L += gridDim.x;
        const bool has_next = L < nwg;
        int pm_n = 0, pn_n = 0, kb_n = 0;
        if (has_next) { TILE_COORDS(L, pm_n, pn_n, kb_n); kbase = kb_n; STAGE_P1(pm_n * BM, pn_n * BM); }
        asm volatile("" ::: "memory"); SCHED;
        { int t2 = TID; asm volatile("" : "+v"(t2));
          int pm2 = S == 1 ? pm : pm + (kbase_cur / nt) * nM, pn2 = pn; asm volatile("" : "+s"(pm2), "+s"(pn2));
          epi(acc, pm2, pn2, t2 >> 8, (t2 >> 6) & 3, t2 & 15, (t2 & 63) >> 4); }
        asm volatile("" ::: "memory"); SCHED;
        if (!has_next) break;
        pm = pm_n; pn = pn_n;
    }
#undef TILE_COORDS
#undef STAGE_P1
#undef SA
#undef SB
#undef STAGE
#undef LDA
#undef LDB
#undef MMA
}

struct EpiSwiglu {
    bf16_t* H;
    DI void operator()(const f32x4 (&acc)[2][2][4][2], int pm, int pn, int wr, int wc, int fr, int fq) const {
#pragma unroll
        for (int ai = 0; ai < 2; ++ai)
#pragma unroll
            for (int m = 0; m < 4; ++m) {
                const size_t row = (size_t)pm * BM + ai * HALF + wr * 64 + m * 16 + fr;
#pragma unroll
                for (int bj = 0; bj < 2; ++bj) {
                    const int hc = (pn * BM + bj * HALF + wc * 32) / 2 + 4 * fq;
                    const f32x4 g = acc[ai][bj][m][0], u = acc[ai][bj][m][1];
                    u32x2 w; w.x = pk2(silu_f(g[0]) * u[0], silu_f(g[1]) * u[1]); w.y = pk2(silu_f(g[2]) * u[2], silu_f(g[3]) * u[3]);
                    *(u32x2*)(H + row * DFF + hc) = w;
                }
            }
    }
};
struct EpiResid {
    const float *srcL, *srcC; float *dstL, *dstC; const float* gate  ; float coef;
    DI void operator()(const f32x4 (&acc)[2][2][4][2], int pm, int pn, int wr, int wc, int fr, int fq) const {
        const int row0 = pm * BM;
        const bool lat = row0 < TL;
        const float* src = lat ? srcL : srcC - (size_t)TL * DM;
        float* dst = lat ? dstL : dstC - (size_t)TL * DM;
        const int v = lat ? row0 / SEQ : 4;
        const int col0 = pn * BM + wc * 32 + 4 * fq;
        const float* gv = gate + (size_t)v * MODW + col0;
        f32x4 gt[2][2];
#pragma unroll
        for (int bj = 0; bj < 2; ++bj)
#pragma unroll
            for (int n = 0; n < 2; ++n) gt[bj][n] = *(const f32x4*)(gv + bj * HALF + n * 16) * coef;
#pragma unroll
        for (int ai = 0; ai < 2; ++ai)
#pragma unroll
            for (int m = 0; m < 4; ++m) {
                const size_t off = (size_t)(row0 + ai * HALF + wr * 64 + m * 16 + fr) * DM + col0;
                const float* sp = src + off; float* dp = dst + off;
                f32x4 s[2][2];
#pragma unroll
                for (int bj = 0; bj < 2; ++bj)
#pragma unroll
                    for (int n = 0; n < 2; ++n) s[bj][n] = *(const f32x4*)(sp + bj * HALF + n * 16);
#pragma unroll
                for (int bj = 0; bj < 2; ++bj)
#pragma unroll
                    for (int n = 0; n < 2; ++n) *(f32x4*)(dp + bj * HALF + n * 16) = s[bj][n] + gt[bj][n] * acc[ai][bj][m][n];
                asm volatile("" ::: "memory");
            }
    }
};
struct EpiPartial {
    float* part; const float* gate; float coef;
    DI void operator()(const f32x4 (&acc)[2][2][4][2], int pm, int pn, int wr, int wc, int fr, int fq) const {
        const int col0 = pn * BM + wc * 32 + 4 * fq;
        f32x4 gt[2][2];
#pragma unroll
        for (int bj = 0; bj < 2; ++bj)
#pragma unroll
            for (int n = 0; n < 2; ++n) gt[bj][n] = *(const f32x4*)(gate + col0 + bj * HALF + n * 16) * coef;
#pragma unroll
        for (int ai = 0; ai < 2; ++ai)
#pragma unroll
            for (int m = 0; m < 4; ++m) {
                float* dp = part + (size_t)(pm * BM + ai * HALF + wr * 64 + m * 16 + fr) * DM + col0;
#pragma unroll
                for (int bj = 0; bj < 2; ++bj)
#pragma unroll
                    for (int n = 0; n < 2; ++n) *(f32x4*)(dp + bj * HALF + n * 16) = gt[bj][n] * acc[ai][bj][m][n];
                asm volatile("" ::: "memory");
            }
    }
};
struct EpiStoreBf16 {
    bf16_t* Z; int ldz;
    DI void operator()(const f32x4 (&acc)[2][2][4][2], int pm, int pn, int wr, int wc, int fr, int fq) const {
#pragma unroll
        for (int ai = 0; ai < 2; ++ai)
#pragma unroll
            for (int m = 0; m < 4; ++m) {
                const size_t row = (size_t)pm * BM + ai * HALF + wr * 64 + m * 16 + fr;
#pragma unroll
                for (int bj = 0; bj < 2; ++bj)
#pragma unroll
                    for (int n = 0; n < 2; ++n) {
                        const int col = pn * BM + bj * HALF + wc * 32 + n * 16 + 4 * fq;
                        const f32x4 a = acc[ai][bj][m][n];
                        u32x2 w; w.x = pk2(a[0], a[1]); w.y = pk2(a[2], a[3]);
                        *(u32x2*)(Z + row * ldz + col) = w;
                    }
            }
    }
};
struct EpiGlu {
    const bf16_t* G; const float* bias; bf16_t* MIX;
    DI void operator()(const f32x4 (&acc)[2][2][4][2], int pm, int pn, int wr, int wc, int fr, int fq) const {
        const int col0 = pn * BM + wc * 32 + 4 * fq;
        f32x4 bv[2][2];
#pragma unroll
        for (int bj = 0; bj < 2; ++bj)
#pragma unroll
            for (int n = 0; n < 2; ++n) bv[bj][n] = *(const f32x4*)(bias + col0 + bj * HALF + n * 16);
#pragma unroll
        for (int ai = 0; ai < 2; ++ai)
#pragma unroll
            for (int m = 0; m < 4; ++m) {
                const size_t row = (size_t)pm * BM + ai * HALF + wr * 64 + m * 16 + fr;
                const bf16_t* gp = G + row * 512 + col0; bf16_t* mp = MIX + row * DM + col0;
#pragma unroll
                for (int bj = 0; bj < 2; ++bj)
#pragma unroll
                    for (int n = 0; n < 2; ++n) {
                        const u32x2 gw = *(const u32x2*)(gp + bj * HALF + n * 16);
                        const f32x4 a = acc[ai][bj][m][n] + bv[bj][n];
                        u32x2 w; w.x = pk2(bflo(gw.x) * sigmoid_f(a[0]), bfhi(gw.x) * sigmoid_f(a[1])); w.y = pk2(bflo(gw.y) * sigmoid_f(a[2]), bfhi(gw.y) * sigmoid_f(a[3]));
                        *(u32x2*)(mp + bj * HALF + n * 16) = w;
                    }
                asm volatile("" ::: "memory");
            }
    }
};

DI void transpose_item(const float* __restrict__ W, int K, int N, bf16_t* __restrict__ WT, int mode, float* scr, int item, int lane) {
    const int nblk = N / 32, kb = item / nblk, nb = item % nblk, k0 = 64 * kb, n0 = 32 * nb;
#pragma unroll 8
    for (int i = 0; i < 32; ++i) { const int kk = 2 * i + (lane >> 5); scr[kk * 33 + (lane & 31)] = W[(size_t)(k0 + kk) * N + n0 + (lane & 31)]; }
    LDS_FENCE();
    const int c = lane & 7;
#pragma unroll
    for (int j = 0; j < 4; ++j) {
        const int n = (lane >> 3) + 8 * j; const float* s = scr + (8 * c) * 33 + n;
        u32x4 o; o.x = pk2(s[0 * 33], s[1 * 33]); o.y = pk2(s[2 * 33], s[3 * 33]); o.z = pk2(s[4 * 33], s[5 * 33]); o.w = pk2(s[6 * 33], s[7 * 33]);
        const int nn = n0 + n;
        int row = nn;
        if (mode == 1) { const int jj = nn < DFF ? nn : nn - DFF; row = (jj >> 4) * 32 + (jj & 15) + (nn < DFF ? 0 : 16); }
        *(u32x4*)(WT + (size_t)row * K + k0 + 8 * c) = o;
    }
    LDS_FENCE();
}

DI void prologue_phase(const int TID, const Params& p) {
    extern __shared__ __attribute__((aligned(16))) float shf[];
    const int tid = TID, lane = tid & 63, wave = tid >> 6;
    unsigned char* ws = p.ws;
    {
        float* scr = shf + wave * (64 * 33);
        const int gw = blockIdx.x * 8 + wave, ngw = gridDim.x * 8;
        constexpr int I13 = (DM / 64) * (2 * DFF / 32), I2 = (DFF / 64) * (DM / 32);
        constexpr int IEI = (DM / 64) * (EVEN_IN / 32), IEO = (DM / 64) * (DM / 32), IGL = (512 / 64) * (512 / 32), IOI = (DM / 64) * (ODD_IN / 32), IOO = IEO;
        constexpr int NIT = 4 * (I13 + I2) + IEI + IEO + IGL + IOI + IOO;
        for (int it = gw; it < NIT; it += ngw) {
            int r = it;
            if (r < 4 * (I13 + I2)) {
                const int lf = r / (I13 + I2); r -= lf * (I13 + I2);
                const int l = lf >> 1, f = lf & 1;
                bf16_t* base = (bf16_t*)(ws + OFF_W + (size_t)lf * SZ_FFN);
                if (r < I13) transpose_item((f ? p.ffn2_w13 : p.ffn1_w13) + (size_t)l * DM * 2 * DFF, DM, 2 * DFF, base, 1, scr, r, lane);
                else transpose_item((f ? p.ffn2_w2 : p.ffn1_w2) + (size_t)l * DFF * DM, DFF, DM, (bf16_t*)((unsigned char*)base + SZ_W13), 0, scr, r - I13, lane);
                continue;
            }
            r -= 4 * (I13 + I2);
            if (r < IEI) { transpose_item(p.ev_w_in, DM, EVEN_IN, (bf16_t*)(ws + OFF_EVIN), 0, scr, r, lane); continue; } r -= IEI;
            if (r < IEO) { transpose_item(p.ev_w_out, DM, DM, (bf16_t*)(ws + OFF_EVOUT), 0, scr, r, lane); continue; } r -= IEO;
            if (r < IGL) { transpose_item(p.s5_glu_w, 512, 512, (bf16_t*)(ws + OFF_GLUW), 0, scr, r, lane); continue; } r -= IGL;
            if (r < IOI) { transpose_item(p.od_w_in, DM, ODD_IN, (bf16_t*)(ws + OFF_ODIN), 0, scr, r, lane); continue; } r -= IOI;
            transpose_item(p.od_w_out, DM, DM, (bf16_t*)(ws + OFF_ODOUT), 0, scr, r, lane);
        }
    }
    __syncthreads();
    {
        float* red = shf;
        float* sl = shf + 8 * 5 * 64;
        for (int idx = tid; idx < 5 * DM; idx += 512) { const int v = idx >> 10, k = idx & (DM - 1); sl[idx] = silu_f(v < 4 ? p.c[v * DM + k] : p.c_ctx[k]); }
        __syncthreads();
        float* MOD = (float*)(ws + OFF_MOD);
        for (int item = blockIdx.x; item < 2 * (MODW / 64); item += gridDim.x) {
            const int i = item / (MODW / 64), col = (item % (MODW / 64)) * 64 + lane;
            const float* W = p.mod_w + (size_t)i * DM * MODW + col;
            float a0 = 0.f, a1 = 0.f, a2 = 0.f, a3 = 0.f, a4 = 0.f;
            for (int k = wave * 128; k < wave * 128 + 128; ++k) {
                const float w = W[(size_t)k * MODW];
                a0 += sl[k] * w; a1 += sl[DM + k] * w; a2 += sl[2 * DM + k] * w; a3 += sl[3 * DM + k] * w; a4 += sl[4 * DM + k] * w;
            }
            __syncthreads();
            red[(wave * 5 + 0) * 64 + lane] = a0; red[(wave * 5 + 1) * 64 + lane] = a1; red[(wave * 5 + 2) * 64 + lane] = a2; red[(wave * 5 + 3) * 64 + lane] = a3; red[(wave * 5 + 4) * 64 + lane] = a4;
            __syncthreads();
            if (tid < 320) {
                const int v = tid >> 6; float s = 0.f;
#pragma unroll
                for (int w8 = 0; w8 < 8; ++w8) s += red[(w8 * 5 + v) * 64 + lane];
                MOD[((size_t)i * 5 + v) * MODW + col] = s + p.mod_b[(size_t)i * MODW + col];
            }
        }
    }
    {
        f32x4* dstc = (f32x4*)(ws + OFF_CTXX); const f32x4* srcc = (const f32x4*)p.ctx;
        for (int idx = blockIdx.x * 512 + tid; idx < TC * DM / 4; idx += gridDim.x * 512) dstc[idx] = srcc[idx];
    }
    {
        f32x2* ROPE = (f32x2*)(ws + OFF_ROPE);
        for (int idx = blockIdx.x * 512 + tid; idx < SEQ * 32; idx += gridDim.x * 512) {
            const int pos = idx >> 5, i = idx & 31;
            const float inv = powf(10000.0f, -(float)(i & 15) / 16.0f);
            const float ang = (float)(i < 16 ? pos / 64 : pos % 64) * inv;
            float sn, cs; sincosf(ang, &sn, &cs);
            ROPE[idx] = (f32x2){cs, sn};
        }
    }
    {
        f32x2* SA_ = (f32x2*)(ws + OFF_S5A); bf16_t* SB_ = (bf16_t*)(ws + OFF_S5B); bf16_t* SC_ = (bf16_t*)(ws + OFF_S5C);
        for (int idx = blockIdx.x * 512 + tid; idx < 2 * 32 * 64; idx += gridDim.x * 512) {
            const int dg = idx >> 6, pp = idx & 63;
            const float lr = p.s5_lam_re[idx], li = p.s5_lam_im[idx], dt = expf(p.s5_log_dt[dg]);
            const float mag = expf(lr * dt); float sn, cs; sincosf(li * dt, &sn, &cs);
            const float ar = mag * cs, ai = mag * sn, den = lr * lr + li * li;
            const float fr = ((ar - 1.f) * lr + ai * li) / den, fi = (ai * lr - (ar - 1.f) * li) / den;
            SA_[idx] = (f32x2){ar, ai};
#pragma unroll
            for (int hh = 0; hh < 16; ++hh) {
                const float br = p.s5_b_re[(size_t)idx * 16 + hh], bi = p.s5_b_im[(size_t)idx * 16 + hh];
                const float vr = fr * br - fi * bi, vi = fr * bi + fi * br;
                const bf16_t rh = f2bf(vr), ih = f2bf(vi);
                SB_[((size_t)(dg * 4 + 0) * 64 + pp) * 16 + hh] = rh; SB_[((size_t)(dg * 4 + 1) * 64 + pp) * 16 + hh] = f2bf(vr - bf2f(rh));
                SB_[((size_t)(dg * 4 + 2) * 64 + pp) * 16 + hh] = ih; SB_[((size_t)(dg * 4 + 3) * 64 + pp) * 16 + hh] = f2bf(vi - bf2f(ih));
            }
        }
        for (int idx = blockIdx.x * 512 + tid; idx < 2 * 32 * 16 * 128; idx += gridDim.x * 512) {
            const int k = idx & 127, hh = (idx >> 7) & 15, dg = idx >> 11;
            const float v = (k & 1) ? -p.s5_c_im[((size_t)dg * 16 + hh) * 64 + (k >> 1)] : p.s5_c_re[((size_t)dg * 16 + hh) * 64 + (k >> 1)];
            const bf16_t vh = f2bf(v);
            SC_[((size_t)(dg * 2 + 0) * 16 + hh) * 128 + k] = vh; SC_[((size_t)(dg * 2 + 1) * 16 + hh) * 128 + k] = f2bf(v - bf2f(vh));
        }
    }
}

DI void normmod_phase(const int TID, const float* __restrict__ xl, float* __restrict__ xc, const float* __restrict__ g, const float* __restrict__ modl, int i_shift, int i_scale,
                      bf16_t* __restrict__ XN, int nrows, const float* __restrict__ part, int nslice) {
    const int lane = TID & 63, wave = TID >> 6;
    for (int row = blockIdx.x * 8 + wave; row < nrows; row += gridDim.x * 8) {
        const float* xr = row < TL ? xl + (size_t)row * DM : xc + (size_t)(row - TL) * DM;
        const int v = row < TL ? row / SEQ : 4;
        const float* sh = modl + (size_t)v * MODW + i_shift * DM; const float* sc = modl + (size_t)v * MODW + i_scale * DM;
        f32x4 x[4]; float ss = 0.f;
#pragma unroll
        for (int j = 0; j < 4; ++j) x[j] = __builtin_nontemporal_load((const f32x4*)(xr + 256 * j + 4 * lane));
        if (row >= TL && nslice > 0) {
            for (int sl = 0; sl < nslice; ++sl)
#pragma unroll
                for (int j = 0; j < 4; ++j) x[j] += *(const f32x4*)(part + ((size_t)sl * TC + (row - TL)) * DM + 256 * j + 4 * lane);
#pragma unroll
            for (int j = 0; j < 4; ++j) *(f32x4*)(xc + (size_t)(row - TL) * DM + 256 * j + 4 * lane) = x[j];
        }
#pragma unroll
        for (int j = 0; j < 4; ++j) ss += x[j][0] * x[j][0] + x[j][1] * x[j][1] + x[j][2] * x[j][2] + x[j][3] * x[j][3];
        const float rstd = rsqrtf(wave_sum(ss) * (1.f / DM) + EPSN);
#pragma unroll
        for (int j = 0; j < 4; ++j) {
            const int col = 256 * j + 4 * lane;
            const f32x4 gg = *(const f32x4*)(g + col), s1 = *(const f32x4*)(sc + col), s0 = *(const f32x4*)(sh + col);
            const f32x4 y = (x[j] * rstd * gg) * (s1 + 1.0f) + s0;
            u32x2 w; w.x = pk2(y[0], y[1]); w.y = pk2(y[2], y[3]);
            *(u32x2*)(XN + (size_t)row * DM + col) = w;
        }
    }
}

DI void qkv_post_phase(const int TID, const Params& p, const bf16_t* __restrict__ Z, int ldz, int qcol, int nq, int kcol, int nk, int vcol, int nvh, int dv,
                       const float* __restrict__ gq, const float* __restrict__ gk) {
    extern __shared__ __attribute__((aligned(16))) unsigned char shb[];
    const int tid = TID, lane = tid & 63, wave = tid >> 6;
    bf16_t* Qh = (bf16_t*)(p.ws + OFF_Q); bf16_t* Kh = (bf16_t*)(p.ws + OFF_K); bf16_t* Vt = (bf16_t*)(p.ws + OFF_V);
    const f32x2* ROPE = (const f32x2*)(p.ws + OFF_ROPE);
    {
        const int hsub = lane >> 4, j = lane & 15, ngrp = (nk + 3) >> 2;
        const f32x4 gq4 = *(const f32x4*)(gq + 4 * j) * (0.125f * LOG2E), gk4 = *(const f32x4*)(gk + 4 * j);
        for (int item = blockIdx.x * 8 + wave; item < TT * ngrp; item += gridDim.x * 8) {
            const int row = item / ngrp, hh = nq + (item % ngrp) * 4 + hsub;
            const bool lat = row < TL, valid = hh < nq + nk, isq = hh < nq;
            const int b = lat ? row / SEQ : (row - TL) / CTXL;
            const int key = lat ? row % SEQ : SEQ + (row - TL) % CTXL;
            const int hd = isq ? hh : hh - nq;
            f32x4 x = {0.f, 0.f, 0.f, 0.f};
            if (valid) { const u32x2 w = *(const u32x2*)(Z + (size_t)row * ldz + (isq ? qcol : kcol) + hd * 64 + 4 * j); x = (f32x4){bflo(w.x), bfhi(w.x), bflo(w.y), bfhi(w.y)}; }
            float ss = x[0] * x[0] + x[1] * x[1] + x[2] * x[2] + x[3] * x[3];
            ss += __shfl_xor(ss, 1); ss += __shfl_xor(ss, 2); ss += __shfl_xor(ss, 4); ss += __shfl_xor(ss, 8);
            const float rstd = rsqrtf(ss * (1.f / 64.f) + EPSN);
            f32x4 y = x * rstd * (isq ? gq4 : gk4);
            f32x4 o; o[0] = __shfl_xor(y[0], 8); o[1] = __shfl_xor(y[1], 8); o[2] = __shfl_xor(y[2], 8); o[3] = __shfl_xor(y[3], 8);
            if (lat) {
                const f32x2* cs = ROPE + key * 32 + 4 * (j & 7);
#pragma unroll
                for (int e = 0; e < 4; ++e) { const f32x2 c = cs[e]; y[e] = j < 8 ? y[e] * c[0] - o[e] * c[1] : o[e] * c[1] + y[e] * c[0]; }
            }
            if (valid) {
                bf16_t* dst = (isq ? Qh + ((size_t)(b * nq + hd) * KEYS + key) * 64 : Kh + ((size_t)(b * nk + hd) * KEYS + key) * 64);
                u32x2 w; w.x = pk2(y[0], y[1]); w.y = pk2(y[2], y[3]);
                *(u32x2*)(dst + 4 * j) = w;
            }
        }
    }
    const int vc = nvh * dv, pitch = vc * 2 + 16;
    for (int item = blockIdx.x; item < TT / 64; item += gridDim.x) {
        const int row0 = item * 64;
        const bool lat = row0 < TL;
        const int b = lat ? row0 / SEQ : (row0 - TL) / CTXL;
        const int key0 = lat ? row0 % SEQ : SEQ + (row0 - TL) % CTXL;
        __syncthreads();
        for (int c = tid; c < 64 * (vc / 8); c += 512) {
            const int r = c / (vc / 8), cc = c % (vc / 8);
            *(u32x4*)(shb + r * pitch + cc * 16) = *(const u32x4*)(Z + (size_t)(row0 + r) * ldz + vcol + cc * 8);
        }
        __syncthreads();
        for (int idx = tid; idx < vc * 8; idx += 512) {
            const int tch = idx & 7, col = idx >> 3;
            unsigned short e[8];
#pragma unroll
            for (int k = 0; k < 8; ++k) e[k] = *(const unsigned short*)(shb + (8 * tch + k) * pitch + col * 2);
            u32x4 o; o.x = e[0] | ((unsigned)e[1] << 16); o.y = e[2] | ((unsigned)e[3] << 16); o.z = e[4] | ((unsigned)e[5] << 16); o.w = e[6] | ((unsigned)e[7] << 16);
            const int hd = col / dv, d = col % dv;
            *(u32x4*)(Vt + ((size_t)(b * nvh + hd) * dv + d) * KEYS + key0 + 8 * tch) = o;
        }
    }
}

#define MFMA32(a, b, c) __builtin_amdgcn_mfma_f32_32x32x16_bf16((a), (b), (c), 0, 0, 0)
constexpr int KP = 144, VP = 136;
constexpr int KT_BYTES = 64 * KP;

template <int NDT>
DI void attn_tile(const unsigned char* Kt, const unsigned char* Vtile, const bf16x8 (&qf)[4], f32x16 (&o)[NDT], float& l, float c1, float c2, int r, int h,
                  bool domask, int qk0  ) {
#pragma unroll
    for (int sub = 0; sub < 2; ++sub) {
        f32x16 st;
#pragma unroll
        for (int i = 0; i < 16; ++i) st[i] = -c2;
#pragma unroll
        for (int s = 0; s < 4; ++s) {
            const bf16x8 kf = *(const bf16x8*)(Kt + (32 * sub + r) * KP + (16 * s + 8 * h) * 2);
            st = MFMA32(kf, qf[s], st);
        }
        float pv[16];
#pragma unroll
        for (int i = 0; i < 16; ++i) {
            float e = __builtin_amdgcn_exp2f(st[i]);
            if (domask) { const int dd = qk0 - (32 * sub + (i & 3) + 8 * (i >> 2) + 4 * h); if (dd > 128 || dd < -128) e = 0.f; }
            pv[i] = e; l += e;
        }
        u32x4 w0, w1;
        w0.x = pk2(pv[0], pv[1]); w0.y = pk2(pv[2], pv[3]); w0.z = pk2(pv[4], pv[5]); w0.w = pk2(pv[6], pv[7]);
        w1.x = pk2(pv[8], pv[9]); w1.y = pk2(pv[10], pv[11]); w1.z = pk2(pv[12], pv[13]); w1.w = pk2(pv[14], pv[15]);
        const bf16x8 pf0 = __builtin_bit_cast(bf16x8, w0), pf1 = __builtin_bit_cast(bf16x8, w1);
#pragma unroll
        for (int dt = 0; dt < NDT; ++dt) {
#pragma unroll
            for (int s2 = 0; s2 < 2; ++s2) {
                const unsigned char* vp = Vtile + (32 * dt + r) * VP + (32 * sub + 16 * s2 + 4 * h) * 2;
                const s16x4 lo = *(const s16x4*)vp, hi = *(const s16x4*)(vp + 16);
                const bf16x8 vf = __builtin_shufflevector(lo, hi, 0, 1, 2, 3, 4, 5, 6, 7);
                o[dt] = MFMA32(vf, s2 ? pf1 : pf0, o[dt]);
            }
        }
    }
}

DI void load_q_frags(const bf16_t* __restrict__ zq, const float* __restrict__ gq, const f32x2* __restrict__ rope, int h, bf16x8 (&qf)[4]) {
    float x[4][8]; float ss = 0.f;
#pragma unroll
    for (int s = 0; s < 4; ++s) {
        const u32x4 w = *(const u32x4*)(zq + 16 * s + 8 * h);
        x[s][0] = bflo(w.x); x[s][1] = bfhi(w.x); x[s][2] = bflo(w.y); x[s][3] = bfhi(w.y); x[s][4] = bflo(w.z); x[s][5] = bfhi(w.z); x[s][6] = bflo(w.w); x[s][7] = bfhi(w.w);
#pragma unroll
        for (int j = 0; j < 8; ++j) ss += x[s][j] * x[s][j];
    }
    ss += __shfl_xor(ss, 32);
    const float rstd = rsqrtf(ss * (1.f / 64.f) + EPSN);
#pragma unroll
    for (int s = 0; s < 4; ++s)
#pragma unroll
        for (int j = 0; j < 8; ++j) x[s][j] = x[s][j] * rstd * (gq[16 * s + 8 * h + j] * (0.125f * LOG2E));
    if (rope) {
#pragma unroll
        for (int s = 0; s < 2; ++s)
#pragma unroll
            for (int j = 0; j < 8; ++j) {
                const f32x2 c = rope[16 * s + 8 * h + j];
                const float a = x[s][j], bq = x[s + 2][j];
                x[s][j] = a * c[0] - bq * c[1]; x[s + 2][j] = a * c[1] + bq * c[0];
            }
    }
#pragma unroll
    for (int s = 0; s < 4; ++s) {
        u32x4 w; w.x = pk2(x[s][0], x[s][1]); w.y = pk2(x[s][2], x[s][3]); w.z = pk2(x[s][4], x[s][5]); w.w = pk2(x[s][6], x[s][7]);
        qf[s] = __builtin_bit_cast(bf16x8, w);
    }
}

DI void diff_attn_phase(const int TID, const Params& p, const bf16_t* __restrict__ Z, bf16_t* __restrict__ MIX, float lam_init) {
    extern __shared__ __attribute__((aligned(16))) unsigned char smb[];
    const int tid = TID, lane = tid & 63, wave = tid >> 6, r = lane & 31, h = lane >> 5, rg = wave & 3, m = wave >> 2;
    const bf16_t* Qh = (const bf16_t*)(p.ws + OFF_Q); const bf16_t* Kh = (const bf16_t*)(p.ws + OFF_K); const bf16_t* Vt = (const bf16_t*)(p.ws + OFF_V);
    const float gqm = wave_max(fabsf(p.diff_qk_g[lane])), gkm = wave_max(fabsf(p.diff_qk_g[64 + lane]));
    const float c1 = 0.125f * LOG2E, c2 = 8.f * gqm * gkm * LOG2E;
    const float lam = expf(wave_sum(p.diff_lam[lane] * p.diff_lam[64 + lane])) - expf(wave_sum(p.diff_lam[128 + lane] * p.diff_lam[192 + lane])) + lam_init;
    constexpr int BUFSZ = 2 * KT_BYTES + 128 * VP;
    for (int unit = blockIdx.x; unit < NB * 4 * (SEQ / 128); unit += gridDim.x) {
        const int b = unit >> 8, rem = unit & 255, qb = rem >> 2, hd = rem & 3;
        bf16x8 qf[4];
        { const int qpos_ = qb * 128 + rg * 32 + r;
          load_q_frags(Z + (size_t)(b * SEQ + qpos_) * ODD_IN + 1024 + (2 * hd + m) * 64, p.diff_qk_g, (const f32x2*)(p.ws + OFF_ROPE) + qpos_ * 32, h, qf); }
        const bf16_t* K0g = Kh + (size_t)(b * 8 + 2 * hd) * KEYS * 64;
        const bf16_t* Vg = Vt + (size_t)(b * 4 + hd) * 128 * KEYS;
        f32x16 o[4];
#pragma unroll
        for (int dt = 0; dt < 4; ++dt)
#pragma unroll
            for (int i = 0; i < 16; ++i) o[dt][i] = 0.f;
        float l = 0.f;
        u32x4 pre[4];
        const int kkey = (tid & 511) >> 3, kch = tid & 7;
#define DIFF_LOAD(t) do { const int key0_ = (t) * 64; \
            pre[0] = *(const u32x4*)(K0g + (size_t)(key0_ + kkey) * 64 + kch * 8); \
            pre[1] = *(const u32x4*)(K0g + (size_t)KEYS * 64 + (size_t)(key0_ + kkey) * 64 + kch * 8); \
            pre[2] = *(const u32x4*)(Vg + (size_t)(tid >> 3) * KEYS + key0_ + kch * 8); \
            pre[3] = *(const u32x4*)(Vg + (size_t)((tid >> 3) + 64) * KEYS + key0_ + kch * 8); } while (0)
        DIFF_LOAD(0);
        for (int t = 0; t < KEYS / 64; ++t) {
            unsigned char* buf = smb + (t & 1) * BUFSZ;
            *(u32x4*)(buf + kkey * KP + kch * 16) = pre[0];
            *(u32x4*)(buf + KT_BYTES + kkey * KP + kch * 16) = pre[1];
            { unsigned char* vq = buf + 2 * KT_BYTES + (tid >> 3) * VP + kch * 16;
              *(u32x2*)vq = (u32x2){pre[2].x, pre[2].y}; *(u32x2*)(vq + 8) = (u32x2){pre[2].z, pre[2].w};
              vq += 64 * VP;
              *(u32x2*)vq = (u32x2){pre[3].x, pre[3].y}; *(u32x2*)(vq + 8) = (u32x2){pre[3].z, pre[3].w}; }
            __syncthreads();
            if (t + 1 < KEYS / 64) DIFF_LOAD(t + 1);
            attn_tile<4>(buf + m * KT_BYTES, buf + 2 * KT_BYTES, qf, o, l, c1, c2, r, h, false, 0);
        }
#undef DIFF_LOAD
        l += __shfl_xor(l, 32);
        __syncthreads();
        float* X = (float*)smb;
        if (m == 1) {
            const float inv = lam / l;
#pragma unroll
            for (int dt = 0; dt < 4; ++dt)
#pragma unroll
                for (int i = 0; i < 16; ++i) X[(rg * 64 + lane) * 65 + dt * 16 + i] = o[dt][i] * inv;
        }
        __syncthreads();
        if (m == 0) {
            const float inv = 1.f / l; float ss = 0.f;
#pragma unroll
            for (int dt = 0; dt < 4; ++dt)
#pragma unroll
                for (int i = 0; i < 16; ++i) { const float v = o[dt][i] * inv - X[(rg * 64 + lane) * 65 + dt * 16 + i]; o[dt][i] = v; ss += v * v; }
            ss += __shfl_xor(ss, 32);
            const float rstd = rsqrtf(ss * (1.f / 128.f) + EPSN) * (1.f - lam_init);
            bf16_t* orow = MIX + (size_t)(b * SEQ + qb * 128 + rg * 32 + r) * DM + 512 + hd * 128;
#pragma unroll
            for (int dt = 0; dt < 4; ++dt)
#pragma unroll
                for (int g4 = 0; g4 < 4; ++g4) {
                    const int d = 32 * dt + 8 * g4 + 4 * h;
                    const f32x4 sg = *(const f32x4*)(p.diff_sub_g + d);
                    u32x2 w; w.x = pk2(o[dt][4 * g4] * rstd * sg[0], o[dt][4 * g4 + 1] * rstd * sg[1]); w.y = pk2(o[dt][4 * g4 + 2] * rstd * sg[2], o[dt][4 * g4 + 3] * rstd * sg[3]);
                    *(u32x2*)(orow + d) = w;
                }
        }
        __syncthreads();
    }
}

DI void swa_attn_phase(const int TID, const Params& p, const bf16_t* __restrict__ Z, bf16_t* __restrict__ MIX) {
    extern __shared__ __attribute__((aligned(16))) unsigned char smb[];
    const int tid = TID, lane = tid & 63, wave = tid >> 6, r = lane & 31, h = lane >> 5, rg = wave & 3, hh = wave >> 2;
    const bf16_t* Qh = (const bf16_t*)(p.ws + OFF_Q); const bf16_t* Kh = (const bf16_t*)(p.ws + OFF_K); const bf16_t* Vt = (const bf16_t*)(p.ws + OFF_V);
    const float gqm = wave_max(fabsf(p.swa_qk_g[lane])), gkm = wave_max(fabsf(p.swa_qk_g[64 + lane]));
    const float mb = 8.f * gqm * gkm, c1 = 0.125f * LOG2E, c2 = mb * LOG2E;
    constexpr int BUFSZ = KT_BYTES + 64 * VP;
    constexpr int NLAT = NB * (SEQ / 128) * 4, NCTX = NB * (CTXL / 128) * 4;
    for (int unit = blockIdx.x; unit < NLAT + NCTX; unit += gridDim.x) {
        const bool cq = unit >= NLAT;
        int b, qb, kv, pr;
        if (!cq) { b = unit >> 8; const int rem = unit & 255; qb = rem >> 2; kv = (rem >> 1) & 1; pr = rem & 1; }
        else { const int u2 = unit - NLAT; b = u2 >> 3; const int rem = u2 & 7; qb = rem >> 2; kv = (rem >> 1) & 1; pr = rem & 1; }
        const int head = 4 * kv + 2 * pr + hh;
        const int qpos = qb * 128 + rg * 32 + r;
        bf16x8 qf[4];
        load_q_frags(Z + (size_t)(cq ? TL + b * CTXL + qpos : b * SEQ + qpos) * EVEN_IN + 512 + head * 64, p.swa_qk_g, cq ? (const f32x2*)nullptr : (const f32x2*)(p.ws + OFF_ROPE) + qpos * 32, h, qf);
        const bf16_t* Kg = Kh + (size_t)(b * 2 + kv) * KEYS * 64;
        const bf16_t* Vg = Vt + (size_t)(b * 2 + kv) * 64 * KEYS;
        const int tlo = cq ? 0 : max(0, 2 * qb - 2), thi = cq ? -1 : min(SEQ / 64 - 1, 2 * qb + 3), nloc = thi - tlo + 1, ntile = nloc + CTXL / 64;
        f32x16 o[2];
#pragma unroll
        for (int dt = 0; dt < 2; ++dt)
#pragma unroll
            for (int i = 0; i < 16; ++i) o[dt][i] = 0.f;
        float l = 0.f;
        u32x4 pre[2];
        const int kkey = tid >> 3, kch = tid & 7;
#define SWA_TI(i) ((i) < nloc ? tlo + (i) : SEQ / 64 + ((i) - nloc))
#define SWA_LOAD(i) do { const int key0_ = SWA_TI(i) * 64; \
            pre[0] = *(const u32x4*)(Kg + (size_t)(key0_ + kkey) * 64 + kch * 8); \
            pre[1] = *(const u32x4*)(Vg + (size_t)kkey * KEYS + key0_ + kch * 8); } while (0)
        SWA_LOAD(0);
        for (int t = 0; t < ntile; ++t) {
            unsigned char* buf = smb + (t & 1) * BUFSZ;
            *(u32x4*)(buf + kkey * KP + kch * 16) = pre[0];
            { unsigned char* vq = buf + KT_BYTES + kkey * VP + kch * 16;
              *(u32x2*)vq = (u32x2){pre[1].x, pre[1].y}; *(u32x2*)(vq + 8) = (u32x2){pre[1].z, pre[1].w}; }
            __syncthreads();
            if (t + 1 < ntile) SWA_LOAD(t + 1);
            const int key0t = SWA_TI(t) * 64, qlo = qb * 128 + rg * 32;
            if (!(t < nloc && (key0t > qlo + 31 + 128 || key0t + 63 < qlo - 128)))
                attn_tile<2>(buf, buf + KT_BYTES, qf, o, l, c1, c2, r, h, t < nloc, qpos - key0t);
        }
#undef SWA_LOAD
#undef SWA_TI
        l += __shfl_xor(l, 32);
        l += __builtin_amdgcn_exp2f((p.swa_sink[head] - mb) * LOG2E);
        const float inv = 1.f / l;
        bf16_t* orow = MIX + (size_t)(cq ? TL + b * CTXL + qpos : b * SEQ + qpos) * DM + 512 + head * 64;
#pragma unroll
        for (int dt = 0; dt < 2; ++dt)
#pragma unroll
            for (int g4 = 0; g4 < 4; ++g4) {
                const int d = 32 * dt + 8 * g4 + 4 * h;
                u32x2 w; w.x = pk2(o[dt][4 * g4] * inv, o[dt][4 * g4 + 1] * inv); w.y = pk2(o[dt][4 * g4 + 2] * inv, o[dt][4 * g4 + 3] * inv);
                *(u32x2*)(orow + d) = w;
            }
        __syncthreads();
    }
}

DI float fma_s(float a, float b, float c) { float r; asm volatile("v_fma_f32 %0, %1, %2, %3" : "=v"(r) : "v"(a), "v"(b), "v"(c)); return r; }
DI void cmad(float& xr, float& xi, float ar, float ai, float br, float bi) {
    const float nr = fma_s(-xi, ai, fma_s(xr, ar, br)), ni = fma_s(xi, ar, fma_s(xr, ai, bi));
    xr = nr; xi = ni;
}
template <bool FWD, int Q> DI void s5_quad(const f32x16& br, const f32x16& bi, float ar, float ai, float& Br, float& Bi) {
    constexpr int i0 = FWD ? 4 * Q : 4 * Q + 3, st = FWD ? 1 : -1;
    Br = br[i0]; Bi = bi[i0];
    cmad(Br, Bi, ar, ai, br[i0 + st], bi[i0 + st]); cmad(Br, Bi, ar, ai, br[i0 + 2 * st], bi[i0 + 2 * st]); cmad(Br, Bi, ar, ai, br[i0 + 3 * st], bi[i0 + 3 * st]);
}
DI void s5_bu(const bf16_t* __restrict__ SBq  , bf16x8 af, int pt, int r, int h, f32x16& bur, f32x16& bui) {
#pragma unroll
    for (int i = 0; i < 16; ++i) { bur[i] = 0.f; bui[i] = 0.f; }
    const bf16_t* bp = SBq + (size_t)(pt * 32 + r) * 16 + 8 * h;
    bur = MFMA32(af, *(const bf16x8*)(bp), bur); bur = MFMA32(af, *(const bf16x8*)(bp + 1024), bur);
    bui = MFMA32(af, *(const bf16x8*)(bp + 2048), bui); bui = MFMA32(af, *(const bf16x8*)(bp + 3072), bui);
    float one; asm volatile("v_mov_b32 %0, 1.0" : "=v"(one));
#pragma unroll
    for (int i = 0; i < 16; ++i) { bur[i] *= one; bui[i] *= one; }
}
DI f32x2* s5_cin(unsigned char* ws, int b, int dir, int g) { return (f32x2*)(ws + (dir ? OFF_V : OFF_K) + SZ_QKV / 4) + (size_t)(b * 32 + g) * 264 * 64; }
DI void s5_chunk(int item, int& b, int& g, int& ck, int& row0) {
    ck = item % 264; g = (item / 264) & 31; b = item / (264 * 32);
    row0 = ck < 8 ? TL + b * CTXL + ck * 32 : b * SEQ + (ck - 8) * 32;
}
DI void s5_passA(const int TID, const Params& p, const bf16_t* __restrict__ Z) {
    const int lane = TID & 63, wave = TID >> 6, r = lane & 31, h = lane >> 5;
    const f32x2* SAp = (const f32x2*)(p.ws + OFF_S5A); const bf16_t* SBp = (const bf16_t*)(p.ws + OFF_S5B); f32x2* ST = (f32x2*)(p.ws + OFF_ST);
    for (int item = blockIdx.x * 8 + wave; item < NB * 32 * 264; item += gridDim.x * 8) {
        int b, g, ck, row0; s5_chunk(item, b, g, ck, row0);
        const bf16x8 af = *(const bf16x8*)(Z + (size_t)(row0 + r) * EVEN_IN + g * 16 + 8 * h);
        static_for<0, 2>([&](auto dc) {
            constexpr int dir = decltype(dc)::value;
            static_for<0, 2>([&](auto pc) {
                constexpr int pt = decltype(pc)::value;
                f32x16 bur, bui;
                s5_bu(SBp + (size_t)(dir * 32 + g) * 4096, af, pt, r, h, bur, bui);
                const f32x2 A = SAp[(dir * 32 + g) * 64 + pt * 32 + r];
                float a2r = A[0] * A[0] - A[1] * A[1], a2i = 2.f * A[0] * A[1];
                const float a4r = a2r * a2r - a2i * a2i, a4i = 2.f * a2r * a2i, a8r = a4r * a4r - a4i * a4i, a8i = 2.f * a4r * a4i;
                float Er = 0.f, Ei = 0.f;
                static_for<0, 4>([&](auto kc) {
                    constexpr int q = dir ? 3 - decltype(kc)::value : decltype(kc)::value;
                    float Br, Bi; s5_quad<dir == 0, q>(bur, bui, A[0], A[1], Br, Bi);
                    const float Pr = __shfl_xor(Br, 32), Pi = __shfl_xor(Bi, 32);
                    const bool own_first = (dir == 0) ? (h == 0) : (h == 1);
                    float fr = own_first ? Br : Pr, fi = own_first ? Bi : Pi; const float sr = own_first ? Pr : Br, si = own_first ? Pi : Bi;
                    cmad(fr, fi, a4r, a4i, sr, si);
                    cmad(Er, Ei, a8r, a8i, fr, fi);
                });
                if (h == 0) ST[((size_t)((b * 2 + dir) * 32 + g) * 264 + ck) * 64 + pt * 32 + r] = (f32x2){Er, Ei};
            });
        });
    }
}
DI void s5_passB(const int TID, const Params& p) {
    const f32x2* SAp = (const f32x2*)(p.ws + OFF_S5A); f32x2* ST = (f32x2*)(p.ws + OFF_ST);
    for (int idx = blockIdx.x * 512 + TID; idx < NB * 2 * 32 * 64; idx += gridDim.x * 512) {
        const int pp = idx & 63, bdg = idx >> 6, dir = (bdg >> 5) & 1;
        const f32x2 A = SAp[(bdg & 63) * 64 + pp];
        float ar = A[0], ai = A[1];
#pragma unroll
        for (int q = 0; q < 5; ++q) { const float nr = ar * ar - ai * ai; ai = 2.f * ar * ai; ar = nr; }
        float sr = 0.f, si = 0.f;
        const f32x2* e0 = ST + (size_t)bdg * 264 * 64 + pp;
        f32x2* c0 = s5_cin(p.ws, bdg >> 6, dir, bdg & 31) + pp;
        for (int v0 = 0; v0 < 264; v0 += 12) {
            f32x2 E[12];
#pragma unroll
            for (int k = 0; k < 12; ++k) { const int v = v0 + k; const int ck = dir == 0 ? v : (v < 8 ? 7 - v : 263 - (v - 8)); E[k] = e0[(size_t)ck * 64]; }
#pragma unroll
            for (int k = 0; k < 12; ++k) {
                const int v = v0 + k; const int ck = dir == 0 ? v : (v < 8 ? 7 - v : 263 - (v - 8));
                c0[(size_t)ck * 64] = (f32x2){sr, si};
                cmad(sr, si, ar, ai, E[k][0], E[k][1]);
            }
        }
    }
}
constexpr int HSP = 272;
DI void s5_passC(const int TID, const Params& p, const bf16_t* __restrict__ Z, bf16_t* __restrict__ G) {
    extern __shared__ __attribute__((aligned(16))) unsigned char smb[];
    const int lane = TID & 63, wave = TID >> 6, r = lane & 31, h = lane >> 5, c16 = lane & 15, kg = lane >> 4;
    unsigned char* Hs = smb + wave * (32 * HSP);
    const f32x2* SAp = (const f32x2*)(p.ws + OFF_S5A); const bf16_t* SBp = (const bf16_t*)(p.ws + OFF_S5B); const bf16_t* SCp = (const bf16_t*)(p.ws + OFF_S5C);
    const f32x2* ST = (const f32x2*)(p.ws + OFF_ST);
    for (int item = blockIdx.x * 8 + wave; item < NB * 32 * 264; item += gridDim.x * 8) {
        int b, g, ck, row0; s5_chunk(item, b, g, ck, row0);
        const bf16x8 af = *(const bf16x8*)(Z + (size_t)(row0 + r) * EVEN_IN + g * 16 + 8 * h);
        f32x4 yacc[2] = {{0.f, 0.f, 0.f, 0.f}, {0.f, 0.f, 0.f, 0.f}};
        static_for<0, 2>([&](auto dc) {
            constexpr int dir = decltype(dc)::value;
            static_for<0, 2>([&](auto pc) {
                constexpr int pt = decltype(pc)::value;
                f32x16 bur, bui;
                s5_bu(SBp + (size_t)(dir * 32 + g) * 4096, af, pt, r, h, bur, bui);
                const f32x2 A = SAp[(dir * 32 + g) * 64 + pt * 32 + r];
                float a2r = A[0] * A[0] - A[1] * A[1], a2i = 2.f * A[0] * A[1];
                const float a4r = a2r * a2r - a2i * a2i, a4i = 2.f * a2r * a2i, a8r = a4r * a4r - a4i * a4i, a8i = 2.f * a4r * a4i;
                const f32x2 cin = s5_cin(p.ws, b, dir, g)[(size_t)ck * 64 + pt * 32 + r];
                float Sr = cin[0], Si = cin[1];
                static_for<0, 4>([&](auto kc) {
                    constexpr int q = dir ? 3 - decltype(kc)::value : decltype(kc)::value;
                    float Br, Bi; s5_quad<dir == 0, q>(bur, bui, A[0], A[1], Br, Bi);
                    const float Pr = __shfl_xor(Br, 32), Pi = __shfl_xor(Bi, 32);
                    const bool own_first = (dir == 0) ? (h == 0) : (h == 1);
                    float er = Sr, ei = Si;
                    if (!own_first) cmad(er, ei, a4r, a4i, Pr, Pi);
                    float fr = own_first ? Br : Pr, fi = own_first ? Bi : Pi; const float sr = own_first ? Pr : Br, si = own_first ? Pi : Bi;
                    cmad(fr, fi, a4r, a4i, sr, si);
                    cmad(Sr, Si, a8r, a8i, fr, fi);
                    static_for<0, 4>([&](auto jc) {
                        constexpr int i = dir ? 4 * q + 3 - decltype(jc)::value : 4 * q + decltype(jc)::value;
                        cmad(er, ei, A[0], A[1], bur[i], bui[i]);
                        *(unsigned*)(Hs + (8 * (i >> 2) + 4 * h + (i & 3)) * HSP + (pt * 32 + r) * 4) = pk2(er, ei);
                    });
                });
            });
            LDS_FENCE();
            const bf16_t* cp = SCp + (size_t)(dir * 32 + g) * 2 * 16 * 128 + (size_t)c16 * 128 + 8 * kg;
#pragma unroll
            for (int tt = 0; tt < 2; ++tt)
#pragma unroll
                for (int ks = 0; ks < 4; ++ks) {
                    const bf16x8 hf = *(const bf16x8*)(Hs + (16 * tt + c16) * HSP + (32 * ks + 8 * kg) * 2);
                    yacc[tt] = __builtin_amdgcn_mfma_f32_16x16x32_bf16(hf, *(const bf16x8*)(cp + 32 * ks), yacc[tt], 0, 0, 0);
                    yacc[tt] = __builtin_amdgcn_mfma_f32_16x16x32_bf16(hf, *(const bf16x8*)(cp + 2048 + 32 * ks), yacc[tt], 0, 0, 0);
                }
            LDS_FENCE();
        });
        const float dsk = p.s5_d[g * 16 + c16];
#pragma unroll
        for (int tt = 0; tt < 2; ++tt)
#pragma unroll
            for (int i = 0; i < 4; ++i) {
                const size_t row = (size_t)row0 + 16 * tt + 4 * kg + i;
                const float u = bf2f(Z[row * EVEN_IN + g * 16 + c16]);
                G[row * 512 + g * 16 + c16] = f2bf(gelu_tanh(yacc[tt][i] + dsk * u));
            }
    }
}

constexpr int WLP = 144;
DI void lru_load_wl(const int TID, const Params& p, int n, unsigned char* WL, float* CW) {
    for (int idx = TID; idx < 4 * 4096; idx += 512) {
        const int mat = idx >> 12, de = idx & 4095, d = de >> 6, e = de & 63, dir = mat >> 1;
        const float* src = (mat & 1) ? p.lru_wx : p.lru_wa;
        *(bf16_t*)(WL + mat * 64 * WLP + e * WLP + d * 2) = f2bf(src[(size_t)(dir * 8 + n) * 4096 + de]);
    }
    for (int idx = TID; idx < 4096; idx += 512) { const int e = idx >> 6, d = idx & 63; *(bf16_t*)(WL + 4 * 64 * WLP + e * WLP + d * 2) = (e == d) ? (bf16_t)0x3F80 : (bf16_t)0; }
    if (TID < 320) { const int k = TID >> 6, d = TID & 63; CW[TID] = k < 4 ? p.lru_conv_w[k * 512 + n * 64 + d] : p.lru_conv_b[n * 64 + d]; }
}
DI void lru_afrag(const bf16_t* __restrict__ zr, int t, int seq_len, const float* CW, int h, bf16x8 (&af)[4]) {
#pragma unroll
    for (int s = 0; s < 4; ++s) {
        const int d0 = 16 * s + 8 * h;
        float x[8];
#pragma unroll
        for (int j = 0; j < 8; ++j) x[j] = CW[256 + d0 + j];
#pragma unroll
        for (int k = 0; k < 4; ++k) {
            const int tt = t + k - 2;
            if (tt >= 0 && tt < seq_len) {
                const u32x4 v = *(const u32x4*)(zr + (size_t)tt * ODD_IN + d0);
                const float* w = CW + k * 64 + d0;
                x[0] += bflo(v.x) * w[0]; x[1] += bfhi(v.x) * w[1]; x[2] += bflo(v.y) * w[2]; x[3] += bfhi(v.y) * w[3];
                x[4] += bflo(v.z) * w[4]; x[5] += bfhi(v.z) * w[5]; x[6] += bflo(v.w) * w[6]; x[7] += bfhi(v.w) * w[7];
            }
        }
        u32x4 w4; w4.x = pk2(x[0], x[1]); w4.y = pk2(x[2], x[3]); w4.z = pk2(x[4], x[5]); w4.w = pk2(x[6], x[7]);
        af[s] = __builtin_bit_cast(bf16x8, w4);
    }
}
DI void lru_pre(const unsigned char* WL, const bf16x8 (&af)[4], int et, int r, int h, f32x16 (&pre)[5]) {
#pragma unroll
    for (int mat = 0; mat < 5; ++mat) {
#pragma unroll
        for (int i = 0; i < 16; ++i) pre[mat][i] = 0.f;
#pragma unroll
        for (int s = 0; s < 4; ++s) pre[mat] = MFMA32(af[s], *(const bf16x8*)(WL + mat * 64 * WLP + (et * 32 + r) * WLP + (16 * s + 8 * h) * 2), pre[mat]);
    }
}
DI void lru_gates(const f32x16& pa, const f32x16& px, const f32x16& xcv, float ba, float bx, float sp, float (&a)[16], float (&bq)[16]) {
#pragma unroll
    for (int i = 0; i < 16; ++i) {
        const float rg = sigmoid_f(pa[i] + ba), gi = sigmoid_f(px[i] + bx);
        const float la = -8.f * rg * sp;
        const float av = __builtin_amdgcn_exp2f(la * LOG2E);
        a[i] = av; bq[i] = __builtin_amdgcn_sqrtf(fmaxf(fmaf(-av, av, 1.f), 0.f)) * (gi * xcv[i]);
    }
}
template <bool FWD, int Q> DI void lru_quad(const float (&a)[16], const float (&bq)[16], float& A, float& B) {
    constexpr int i0 = FWD ? 4 * Q : 4 * Q + 3, st = FWD ? 1 : -1;
    A = a[i0] * a[i0 + st] * a[i0 + 2 * st] * a[i0 + 3 * st];
    B = ((bq[i0] * a[i0 + st] + bq[i0 + st]) * a[i0 + 2 * st] + bq[i0 + 2 * st]) * a[i0 + 3 * st] + bq[i0 + 3 * st];
}
DI void lru_passA(const int TID, const Params& p, const bf16_t* __restrict__ Z) {
    extern __shared__ __attribute__((aligned(16))) unsigned char smb[];
    const int lane = TID & 63, wave = TID >> 6, r = lane & 31, h = lane >> 5;
    unsigned char* WL = smb; float* CW = (float*)(smb + 5 * 64 * WLP);
    f32x2* SUM = (f32x2*)(p.ws + OFF_ST);
    const int n = blockIdx.x & 7;
    __syncthreads();
    lru_load_wl(TID, p, n, WL, CW);
    __syncthreads();
    for (int item = (blockIdx.x >> 3) * 8 + wave; item < NB * 264; item += (gridDim.x >> 3) * 8) {
        asm volatile("" ::: "memory");
        const int b = item / 264, ck = item % 264;
        const int seq_len = ck < 8 ? CTXL : SEQ, t0 = ck < 8 ? ck * 32 : (ck - 8) * 32, rowbase = ck < 8 ? TL + b * CTXL : b * SEQ;
        bf16x8 af[4];
        lru_afrag(Z + (size_t)rowbase * ODD_IN + 512 + n * 64, t0 + r, seq_len, CW, h, af);
        static_for<0, 2>([&](auto etc) {
            constexpr int et = decltype(etc)::value;
            const int ch = n * 64 + et * 32 + r;
            f32x16 pre[5];
            lru_pre(WL, af, et, r, h, pre);
            static_for<0, 2>([&](auto dc) {
                constexpr int dir = decltype(dc)::value;
                float a[16], bq[16];
                lru_gates(pre[2 * dir], pre[2 * dir + 1], pre[4], p.lru_ba[dir * 512 + ch], p.lru_bx[dir * 512 + ch], log1pf(__expf(-p.lru_lam[dir * 512 + ch])), a, bq);
                float P = 1.f, E = 0.f;
                static_for<0, 4>([&](auto kc) {
                    constexpr int q = dir ? 3 - decltype(kc)::value : decltype(kc)::value;
                    float A, B;
                    lru_quad<dir == 0, q>(a, bq, A, B);
                    const float Ap = __shfl_xor(A, 32), Bp = __shfl_xor(B, 32);
                    const bool own_first = (dir == 0) ? (h == 0) : (h == 1);
                    const float fA = own_first ? A : Ap, fB = own_first ? B : Bp, sA = own_first ? Ap : A, sB = own_first ? Bp : B;
                    const float pA = fA * sA, pB = sA * fB + sB;
                    E = pA * E + pB; P *= pA;
                });
                if (h == 0) SUM[((size_t)(b * 2 + dir) * 264 + ck) * 512 + ch] = (f32x2){P, E};
            });
        });
    }
}
DI void lru_passB(const int TID, const Params& p) {
    const f32x2* SUM = (const f32x2*)(p.ws + OFF_ST); float* LC = (float*)(p.ws + OFF_LCIN);
    for (int idx = blockIdx.x * 512 + TID; idx < NB * 2 * 512; idx += gridDim.x * 512) {
        const int ch = idx & 511, bd = idx >> 9, dir = bd & 1;
        float s = 0.f;
        for (int v0 = 0; v0 < 264; v0 += 24) {
            f32x2 pe[24];
#pragma unroll
            for (int k = 0; k < 24; ++k) { const int v = v0 + k; const int ck = dir == 0 ? v : (v < 8 ? 7 - v : 263 - (v - 8)); pe[k] = SUM[((size_t)bd * 264 + ck) * 512 + ch]; }
#pragma unroll
            for (int k = 0; k < 24; ++k) { const int v = v0 + k; const int ck = dir == 0 ? v : (v < 8 ? 7 - v : 263 - (v - 8)); LC[((size_t)bd * 264 + ck) * 512 + ch] = s; s = pe[k][0] * s + pe[k][1]; }
        }
    }
}
DI void lru_passC(const int TID, const Params& p, const bf16_t* __restrict__ Z, bf16_t* __restrict__ MIX) {
    extern __shared__ __attribute__((aligned(16))) unsigned char smb[];
    const int lane = TID & 63, wave = TID >> 6, r = lane & 31, h = lane >> 5;
    unsigned char* WL = smb; float* CW = (float*)(smb + 5 * 64 * WLP);
    const float* LC = (const float*)(p.ws + OFF_LCIN);
    const int n = blockIdx.x & 7;
    __syncthreads();
    lru_load_wl(TID, p, n, WL, CW);
    __syncthreads();
    for (int item = (blockIdx.x >> 3) * 8 + wave; item < NB * 256; item += (gridDim.x >> 3) * 8) {
        asm volatile("" ::: "memory");
        const int b = item >> 8, j = item & 255, ck = 8 + j, t0 = j * 32;
        bf16x8 af[4];
        lru_afrag(Z + (size_t)b * SEQ * ODD_IN + 512 + n * 64, t0 + r, SEQ, CW, h, af);
        static_for<0, 2>([&](auto etc) {
            constexpr int et = decltype(etc)::value;
            const int ch = n * 64 + et * 32 + r;
            f32x16 pre[5];
            lru_pre(WL, af, et, r, h, pre);
            float y[16];
            static_for<0, 2>([&](auto dc) {
                constexpr int dir = decltype(dc)::value;
                float a[16], bq[16];
                lru_gates(pre[2 * dir], pre[2 * dir + 1], pre[4], p.lru_ba[dir * 512 + ch], p.lru_bx[dir * 512 + ch], log1pf(__expf(-p.lru_lam[dir * 512 + ch])), a, bq);
                float S = LC[((size_t)(b * 2 + dir) * 264 + ck) * 512 + ch];
                static_for<0, 4>([&](auto kc) {
                    constexpr int q = dir ? 3 - decltype(kc)::value : decltype(kc)::value;
                    float A, B;
                    lru_quad<dir == 0, q>(a, bq, A, B);
                    const float Ap = __shfl_xor(A, 32), Bp = __shfl_xor(B, 32);
                    const bool own_first = (dir == 0) ? (h == 0) : (h == 1);
                    float s = own_first ? S : Ap * S + Bp;
                    const float fA = own_first ? A : Ap, fB = own_first ? B : Bp, sA = own_first ? Ap : A, sB = own_first ? Bp : B;
                    S = (fA * sA) * S + (sA * fB + sB);
                    static_for<0, 4>([&](auto jc) {
                        constexpr int i = dir ? 4 * q + 3 - decltype(jc)::value : 4 * q + decltype(jc)::value;
                        s = a[i] * s + bq[i];
                        if (dir == 0) y[i] = s; else y[i] += s;
                    });
                });
            });
#pragma unroll
            for (int i = 0; i < 16; ++i) {
                const size_t row = (size_t)b * SEQ + t0 + 8 * (i >> 2) + 4 * h + (i & 3);
                const float gz = bf2f(Z[row * ODD_IN + ch]);
                MIX[row * DM + ch] = f2bf(y[i] * gelu_tanh(gz));
            }
        });
    }
}

constexpr int NPHASE = 26;
#ifndef MK_RPT
#define MK_RPT 0ull
#endif
#define RPT(bit, ...) do { __VA_ARGS__; if ((MK_RPT >> (bit)) & 1ull) { __syncthreads(); __VA_ARGS__; } } while (0)
DI void run_phase(const int TID, const Params& p, int ph) {
    if (ph == 0) { RPT(0, prologue_phase(TID, p)); return; }
    const int l = ph >= 14 ? 1 : 0;
    int s = l ? ph - 13 : ph;
    if (l && s >= 9) s += 1;
    const int rb = 16 * l;
    unsigned char* ws = p.ws;
    float* ctxx = (float*)(ws + OFF_CTXX);
    const float* modl = (const float*)(ws + OFF_MOD) + (size_t)l * 5 * MODW;
    bf16_t* XN = (bf16_t*)(ws + OFF_XN); bf16_t* H = (bf16_t*)(ws + OFF_H); bf16_t* G = (bf16_t*)(ws + OFF_G);
    const bool first = (l == 0 && s <= 3);
    const float* srcL = first ? p.x : p.out; const float* srcC = ctxx;
    (void)srcC;
    const int nrows = (l == 1 && s >= 10) ? TL : TT;
    const int f = s >= 11 ? 1 : 0;
    const bf16_t* W13 = (const bf16_t*)(ws + OFF_W + (size_t)(l * 2 + f) * SZ_FFN);
    const bf16_t* W2 = (const bf16_t*)(ws + OFF_W + (size_t)(l * 2 + f) * SZ_FFN + SZ_W13);
    switch (s) {
    case 1: case 4: case 11: {
        const int gi = s == 1 ? 0 : (s == 4 ? 1 : 2);
        const int nsl = (l == 0 && s == 1) ? 0 : (s == 11 ? 4 : 11);
        normmod_phase(TID, srcL, ctxx, p.norm_g + (size_t)(l * 3 + gi) * DM, modl, 3 * gi, 3 * gi + 1, XN, nrows, (const float*)(ws + OFF_Q), nsl);
    } break;
    case 2: case 12: { EpiSwiglu e{H}; RPT(rb + s, gemm_phase(TID, XN, W13, nrows, 2 * DFF, DM, e)); } break;
    case 3: case 13: case 10: {
        const float* gbase = modl + (s == 3 ? 2 : (s == 13 ? 8 : 5)) * DM; const float coef = s == 10 ? 1.0f : 0.5f;
        EpiResid e{srcL, srcC, p.out, ctxx, gbase, coef};
        EpiPartial ea{(float*)(ws + OFF_Q), gbase + (size_t)4 * MODW, coef};
        const bf16_t* Wo = (const bf16_t*)(ws + (l ? OFF_ODOUT : OFF_EVOUT));
        if (s == 10) { gemm_phase(TID, XN, Wo, TL, DM, DM, e); if (nrows == TT) gemm_phase(TID, XN + (size_t)TL * DM, Wo, TC, DM, DM, ea, 4); }
        else { gemm_phase(TID, H, W2, TL, DM, DFF, e); if (nrows == TT) gemm_phase(TID, H + (size_t)TL * DFF, W2, TC, DM, DFF, ea, 11); }
    } break;
    case 5: {
        EpiStoreBf16 e{H, l ? ODD_IN : EVEN_IN};
        RPT(rb + s, gemm_phase(TID, XN, (const bf16_t*)(ws + (l ? OFF_ODIN : OFF_EVIN)), TT, l ? ODD_IN : EVEN_IN, DM, e));
    } break;
    case 6:
        if (l == 0) { RPT(6, qkv_post_phase(TID, p, H, EVEN_IN, 512, 8, 1024, 2, 1152, 2, 64, p.swa_qk_g, p.swa_qk_g + 64)); __syncthreads(); RPT(14, s5_passA(TID, p, H)); }
        else { RPT(22, qkv_post_phase(TID, p, H, ODD_IN, 1024, 8, 1536, 8, 2048, 4, 128, p.diff_qk_g, p.diff_qk_g + 64)); __syncthreads(); RPT(30, lru_passA(TID, p, H)); }
        break;
    case 7:
        if (l == 0) { s5_passB(TID, p); RPT(7, swa_attn_phase(TID, p, H, XN)); }
        else { lru_passB(TID, p); RPT(23, diff_attn_phase(TID, p, H, XN, 0.8f - 0.6f * 0.74081822068171788f)); }
        break;
    case 8:
        if (l == 0) RPT(8, s5_passC(TID, p, H, G)); else RPT(24, lru_passC(TID, p, H, XN));
        break;
    case 9: { EpiGlu e{G, p.s5_glu_b, XN}; RPT(9, gemm_phase(TID, G, (const bf16_t*)(ws + OFF_GLUW), TT, 512, 512, e)); } break;
    default: break;
    }
}

DI int mk_tid(int wv) { int l; asm volatile("v_mbcnt_lo_u32_b32 %0, -1, 0\n\tv_mbcnt_hi_u32_b32 %0, -1, %0" : "=v"(l)); return wv * 64 + l; }
#define XB_TMO      128
#define XB_XCNT(j)  (256  + 64 * (j))
#define XB_XSUB(j)  (1280 + 64 * (j))
#define XB_XGEN(j)  (2304 + 64 * (j))
#define XB_TOP      3328
#define XB_TOPGEN   3392
#define XCD_BAR_WORDS 3456
#define XB_SPIN_CAP (1u << 22)
#define LAS __attribute__((address_space(3)))
DI unsigned xb_ld(unsigned* p) { return __hip_atomic_load(p, __ATOMIC_RELAXED, __HIP_MEMORY_SCOPE_AGENT); }
DI unsigned xb_add(unsigned* p, unsigned v) { return __hip_atomic_fetch_add(p, v, __ATOMIC_RELAXED, __HIP_MEMORY_SCOPE_AGENT); }
DI unsigned xb_xcc_id() { return (unsigned)__builtin_amdgcn_s_getreg((3 << 11) | 20) & 0xFu; }
#define XB_SPIN(cond, bar) do { unsigned _sp = 0; while (cond) { __builtin_amdgcn_s_sleep(1); \
    if ((++_sp & 255u) == 0u) { if (xb_ld(&(bar)[XB_TMO])) break; if (_sp > XB_SPIN_CAP) { atomicAdd(&(bar)[XB_TMO], 1u); break; } } } } while (0)
DI void xcd_barrier_complete(unsigned* bar, unsigned x, unsigned& nloc, unsigned& nx) {
    const unsigned G = gridDim.x;
    unsigned sum, cnt, mine, sp = 0u;
    for (;;) {
        sum = 0u; cnt = 0u; mine = 0u;
#pragma unroll
        for (unsigned j = 0; j < 16; ++j) { const unsigned c = xb_ld(&bar[XB_XCNT(j)]); sum += c; cnt += (c > 0u) ? 1u : 0u; mine = (j == x) ? c : mine; }
        if (sum == G) break;
        __builtin_amdgcn_s_sleep(1);
        if ((++sp & 255u) == 0u) { if (xb_ld(&bar[XB_TMO])) break; if (sp > XB_SPIN_CAP) { atomicAdd(&bar[XB_TMO], 1u); break; } }
    }
    nloc = mine > 0u ? mine : 1u; nx = cnt > 0u ? cnt : 1u;
}
DI void xcd_barrier(unsigned* bar, int tid) {
    extern __shared__ __attribute__((aligned(16))) unsigned char smx[];
    volatile LAS unsigned* st = (volatile LAS unsigned*)(smx + 131072);
    asm volatile("s_waitcnt vmcnt(0)" ::: "memory");
    __syncthreads();
    if (tid == 0) {
        const unsigned x = xb_xcc_id();
        __builtin_amdgcn_s_waitcnt(0);
        unsigned nloc = st[0], nx = st[1];
        if (nloc == 0u) { xcd_barrier_complete(bar, x, nloc, nx); st[0] = nloc; st[1] = nx; }
        const unsigned old = xb_add(&bar[XB_XSUB(x)], 1u);
        const unsigned gen = old / nloc;
        if (old + 1u == (gen + 1u) * nloc) {
            __builtin_amdgcn_fence(__ATOMIC_RELEASE, "agent");
            asm volatile("s_waitcnt vmcnt(0)" ::: "memory");
            const unsigned og = xb_add(&bar[XB_TOP], 1u);
            const unsigned tg = og / nx;
            if (og + 1u == (tg + 1u) * nx) xb_add(&bar[XB_TOPGEN], 1u);
            else XB_SPIN(xb_ld(&bar[XB_TOPGEN]) == tg, bar);
            __builtin_amdgcn_fence(__ATOMIC_ACQUIRE, "agent");
            xb_add(&bar[XB_XGEN(x)], 1u);
            asm volatile("s_waitcnt vmcnt(0)" ::: "memory");
        } else {
            XB_SPIN(xb_ld(&bar[XB_XGEN(x)]) == gen, bar);
            __builtin_amdgcn_fence(__ATOMIC_ACQUIRE, "agent");
            asm volatile("s_waitcnt vmcnt(0)" ::: "memory");
        }
    }
    __syncthreads();
}
template <int K>
DI void run_all(const int wv, const Params& p, int lo, int hi) {
    if constexpr (K < NPHASE) {
        if (K >= lo && K < hi) {
            const int tid = mk_tid(wv);
            run_phase(tid, p, K);
            if (K + 1 < hi) { xcd_barrier((unsigned*)(p.ws + OFF_BAR), tid); if ((MK_RPT >> 63) & 1ull) xcd_barrier((unsigned*)(p.ws + OFF_BAR), tid); }
        }
        run_all<K + 1>(wv, p, lo, hi);
    }
}
__global__ void __launch_bounds__(512) mega_fwd(Params p, int ph_lo, int ph_hi) {
    const int wv = __builtin_amdgcn_readfirstlane((int)(threadIdx.x >> 6));
    {
        extern __shared__ __attribute__((aligned(16))) unsigned char smx[];
        if (threadIdx.x == 0) { *(u32x4*)(smx + 131072) = (u32x4){0u, 0u, 0u, 0u}; (void)xb_add((unsigned*)(p.ws + OFF_BAR) + XB_XCNT(xb_xcc_id()), 1u); }
        __syncthreads();
    }
    if (ph_hi - ph_lo > 1) cg::this_grid().sync();
    run_all<0>(wv, p, ph_lo, ph_hi);
}

#ifndef MK_MULTI
#define MK_MULTI 0
#endif
extern "C" void kernel_launch(void* const* d_in, const int* in_sizes, int n_in, void* d_out, int out_size, void* d_ws, size_t ws_size, hipStream_t stream) {
    static int grid = 0;
    if (grid == 0) {
        if (n_in != 37 || in_sizes[0] != TL * DM || out_size != TL * DM || ws_size < WS_END) {
            fprintf(stderr, "kernel_launch: unexpected problem: n_in %d in0 %d out %d ws %zu (need %zu)\n", n_in, n_in > 0 ? in_sizes[0] : -1, out_size, ws_size, (size_t)WS_END);
            grid = -1; return;
        }
        int dev = 0, cus = 0, per_cu = 0;
        (void)hipGetDevice(&dev);
        (void)hipDeviceGetAttribute(&cus, hipDeviceAttributeMultiprocessorCount, dev);
        if (hipFuncSetAttribute((const void*)mega_fwd, hipFuncAttributeMaxDynamicSharedMemorySize, LDS_BYTES) != hipSuccess) { fprintf(stderr, "kernel_launch: hipFuncSetAttribute failed\n"); grid = -1; return; }
        (void)hipOccupancyMaxActiveBlocksPerMultiprocessor(&per_cu, (const void*)mega_fwd, 512, LDS_BYTES);
        if (per_cu < 1) { fprintf(stderr, "kernel_launch: occupancy query says %d blocks per CU\n", per_cu); per_cu = 1; }
        (void)hipGetLastError();
        grid = cus * per_cu;
    }
    if (grid < 0) return;
    if (hipMemsetAsync((unsigned char*)d_ws + OFF_BAR, 0, 16384, stream) != hipSuccess) { fprintf(stderr, "kernel_launch: memset failed\n"); return; }
    Params p{};
    const float** pp = (const float**)&p;
    for (int i = 0; i < 37; ++i) pp[i] = (const float*)d_in[i];
    p.out = (float*)d_out; p.ws = (unsigned char*)d_ws;
#if MK_MULTI
    for (int ph = 0; ph < NPHASE; ++ph) hipLaunchKernelGGL(mega_fwd, dim3(grid), dim3(512), LDS_BYTES, stream, p, ph, ph + 1);
#else
    int lo = 0, hi = NPHASE;
    void* args[] = {&p, &lo, &hi};
    hipError_t e = hipLaunchCooperativeKernel((const void*)mega_fwd, dim3(grid), dim3(512), args, LDS_BYTES, stream);
    if (e != hipSuccess) fprintf(stderr, "kernel_launch: cooperative launch failed: %s (grid %d)\n", hipGetErrorString(e), grid);
#endif
}
```

```cpp
#include <hip/hip_runtime.h>
#include <hip/hip_cooperative_groups.h>
#include <cstdio>
#include <cstdint>
namespace cg = cooperative_groups;

#define DI __device__ __forceinline__
typedef unsigned short bf16_t;
typedef short bf16x8 __attribute__((ext_vector_type(8)));
typedef short s16x4 __attribute__((ext_vector_type(4)));
typedef float f32x2 __attribute__((ext_vector_type(2)));
typedef float f32x4 __attribute__((ext_vector_type(4)));
typedef float f32x16 __attribute__((ext_vector_type(16)));
typedef unsigned u32x2 __attribute__((ext_vector_type(2)));
typedef unsigned u32x4 __attribute__((ext_vector_type(4)));
typedef __bf16 bf16x2_t __attribute__((ext_vector_type(2)));

constexpr int DM = 1024, NB = 4, SEQ = 8192, CTXL = 256, TL = NB * SEQ, TC = NB * CTXL, TT = TL + TC, DFF = 2816, KEYS = SEQ + CTXL;
constexpr int NMOD = 9, MODW = NMOD * DM;
constexpr int EVEN_IN = 1280, ODD_IN = 2560;
constexpr float EPSN = 1e-6f;
constexpr float LOG2E = 1.4426950408889634f;

constexpr size_t SZ_W13 = (size_t)2 * DFF * DM * 2, SZ_W2 = (size_t)DM * DFF * 2, SZ_FFN = SZ_W13 + SZ_W2;
constexpr size_t OFF_W = 0;
constexpr size_t OFF_EVIN = OFF_W + 4 * SZ_FFN;
constexpr size_t OFF_EVOUT = OFF_EVIN + (size_t)EVEN_IN * DM * 2;
constexpr size_t OFF_GLUW = OFF_EVOUT + (size_t)DM * DM * 2;
constexpr size_t OFF_ODIN = OFF_GLUW + (size_t)512 * 512 * 2;
constexpr size_t OFF_ODOUT = OFF_ODIN + (size_t)ODD_IN * DM * 2;
constexpr size_t OFF_XN = OFF_ODOUT + (size_t)DM * DM * 2;
constexpr size_t OFF_H = OFF_XN + (size_t)TT * DM * 2;
constexpr size_t OFF_CTXX = OFF_H + (size_t)TT * DFF * 2;
constexpr size_t OFF_MOD = OFF_CTXX + (size_t)TC * DM * 4;
constexpr size_t OFF_ROPE = OFF_MOD + (size_t)2 * 5 * MODW * 4;
constexpr size_t OFF_S5A = OFF_ROPE + (size_t)SEQ * 32 * 8;
constexpr size_t OFF_S5B = OFF_S5A + (size_t)2 * 32 * 64 * 8;
constexpr size_t OFF_Q = OFF_S5B + (size_t)2 * 32 * 64 * 16 * 8;
constexpr size_t SZ_QKV = (size_t)NB * 8 * KEYS * 64 * 2;
constexpr size_t OFF_K = OFF_Q + SZ_QKV;
constexpr size_t OFF_V = OFF_K + SZ_QKV;
constexpr size_t OFF_G = OFF_V + SZ_QKV;
constexpr size_t OFF_ST = OFF_G + (size_t)TT * 512 * 2;
constexpr size_t SZ_ST = (size_t)NB * 2 * 32 * 264 * 64 * 8;
constexpr size_t OFF_LCIN = OFF_ST + (size_t)NB * 2 * 264 * 512 * 8;
constexpr size_t OFF_BAR = OFF_ST + SZ_ST;
constexpr size_t OFF_S5C = OFF_BAR + 16384;
constexpr size_t WS_END = OFF_S5C + (size_t)2 * 32 * 2 * 16 * 128 * 2;
static_assert(OFF_LCIN + (size_t)NB * 2 * 264 * 512 * 4 <= OFF_BAR, "lru regions");
static_assert(SZ_QKV / 4 + (size_t)NB * 32 * 264 * 64 * 8 <= SZ_QKV, "s5 carry-in regions");
constexpr int LDS_BYTES = 131072 + 16;

struct Params {
    const float *x, *c, *ctx, *c_ctx, *mod_w, *mod_b, *norm_g, *ffn1_w13, *ffn1_w2, *ffn2_w13, *ffn2_w2, *ev_w_in, *ev_w_out;
    const float *s5_lam_re, *s5_lam_im, *s5_log_dt, *s5_b_re, *s5_b_im, *s5_c_re, *s5_c_im, *s5_d, *s5_glu_w, *s5_glu_b, *swa_qk_g, *swa_sink;
    const float *od_w_in, *od_w_out, *lru_conv_w, *lru_conv_b, *lru_wa, *lru_ba, *lru_wx, *lru_bx, *lru_lam, *diff_qk_g, *diff_lam, *diff_sub_g;
    float* out;
    unsigned char* ws;
};

DI unsigned pk2(float lo, float hi) { f32x2 v = {lo, hi}; bf16x2_t r = __builtin_convertvector(v, bf16x2_t); return __builtin_bit_cast(unsigned, r); }
DI bf16_t f2bf(float x) { return (bf16_t)(pk2(x, 0.f) & 0xffffu); }
DI float bf2f(bf16_t v) { return __uint_as_float((unsigned)v << 16); }
DI float bflo(unsigned w) { return __uint_as_float(w << 16); }
DI float bfhi(unsigned w) { return __uint_as_float(w & 0xffff0000u); }
DI float wave_sum(float v) {
#pragma unroll
    for (int o = 32; o; o >>= 1) v += __shfl_xor(v, o);
    return v;
}
DI float wave_max(float v) {
#pragma unroll
    for (int o = 32; o; o >>= 1) v = fmaxf(v, __shfl_xor(v, o));
    return v;
}
DI float sigmoid_f(float x) { return __builtin_amdgcn_rcpf(1.f + __builtin_amdgcn_exp2f(-LOG2E * x)); }
DI float silu_f(float x) { return x * sigmoid_f(x); }
DI float gelu_tanh(float x) { const float u = 0.7978845608028654f * (x + 0.044715f * x * x * x); return x * sigmoid_f(2.f * u); }
#define LDS_FENCE() asm volatile("s_waitcnt lgkmcnt(0)" ::: "memory")
template <int V> struct IC { static constexpr int value = V; };
template <int I, int N, class F> DI void static_for(F&& f) { if constexpr (I < N) { f(IC<I>{}); static_for<I + 1, N>(f); } }

constexpr int BM = 256, BK = 64, HALF = 128, HT = HALF * BK, NXCD = 8, WGM = 8;
DI int lds_byte(int r, int c) { int st = (r >> 4) * 2 + (c >> 5), rr = r & 15, cc = c & 31, ob = rr * 64 + cc * 2; return st * 1024 + (ob ^ (((ob >> 9) & 1) << 5)); }
DI void stage_rc(int b, int& R, int& C) { int st = b / 1024, sb = b % 1024, swz = sb ^ (((sb >> 9) & 1) << 5); R = (st >> 1) * 16 + swz / 64; C = (st & 1) * 32 + (swz % 64) / 2; }

template <class Epi>
DI void gemm_phase(const int TID, const bf16_t* __restrict__ A, const bf16_t* __restrict__ Bt, int M, int N, int K, const Epi& epi, const int S = 1) {
    extern __shared__ __attribute__((aligned(16))) bf16_t shm[];
    int tidx = TID; asm volatile("" : "+v"(tidx));
#define SA(b, h) (shm + ((b) * 2 + (h)) * HT)
#define SB(b, h) (shm + (4 + (b) * 2 + (h)) * HT)
#define STAGE(P, BASE, br, kt) do { const char* _ub = (const char*)(BASE) + ((long)(br) * K + (long)((kt) + kbase) * BK) * 2; \
      __builtin_amdgcn_global_load_lds((const unsigned*)(_ub + voff0), (unsigned*)((char*)(P) + wv_s * 1024), 16, 0, 0); \
      __builtin_amdgcn_global_load_lds((const unsigned*)(_ub + voff1), (unsigned*)((char*)(P) + wv_s * 1024 + 8192), 16, 0, 0); } while (0)
#define LDA(dst, b, h) for (int m = 0; m < 4; ++m) for (int k = 0; k < 2; ++k) \
    dst[m][k] = *reinterpret_cast<const bf16x8*>((char*)SA(b, h) + lds_byte(wr * 64 + m * 16 + fr, k * 32 + fq * 8))
#define LDB(dst, b, h) for (int n = 0; n < 2; ++n) for (int k = 0; k < 2; ++k) \
    dst[n][k] = *reinterpret_cast<const bf16x8*>((char*)SB(b, h) + lds_byte(wc * 32 + n * 16 + fr, k * 32 + fq * 8))
#define MMA(ai, bj, At_, Bt_) do { __builtin_amdgcn_s_setprio(1); \
    for (int m = 0; m < 4; ++m) for (int n = 0; n < 2; ++n) for (int k = 0; k < 2; ++k) \
      acc[ai][bj][m][n] = __builtin_amdgcn_mfma_f32_16x16x32_bf16(Bt_[n][k], At_[m][k], acc[ai][bj][m][n], 0, 0, 0); \
    __builtin_amdgcn_s_setprio(0); } while (0)
#define WAIT_V(n) asm volatile("s_waitcnt vmcnt(" #n ")" ::: "memory")
#define WAIT_L(n) asm volatile("s_waitcnt lgkmcnt(" #n ")" ::: "memory")
#define BAR __builtin_amdgcn_s_barrier()
#define SCHED __builtin_amdgcn_sched_barrier(0)
    const int nM = M / BM, nN = N / BM, ntile = nM * nN, nwg = ntile * S;
    const int wid = tidx >> 6, lane = tidx & 63, wr = wid >> 2, wc = wid & 3, fr = lane & 15, fq = lane >> 4;
    const int nt = K / BK / S;
    const int wv_s = __builtin_amdgcn_readfirstlane(tidx >> 6);
    unsigned voff0, voff1;
    { int r_, c_; stage_rc(tidx * 16, r_, c_); voff0 = (unsigned)(r_ * K + c_) * 2u; stage_rc(tidx * 16 + 8192, r_, c_); voff1 = (unsigned)(r_ * K + c_) * 2u; }
#define TILE_COORDS(L_, pm_, pn_, kb_) do { int wgid = (int)(L_); \
        if (S == 1) { const int q = nwg / NXCD, r = nwg % NXCD, xcd = wgid % NXCD, off = wgid / NXCD; wgid = (xcd < r ? xcd * (q + 1) : r * (q + 1) + (xcd - r) * q) + off; kb_ = 0; } \
        else { kb_ = (wgid % S) * nt; wgid /= S; } \
        const int nig = WGM * nN, gid = wgid / nig, fm = gid * WGM, gsz = min(nM - fm, WGM); \
        pm_ = fm + ((wgid % nig) % gsz); pn_ = (wgid % nig) / gsz; } while (0)
#define STAGE_P1(brow_, bcol_) do { STAGE(SB(0, 0), Bt, bcol_, 0); STAGE(SA(0, 0), A, brow_, 0); STAGE(SB(0, 1), Bt, (bcol_) + HALF, 0); STAGE(SA(0, 1), A, (brow_) + HALF, 0); } while (0)
    long L = blockIdx.x;
    if (L >= nwg) return;
    int pm, pn, kbase;
    TILE_COORDS(L, pm, pn, kbase);
    STAGE_P1(pm * BM, pn * BM);
    for (;;) {
        const int brow = pm * BM, bcol = pn * BM;
        f32x4 acc[2][2][4][2] = {};
        bf16x8 At[4][2], B0[2][2], B1[2][2];
        if (wr == 1) BAR;
        WAIT_V(0); BAR;
        STAGE(SB(1, 0), Bt, bcol, 1); STAGE(SA(1, 0), A, brow, 1); STAGE(SB(1, 1), Bt, bcol + HALF, 1);
        WAIT_V(6); BAR;
        for (int t = 0; t < nt - 2; t += 2) {
            LDB(B0, 0, 0); SCHED; LDA(At, 0, 0); STAGE(SA(1, 1), A, brow + HALF, t + 1);
            WAIT_L(8); BAR; WAIT_L(0); MMA(0, 0, At, B0); BAR; SCHED;
            LDB(B1, 0, 1); STAGE(SB(0, 0), Bt, bcol, t + 2);
            BAR; WAIT_L(0); MMA(0, 1, At, B1); BAR;
            LDA(At, 0, 1); STAGE(SA(0, 0), A, brow, t + 2);
            BAR; WAIT_L(0); MMA(1, 0, At, B0); BAR; SCHED;
            STAGE(SB(0, 1), Bt, bcol + HALF, t + 2);
            WAIT_V(6); BAR; MMA(1, 1, At, B1); BAR;
            LDB(B0, 1, 0); SCHED; LDA(At, 1, 0); STAGE(SA(0, 1), A, brow + HALF, t + 2);
            WAIT_L(8); BAR; WAIT_L(0); MMA(0, 0, At, B0); BAR; SCHED;
            LDB(B1, 1, 1); STAGE(SB(1, 0), Bt, bcol, t + 3);
            BAR; WAIT_L(0); MMA(0, 1, At, B1); BAR;
            LDA(At, 1, 1); STAGE(SA(1, 0), A, brow, t + 3);
            BAR; WAIT_L(0); MMA(1, 0, At, B0); BAR; SCHED;
            STAGE(SB(1, 1), Bt, bcol + HALF, t + 3);
            WAIT_V(6); BAR; MMA(1, 1, At, B1); BAR;
        }
        { LDB(B0, 0, 0); LDA(At, 0, 0); STAGE(SA(1, 1), A, brow + HALF, nt - 1);
          BAR; WAIT_L(0); MMA(0, 0, At, B0); BAR;
          LDB(B1, 0, 1); BAR; WAIT_L(0); MMA(0, 1, At, B1); BAR;
          LDA(At, 0, 1); WAIT_V(4); BAR; WAIT_L(0); MMA(1, 0, At, B0); MMA(1, 1, At, B1); BAR; }
        { LDB(B0, 1, 0); LDA(At, 1, 0); WAIT_V(2); BAR; WAIT_L(0); MMA(0, 0, At, B0); BAR;
          LDB(B1, 1, 1); WAIT_V(0); BAR; WAIT_L(0); MMA(0, 1, At, B1); BAR;
          LDA(At, 1, 1); BAR; WAIT_L(0); MMA(1, 0, At, B0); MMA(1, 1, At, B1); BAR; }
        if (wr == 0) BAR;
        const int kbase_cur = kbase;
        L += gridDim.x;
        const bool has_next = L < nwg;
        int pm_n = 0, pn_n = 0, kb_n = 0;
        if (has_next) { TILE_COORDS(L, pm_n, pn_n, kb_n); kbase = kb_n; STAGE_P1(pm_n * BM, pn_n * BM); }
        asm volatile("" ::: "memory"); SCHED;
        { int t2 = TID; asm volatile("" : "+v"(t2));
          int pm2 = S == 1 ? pm : pm + (kbase_cur / nt) * nM, pn2 = pn; asm volatile("" : "+s"(pm2), "+s"(pn2));
          epi(acc, pm2, pn2, t2 >> 8, (t2 >> 6) & 3, t2 & 15, (t2 & 63) >> 4); }
        asm volatile("" ::: "memory"); SCHED;
        if (!has_next) break;
        pm = pm_n; pn = pn_n;
    }
#undef TILE_COORDS
#undef STAGE_P1
#undef SA
#undef SB
#undef STAGE
#undef LDA
#undef LDB
#undef MMA
}

struct EpiSwiglu {
    bf16_t* H;
    DI void operator()(const f32x4 (&acc)[2][2][4][2], int pm, int pn, int wr, int wc, int fr, int fq) const {
#pragma unroll
        for (int ai = 0; ai < 2; ++ai)
#pragma unroll
            for (int m = 0; m < 4; ++m) {
                const size_t row = (size_t)pm * BM + ai * HALF + wr * 64 + m * 16 + fr;
#pragma unroll
                for (int bj = 0; bj < 2; ++bj) {
                    const int hc = (pn * BM + bj * HALF + wc * 32) / 2 + 4 * fq;
                    const f32x4 g = acc[ai][bj][m][0], u = acc[ai][bj][m][1];
                    u32x2 w; w.x = pk2(silu_f(g[0]) * u[0], silu_f(g[1]) * u[1]); w.y = pk2(silu_f(g[2]) * u[2], silu_f(g[3]) * u[3]);
                    *(u32x2*)(H + row * DFF + hc) = w;
                }
            }
    }
};
struct EpiResid {
    const float *srcL, *srcC; float *dstL, *dstC; const float* gate  ; float coef;
    DI void operator()(const f32x4 (&acc)[2][2][4][2], int pm, int pn, int wr, int wc, int fr, int fq) const {
        const int row0 = pm * BM;
        const bool lat = row0 < TL;
        const float* src = lat ? srcL : srcC - (size_t)TL * DM;
        float* dst = lat ? dstL : dstC - (size_t)TL * DM;
        const int v = lat ? row0 / SEQ : 4;
        const int col0 = pn * BM + wc * 32 + 4 * fq;
        const float* gv = gate + (size_t)v * MODW + col0;
        f32x4 gt[2][2];
#pragma unroll
        for (int bj = 0; bj < 2; ++bj)
#pragma unroll
            for (int n = 0; n < 2; ++n) gt[bj][n] = *(const f32x4*)(gv + bj * HALF + n * 16) * coef;
#pragma unroll
        for (int ai = 0; ai < 2; ++ai)
#pragma unroll
            for (int m = 0; m < 4; ++m) {
                const size_t off = (size_t)(row0 + ai * HALF + wr * 64 + m * 16 + fr) * DM + col0;
                const float* sp = src + off; float* dp = dst + off;
                f32x4 s[2][2];
#pragma unroll
                for (int bj = 0; bj < 2; ++bj)
#pragma unroll
                    for (int n = 0; n < 2; ++n) s[bj][n] = *(const f32x4*)(sp + bj * HALF + n * 16);
#pragma unroll
                for (int bj = 0; bj < 2; ++bj)
#pragma unroll
                    for (int n = 0; n < 2; ++n) *(f32x4*)(dp + bj * HALF + n * 16) = s[bj][n] + gt[bj][n] * acc[ai][bj][m][n];
                asm volatile("" ::: "memory");
            }
    }
};
struct EpiPartial {
    float* part; const float* gate; float coef;
    DI void operator()(const f32x4 (&acc)[2][2][4][2], int pm, int pn, int wr, int wc, int fr, int fq) const {
        const int col0 = pn * BM + wc * 32 + 4 * fq;
        f32x4 gt[2][2];
#pragma unroll
        for (int bj = 0; bj < 2; ++bj)
#pragma unroll
            for (int n = 0; n < 2; ++n) gt[bj][n] = *(const f32x4*)(gate + col0 + bj * HALF + n * 16) * coef;
#pragma unroll
        for (int ai = 0; ai < 2; ++ai)
#pragma unroll
            for (int m = 0; m < 4; ++m) {
                float* dp = part + (size_t)(pm * BM + ai * HALF + wr * 64 + m * 16 + fr) * DM + col0;
#pragma unroll
                for (int bj = 0; bj < 2; ++bj)
#pragma unroll
                    for (int n = 0; n < 2; ++n) *(f32x4*)(dp + bj * HALF + n * 16) = gt[bj][n] * acc[ai][bj][m][n];
                asm volatile("" ::: "memory");
            }
    }
};
struct EpiStoreBf16 {
    bf16_t* Z; int ldz;
    DI void operator()(const f32x4 (&acc)[2][2][4][2], int pm, int pn, int wr, int wc, int fr, int fq) const {
#pragma unroll
        for (int ai = 0; ai < 2; ++ai)
#pragma unroll
            for (int m = 0; m < 4; ++m) {
                const size_t row = (size_t)pm * BM + ai * HALF + wr * 64 + m * 16 + fr;
#pragma unroll
                for (int bj = 0; bj < 2; ++bj)
#pragma unroll
                    for (int n = 0; n < 2; ++n) {
                        const int col = pn * BM + bj * HALF + wc * 32 + n * 16 + 4 * fq;
                        const f32x4 a = acc[ai][bj][m][n];
                        u32x2 w; w.x = pk2(a[0], a[1]); w.y = pk2(a[2], a[3]);
                        *(u32x2*)(Z + row * ldz + col) = w;
                    }
            }
    }
};
struct EpiGlu {
    const bf16_t* G; const float* bias; bf16_t* MIX;
    DI void operator()(const f32x4 (&acc)[2][2][4][2], int pm, int pn, int wr, int wc, int fr, int fq) const {
        const int col0 = pn * BM + wc * 32 + 4 * fq;
        f32x4 bv[2][2];
#pragma unroll
        for (int bj = 0; bj < 2; ++bj)
#pragma unroll
            for (int n = 0; n < 2; ++n) bv[bj][n] = *(const f32x4*)(bias + col0 + bj * HALF + n * 16);
#pragma unroll
        for (int ai = 0; ai < 2; ++ai)
#pragma unroll
            for (int m = 0; m < 4; ++m) {
                const size_t row = (size_t)pm * BM + ai * HALF + wr * 64 + m * 16 + fr;
                const bf16_t* gp = G + row * 512 + col0; bf16_t* mp = MIX + row * DM + col0;
#pragma unroll
                for (int bj = 0; bj < 2; ++bj)
#pragma unroll
                    for (int n = 0; n < 2; ++n) {
                        const u32x2 gw = *(const u32x2*)(gp + bj * HALF + n * 16);
                        const f32x4 a = acc[ai][bj][m][n] + bv[bj][n];
                        u32x2 w; w.x = pk2(bflo(gw.x) * sigmoid_f(a[0]), bfhi(gw.x) * sigmoid_f(a[1])); w.y = pk2(bflo(gw.y) * sigmoid_f(a[2]), bfhi(gw.y) * sigmoid_f(a[3]));
                        *(u32x2*)(mp + bj * HALF + n * 16) = w;
                    }
                asm volatile("" ::: "memory");
            }
    }
};

DI void transpose_item(const float* __restrict__ W, int K, int N, bf16_t* __restrict__ WT, int mode, float* scr, int item, int lane) {
    const int nblk = N / 32, kb = item / nblk, nb = item % nblk, k0 = 64 * kb, n0 = 32 * nb;
#pragma unroll 8
    for (int i = 0; i < 32; ++i) { const int kk = 2 * i + (lane >> 5); scr[kk * 33 + (lane & 31)] = __builtin_nontemporal_load(W + (size_t)(k0 + kk) * N + n0 + (lane & 31)); }
    LDS_FENCE();
    const int c = lane & 7;
#pragma unroll
    for (int j = 0; j < 4; ++j) {
        const int n = (lane >> 3) + 8 * j; const float* s = scr + (8 * c) * 33 + n;
        u32x4 o; o.x = pk2(s[0 * 33], s[1 * 33]); o.y = pk2(s[2 * 33], s[3 * 33]); o.z = pk2(s[4 * 33], s[5 * 33]); o.w = pk2(s[6 * 33], s[7 * 33]);
        const int nn = n0 + n;
        int row = nn;
        if (mode == 1) { const int jj = nn < DFF ? nn : nn - DFF; row = (jj >> 4) * 32 + (jj & 15) + (nn < DFF ? 0 : 16); }
        *(u32x4*)(WT + (size_t)row * K + k0 + 8 * c) = o;
    }
    LDS_FENCE();
}

DI void prologue_phase(const int TID, const Params& p) {
    extern __shared__ __attribute__((aligned(16))) float shf[];
    const int tid = TID, lane = tid & 63, wave = tid >> 6;
    unsigned char* ws = p.ws;
    {
        float* scr = shf + wave * (64 * 33);
        const int gw = blockIdx.x * 8 + wave, ngw = gridDim.x * 8;
        constexpr int I13 = (DM / 64) * (2 * DFF / 32), I2 = (DFF / 64) * (DM / 32);
        constexpr int IEI = (DM / 64) * (EVEN_IN / 32), IEO = (DM / 64) * (DM / 32), IGL = (512 / 64) * (512 / 32), IOI = (DM / 64) * (ODD_IN / 32), IOO = IEO;
        constexpr int NIT = 4 * (I13 + I2) + IEI + IEO + IGL + IOI + IOO;
        for (int it = gw; it < NIT; it += ngw) {
            int r = it;
            if (r < 4 * (I13 + I2)) {
                const int lf = r / (I13 + I2); r -= lf * (I13 + I2);
                const int l = lf >> 1, f = lf & 1;
                bf16_t* base = (bf16_t*)(ws + OFF_W + (size_t)lf * SZ_FFN);
                if (r < I13) transpose_item((f ? p.ffn2_w13 : p.ffn1_w13) + (size_t)l * DM * 2 * DFF, DM, 2 * DFF, base, 1, scr, r, lane);
                else transpose_item((f ? p.ffn2_w2 : p.ffn1_w2) + (size_t)l * DFF * DM, DFF, DM, (bf16_t*)((unsigned char*)base + SZ_W13), 0, scr, r - I13, lane);
                continue;
            }
            r -= 4 * (I13 + I2);
            if (r < IEI) { transpose_item(p.ev_w_in, DM, EVEN_IN, (bf16_t*)(ws + OFF_EVIN), 0, scr, r, lane); continue; } r -= IEI;
            if (r < IEO) { transpose_item(p.ev_w_out, DM, DM, (bf16_t*)(ws + OFF_EVOUT), 0, scr, r, lane); continue; } r -= IEO;
            if (r < IGL) { transpose_item(p.s5_glu_w, 512, 512, (bf16_t*)(ws + OFF_GLUW), 0, scr, r, lane); continue; } r -= IGL;
            if (r < IOI) { transpose_item(p.od_w_in, DM, ODD_IN, (bf16_t*)(ws + OFF_ODIN), 0, scr, r, lane); continue; } r -= IOI;
            transpose_item(p.od_w_out, DM, DM, (bf16_t*)(ws + OFF_ODOUT), 0, scr, r, lane);
        }
    }
    __syncthreads();
    {
        float* red = shf;
        float* sl = shf + 8 * 5 * 64;
        for (int idx = tid; idx < 5 * DM; idx += 512) { const int v = idx >> 10, k = idx & (DM - 1); sl[idx] = silu_f(v < 4 ? p.c[v * DM + k] : p.c_ctx[k]); }
        __syncthreads();
        float* MOD = (float*)(ws + OFF_MOD);
        for (int item = blockIdx.x; item < 2 * (MODW / 64); item += gridDim.x) {
            const int i = item / (MODW / 64), col = (item % (MODW / 64)) * 64 + lane;
            const float* W = p.mod_w + (size_t)i * DM * MODW + col;
            float a0 = 0.f, a1 = 0.f, a2 = 0.f, a3 = 0.f, a4 = 0.f;
            for (int k = wave * 128; k < wave * 128 + 128; ++k) {
                const float w = __builtin_nontemporal_load(W + (size_t)k * MODW);
                a0 += sl[k] * w; a1 += sl[DM + k] * w; a2 += sl[2 * DM + k] * w; a3 += sl[3 * DM + k] * w; a4 += sl[4 * DM + k] * w;
            }
            __syncthreads();
            red[(wave * 5 + 0) * 64 + lane] = a0; red[(wave * 5 + 1) * 64 + lane] = a1; red[(wave * 5 + 2) * 64 + lane] = a2; red[(wave * 5 + 3) * 64 + lane] = a3; red[(wave * 5 + 4) * 64 + lane] = a4;
            __syncthreads();
            if (tid < 320) {
                const int v = tid >> 6; float s = 0.f;
#pragma unroll
                for (int w8 = 0; w8 < 8; ++w8) s += red[(w8 * 5 + v) * 64 + lane];
                MOD[((size_t)i * 5 + v) * MODW + col] = s + p.mod_b[(size_t)i * MODW + col];
            }
        }
    }
    {
        f32x4* dstc = (f32x4*)(ws + OFF_CTXX); const f32x4* srcc = (const f32x4*)p.ctx;
        for (int idx = blockIdx.x * 512 + tid; idx < TC * DM / 4; idx += gridDim.x * 512) dstc[idx] = srcc[idx];
    }
    {
        f32x2* ROPE = (f32x2*)(ws + OFF_ROPE);
        for (int idx = blockIdx.x * 512 + tid; idx < SEQ * 32; idx += gridDim.x * 512) {
            const int pos = idx >> 5, i = idx & 31;
            const float inv = powf(10000.0f, -(float)(i & 15) / 16.0f);
            const float ang = (float)(i < 16 ? pos / 64 : pos % 64) * inv;
            float sn, cs; sincosf(ang, &sn, &cs);
            ROPE[idx] = (f32x2){cs, sn};
        }
    }
    {
        f32x2* SA_ = (f32x2*)(ws + OFF_S5A); bf16_t* SB_ = (bf16_t*)(ws + OFF_S5B); bf16_t* SC_ = (bf16_t*)(ws + OFF_S5C);
        for (int idx = blockIdx.x * 512 + tid; idx < 2 * 32 * 64; idx += gridDim.x * 512) {
            const int dg = idx >> 6, pp = idx & 63;
            const float lr = p.s5_lam_re[idx], li = p.s5_lam_im[idx], dt = expf(p.s5_log_dt[dg]);
            const float mag = expf(lr * dt); float sn, cs; sincosf(li * dt, &sn, &cs);
            const float ar = mag * cs, ai = mag * sn, den = lr * lr + li * li;
            const float fr = ((ar - 1.f) * lr + ai * li) / den, fi = (ai * lr - (ar - 1.f) * li) / den;
            SA_[idx] = (f32x2){ar, ai};
#pragma unroll
            for (int hh = 0; hh < 16; ++hh) {
                const float br = p.s5_b_re[(size_t)idx * 16 + hh], bi = p.s5_b_im[(size_t)idx * 16 + hh];
                const float vr = fr * br - fi * bi, vi = fr * bi + fi * br;
                const bf16_t rh = f2bf(vr), ih = f2bf(vi);
                SB_[((size_t)(dg * 4 + 0) * 64 + pp) * 16 + hh] = rh; SB_[((size_t)(dg * 4 + 1) * 64 + pp) * 16 + hh] = f2bf(vr - bf2f(rh));
                SB_[((size_t)(dg * 4 + 2) * 64 + pp) * 16 + hh] = ih; SB_[((size_t)(dg * 4 + 3) * 64 + pp) * 16 + hh] = f2bf(vi - bf2f(ih));
            }
        }
        for (int idx = blockIdx.x * 512 + tid; idx < 2 * 32 * 16 * 128; idx += gridDim.x * 512) {
            const int k = idx & 127, hh = (idx >> 7) & 15, dg = idx >> 11;
            const float v = (k & 1) ? -p.s5_c_im[((size_t)dg * 16 + hh) * 64 + (k >> 1)] : p.s5_c_re[((size_t)dg * 16 + hh) * 64 + (k >> 1)];
            const bf16_t vh = f2bf(v);
            SC_[((size_t)(dg * 2 + 0) * 16 + hh) * 128 + k] = vh; SC_[((size_t)(dg * 2 + 1) * 16 + hh) * 128 + k] = f2bf(v - bf2f(vh));
        }
    }
}

DI void normmod_phase(const int TID, const float* __restrict__ xl, float* __restrict__ xc, const float* __restrict__ g, const float* __restrict__ modl, int i_shift, int i_scale,
                      bf16_t* __restrict__ XN, int nrows, const float* __restrict__ part, int nslice) {
    const int lane = TID & 63, wave = TID >> 6;
    for (int row = blockIdx.x * 8 + wave; row < nrows; row += gridDim.x * 8) {
        const float* xr = row < TL ? xl + (size_t)row * DM : xc + (size_t)(row - TL) * DM;
        const int v = row < TL ? row / SEQ : 4;
        const float* sh = modl + (size_t)v * MODW + i_shift * DM; const float* sc = modl + (size_t)v * MODW + i_scale * DM;
        f32x4 x[4]; float ss = 0.f;
#pragma unroll
        for (int j = 0; j < 4; ++j) x[j] = __builtin_nontemporal_load((const f32x4*)(xr + 256 * j + 4 * lane));
        if (row >= TL && nslice > 0) {
            for (int sl = 0; sl < nslice; ++sl)
#pragma unroll
                for (int j = 0; j < 4; ++j) x[j] += *(const f32x4*)(part + ((size_t)sl * TC + (row - TL)) * DM + 256 * j + 4 * lane);
#pragma unroll
            for (int j = 0; j < 4; ++j) *(f32x4*)(xc + (size_t)(row - TL) * DM + 256 * j + 4 * lane) = x[j];
        }
#pragma unroll
        for (int j = 0; j < 4; ++j) ss += x[j][0] * x[j][0] + x[j][1] * x[j][1] + x[j][2] * x[j][2] + x[j][3] * x[j][3];
        const float rstd = rsqrtf(wave_sum(ss) * (1.f / DM) + EPSN);
#pragma unroll
        for (int j = 0; j < 4; ++j) {
            const int col = 256 * j + 4 * lane;
            const f32x4 gg = *(const f32x4*)(g + col), s1 = *(const f32x4*)(sc + col), s0 = *(const f32x4*)(sh + col);
            const f32x4 y = (x[j] * rstd * gg) * (s1 + 1.0f) + s0;
            u32x2 w; w.x = pk2(y[0], y[1]); w.y = pk2(y[2], y[3]);
            *(u32x2*)(XN + (size_t)row * DM + col) = w;
        }
    }
}

DI void qkv_post_phase(const int TID, const Params& p, const bf16_t* __restrict__ Z, int ldz, int qcol, int nq, int kcol, int nk, int vcol, int nvh, int dv,
                       const float* __restrict__ gq, const float* __restrict__ gk) {
    extern __shared__ __attribute__((aligned(16))) unsigned char shb[];
    const int tid = TID, lane = tid & 63, wave = tid >> 6;
    bf16_t* Qh = (bf16_t*)(p.ws + OFF_Q); bf16_t* Kh = (bf16_t*)(p.ws + OFF_K); bf16_t* Vt = (bf16_t*)(p.ws + OFF_V);
    const f32x2* ROPE = (const f32x2*)(p.ws + OFF_ROPE);
    {
        const int hsub = lane >> 4, j = lane & 15, ngrp = (nk + 3) >> 2;
        const f32x4 gq4 = *(const f32x4*)(gq + 4 * j) * (0.125f * LOG2E), gk4 = *(const f32x4*)(gk + 4 * j);
        for (int item = blockIdx.x * 8 + wave; item < TT * ngrp; item += gridDim.x * 8) {
            const int row = item / ngrp, hh = nq + (item % ngrp) * 4 + hsub;
            const bool lat = row < TL, valid = hh < nq + nk, isq = hh < nq;
            const int b = lat ? row / SEQ : (row - TL) / CTXL;
            const int key = lat ? row % SEQ : SEQ + (row - TL) % CTXL;
            const int hd = isq ? hh : hh - nq;
            f32x4 x = {0.f, 0.f, 0.f, 0.f};
            if (valid) { const u32x2 w = *(const u32x2*)(Z + (size_t)row * ldz + (isq ? qcol : kcol) + hd * 64 + 4 * j); x = (f32x4){bflo(w.x), bfhi(w.x), bflo(w.y), bfhi(w.y)}; }
            float ss = x[0] * x[0] + x[1] * x[1] + x[2] * x[2] + x[3] * x[3];
            ss += __shfl_xor(ss, 1); ss += __shfl_xor(ss, 2); ss += __shfl_xor(ss, 4); ss += __shfl_xor(ss, 8);
            const float rstd = rsqrtf(ss * (1.f / 64.f) + EPSN);
            f32x4 y = x * rstd * (isq ? gq4 : gk4);
            f32x4 o; o[0] = __shfl_xor(y[0], 8); o[1] = __shfl_xor(y[1], 8); o[2] = __shfl_xor(y[2], 8); o[3] = __shfl_xor(y[3], 8);
            if (lat) {
                const f32x2* cs = ROPE + key * 32 + 4 * (j & 7);
#pragma unroll
                for (int e = 0; e < 4; ++e) { const f32x2 c = cs[e]; y[e] = j < 8 ? y[e] * c[0] - o[e] * c[1] : o[e] * c[1] + y[e] * c[0]; }
            }
            if (valid) {
                bf16_t* dst = (isq ? Qh + ((size_t)(b * nq + hd) * KEYS + key) * 64 : Kh + ((size_t)(b * nk + hd) * KEYS + key) * 64);
                u32x2 w; w.x = pk2(y[0], y[1]); w.y = pk2(y[2], y[3]);
                *(u32x2*)(dst + 4 * j) = w;
            }
        }
    }
    const int vc = nvh * dv, pitch = vc * 2 + 16;
    for (int item = blockIdx.x; item < TT / 64; item += gridDim.x) {
        const int row0 = item * 64;
        const bool lat = row0 < TL;
        const int b = lat ? row0 / SEQ : (row0 - TL) / CTXL;
        const int key0 = lat ? row0 % SEQ : SEQ + (row0 - TL) % CTXL;
        __syncthreads();
        for (int c = tid; c < 64 * (vc / 8); c += 512) {
            const int r = c / (vc / 8), cc = c % (vc / 8);
            *(u32x4*)(shb + r * pitch + cc * 16) = *(const u32x4*)(Z + (size_t)(row0 + r) * ldz + vcol + cc * 8);
        }
        __syncthreads();
        for (int idx = tid; idx < vc * 8; idx += 512) {
            const int tch = idx & 7, col = idx >> 3;
            unsigned short e[8];
#pragma unroll
            for (int k = 0; k < 8; ++k) e[k] = *(const unsigned short*)(shb + (8 * tch + k) * pitch + col * 2);
            u32x4 o; o.x = e[0] | ((unsigned)e[1] << 16); o.y = e[2] | ((unsigned)e[3] << 16); o.z = e[4] | ((unsigned)e[5] << 16); o.w = e[6] | ((unsigned)e[7] << 16);
            const int hd = col / dv, d = col % dv;
            *(u32x4*)(Vt + ((size_t)(b * nvh + hd) * dv + d) * KEYS + key0 + 8 * tch) = o;
        }
    }
}

#define MFMA32(a, b, c) __builtin_amdgcn_mfma_f32_32x32x16_bf16((a), (b), (c), 0, 0, 0)
constexpr int KP = 144, VP = 136;
constexpr int KT_BYTES = 64 * KP;

template <int NDT>
DI void attn_tile(const unsigned char* Kt, const unsigned char* Vtile, const bf16x8 (&qf)[4], f32x16 (&o)[NDT], float& l, float c1, float c2, int r, int h,
                  bool domask, int qk0  ) {
#pragma unroll
    for (int sub = 0; sub < 2; ++sub) {
        f32x16 st;
#pragma unroll
        for (int i = 0; i < 16; ++i) st[i] = -c2;
#pragma unroll
        for (int s = 0; s < 4; ++s) {
            const bf16x8 kf = *(const bf16x8*)(Kt + (32 * sub + r) * KP + (16 * s + 8 * h) * 2);
            st = MFMA32(kf, qf[s], st);
        }
        float pv[16];
#pragma unroll
        for (int i = 0; i < 16; ++i) {
            float e = __builtin_amdgcn_exp2f(st[i]);
            if (domask) { const int dd = qk0 - (32 * sub + (i & 3) + 8 * (i >> 2) + 4 * h); if (dd > 128 || dd < -128) e = 0.f; }
            pv[i] = e; l += e;
        }
        u32x4 w0, w1;
        w0.x = pk2(pv[0], pv[1]); w0.y = pk2(pv[2], pv[3]); w0.z = pk2(pv[4], pv[5]); w0.w = pk2(pv[6], pv[7]);
        w1.x = pk2(pv[8], pv[9]); w1.y = pk2(pv[10], pv[11]); w1.z = pk2(pv[12], pv[13]); w1.w = pk2(pv[14], pv[15]);
        const bf16x8 pf0 = __builtin_bit_cast(bf16x8, w0), pf1 = __builtin_bit_cast(bf16x8, w1);
#pragma unroll
        for (int dt = 0; dt < NDT; ++dt) {
#pragma unroll
            for (int s2 = 0; s2 < 2; ++s2) {
                const unsigned char* vp = Vtile + (32 * dt + r) * VP + (32 * sub + 16 * s2 + 4 * h) * 2;
                const s16x4 lo = *(const s16x4*)vp, hi = *(const s16x4*)(vp + 16);
                const bf16x8 vf = __builtin_shufflevector(lo, hi, 0, 1, 2, 3, 4, 5, 6, 7);
                o[dt] = MFMA32(vf, s2 ? pf1 : pf0, o[dt]);
            }
        }
    }
}

DI void load_q_frags(const bf16_t* __restrict__ zq, const float* __restrict__ gq, const f32x2* __restrict__ rope, int h, bf16x8 (&qf)[4]) {
    float x[4][8]; float ss = 0.f;
#pragma unroll
    for (int s = 0; s < 4; ++s) {
        const u32x4 w = *(const u32x4*)(zq + 16 * s + 8 * h);
        x[s][0] = bflo(w.x); x[s][1] = bfhi(w.x); x[s][2] = bflo(w.y); x[s][3] = bfhi(w.y); x[s][4] = bflo(w.z); x[s][5] = bfhi(w.z); x[s][6] = bflo(w.w); x[s][7] = bfhi(w.w);
#pragma unroll
        for (int j = 0; j < 8; ++j) ss += x[s][j] * x[s][j];
    }
    ss += __shfl_xor(ss, 32);
    const float rstd = rsqrtf(ss * (1.f / 64.f) + EPSN);
#pragma unroll
    for (int s = 0; s < 4; ++s)
#pragma unroll
        for (int j = 0; j < 8; ++j) x[s][j] = x[s][j] * rstd * (gq[16 * s + 8 * h + j] * (0.125f * LOG2E));
    if (rope) {
#pragma unroll
        for (int s = 0; s < 2; ++s)
#pragma unroll
            for (int j = 0; j < 8; ++j) {
                const f32x2 c = rope[16 * s + 8 * h + j];
                const float a = x[s][j], bq = x[s + 2][j];
                x[s][j] = a * c[0] - bq * c[1]; x[s + 2][j] = a * c[1] + bq * c[0];
            }
    }
#pragma unroll
    for (int s = 0; s < 4; ++s) {
        u32x4 w; w.x = pk2(x[s][0], x[s][1]); w.y = pk2(x[s][2], x[s][3]); w.z = pk2(x[s][4], x[s][5]); w.w = pk2(x[s][6], x[s][7]);
        qf[s] = __builtin_bit_cast(bf16x8, w);
    }
}

DI void diff_attn_phase(const int TID, const Params& p, const bf16_t* __restrict__ Z, bf16_t* __restrict__ MIX, float lam_init) {
    extern __shared__ __attribute__((aligned(16))) unsigned char smb[];
    const int tid = TID, lane = tid & 63, wave = tid >> 6, r = lane & 31, h = lane >> 5, rg = wave & 3, m = wave >> 2;
    const bf16_t* Qh = (const bf16_t*)(p.ws + OFF_Q); const bf16_t* Kh = (const bf16_t*)(p.ws + OFF_K); const bf16_t* Vt = (const bf16_t*)(p.ws + OFF_V);
    const float gqm = wave_max(fabsf(p.diff_qk_g[lane])), gkm = wave_max(fabsf(p.diff_qk_g[64 + lane]));
    const float c1 = 0.125f * LOG2E, c2 = 8.f * gqm * gkm * LOG2E;
    const float lam = expf(wave_sum(p.diff_lam[lane] * p.diff_lam[64 + lane])) - expf(wave_sum(p.diff_lam[128 + lane] * p.diff_lam[192 + lane])) + lam_init;
    constexpr int BUFSZ = 2 * KT_BYTES + 128 * VP;
    for (int unit = blockIdx.x; unit < NB * 4 * (SEQ / 128); unit += gridDim.x) {
        const int b = unit >> 8, rem = unit & 255, qb = rem >> 2, hd = rem & 3;
        bf16x8 qf[4];
        { const int qpos_ = qb * 128 + rg * 32 + r;
          load_q_frags(Z + (size_t)(b * SEQ + qpos_) * ODD_IN + 1024 + (2 * hd + m) * 64, p.diff_qk_g, (const f32x2*)(p.ws + OFF_ROPE) + qpos_ * 32, h, qf); }
        const bf16_t* K0g = Kh + (size_t)(b * 8 + 2 * hd) * KEYS * 64;
        const bf16_t* Vg = Vt + (size_t)(b * 4 + hd) * 128 * KEYS;
        f32x16 o[4];
#pragma unroll
        for (int dt = 0; dt < 4; ++dt)
#pragma unroll
            for (int i = 0; i < 16; ++i) o[dt][i] = 0.f;
        float l = 0.f;
        u32x4 pre[4];
        const int kkey = (tid & 511) >> 3, kch = tid & 7;
#define DIFF_LOAD(t) do { const int key0_ = (t) * 64; \
            pre[0] = *(const u32x4*)(K0g + (size_t)(key0_ + kkey) * 64 + kch * 8); \
            pre[1] = *(const u32x4*)(K0g + (size_t)KEYS * 64 + (size_t)(key0_ + kkey) * 64 + kch * 8); \
            pre[2] = *(const u32x4*)(Vg + (size_t)(tid >> 3) * KEYS + key0_ + kch * 8); \
            pre[3] = *(const u32x4*)(Vg + (size_t)((tid >> 3) + 64) * KEYS + key0_ + kch * 8); } while (0)
        DIFF_LOAD(0);
        for (int t = 0; t < KEYS / 64; ++t) {
            unsigned char* buf = smb + (t & 1) * BUFSZ;
            *(u32x4*)(buf + kkey * KP + kch * 16) = pre[0];
            *(u32x4*)(buf + KT_BYTES + kkey * KP + kch * 16) = pre[1];
            { unsigned char* vq = buf + 2 * KT_BYTES + (tid >> 3) * VP + kch * 16;
              *(u32x2*)vq = (u32x2){pre[2].x, pre[2].y}; *(u32x2*)(vq + 8) = (u32x2){pre[2].z, pre[2].w};
              vq += 64 * VP;
              *(u32x2*)vq = (u32x2){pre[3].x, pre[3].y}; *(u32x2*)(vq + 8) = (u32x2){pre[3].z, pre[3].w}; }
            __syncthreads();
            if (t + 1 < KEYS / 64) DIFF_LOAD(t + 1);
            attn_tile<4>(buf + m * KT_BYTES, buf + 2 * KT_BYTES, qf, o, l, c1, c2, r, h, false, 0);
        }
#undef DIFF_LOAD
        l += __shfl_xor(l, 32);
        __syncthreads();
        float* X = (float*)smb;
        if (m == 1) {
            const float inv = lam / l;
#pragma unroll
            for (int dt = 0; dt < 4; ++dt)
#pragma unroll
                for (int i = 0; i < 16; ++i) X[(rg * 64 + lane) * 65 + dt * 16 + i] = o[dt][i] * inv;
        }
        __syncthreads();
        if (m == 0) {
            const float inv = 1.f / l; float ss = 0.f;
#pragma unroll
            for (int dt = 0; dt < 4; ++dt)
#pragma unroll
                for (int i = 0; i < 16; ++i) { const float v = o[dt][i] * inv - X[(rg * 64 + lane) * 65 + dt * 16 + i]; o[dt][i] = v; ss += v * v; }
            ss += __shfl_xor(ss, 32);
            const float rstd = rsqrtf(ss * (1.f / 128.f) + EPSN) * (1.f - lam_init);
            bf16_t* orow = MIX + (size_t)(b * SEQ + qb * 128 + rg * 32 + r) * DM + 512 + hd * 128;
#pragma unroll
            for (int dt = 0; dt < 4; ++dt)
#pragma unroll
                for (int g4 = 0; g4 < 4; ++g4) {
                    const int d = 32 * dt + 8 * g4 + 4 * h;
                    const f32x4 sg = *(const f32x4*)(p.diff_sub_g + d);
                    u32x2 w; w.x = pk2(o[dt][4 * g4] * rstd * sg[0], o[dt][4 * g4 + 1] * rstd * sg[1]); w.y = pk2(o[dt][4 * g4 + 2] * rstd * sg[2], o[dt][4 * g4 + 3] * rstd * sg[3]);
                    *(u32x2*)(orow + d) = w;
                }
        }
        __syncthreads();
    }
}

DI void swa_attn_phase(const int TID, const Params& p, const bf16_t* __restrict__ Z, bf16_t* __restrict__ MIX) {
    extern __shared__ __attribute__((aligned(16))) unsigned char smb[];
    const int tid = TID, lane = tid & 63, wave = tid >> 6, r = lane & 31, h = lane >> 5, rg = wave & 3, hh = wave >> 2;
    const bf16_t* Qh = (const bf16_t*)(p.ws + OFF_Q); const bf16_t* Kh = (const bf16_t*)(p.ws + OFF_K); const bf16_t* Vt = (const bf16_t*)(p.ws + OFF_V);
    const float gqm = wave_max(fabsf(p.swa_qk_g[lane])), gkm = wave_max(fabsf(p.swa_qk_g[64 + lane]));
    const float mb = 8.f * gqm * gkm, c1 = 0.125f * LOG2E, c2 = mb * LOG2E;
    constexpr int BUFSZ = KT_BYTES + 64 * VP;
    constexpr int NLAT = NB * (SEQ / 128) * 4, NCTX = NB * (CTXL / 128) * 4;
    for (int unit = blockIdx.x; unit < NLAT + NCTX; unit += gridDim.x) {
        const bool cq = unit >= NLAT;
        int b, qb, kv, pr;
        if (!cq) { b = unit >> 8; const int rem = unit & 255; qb = rem >> 2; kv = (rem >> 1) & 1; pr = rem & 1; }
        else { const int u2 = unit - NLAT; b = u2 >> 3; const int rem = u2 & 7; qb = rem >> 2; kv = (rem >> 1) & 1; pr = rem & 1; }
        const int head = 4 * kv + 2 * pr + hh;
        const int qpos = qb * 128 + rg * 32 + r;
        bf16x8 qf[4];
        load_q_frags(Z + (size_t)(cq ? TL + b * CTXL + qpos : b * SEQ + qpos) * EVEN_IN + 512 + head * 64, p.swa_qk_g, cq ? (const f32x2*)nullptr : (const f32x2*)(p.ws + OFF_ROPE) + qpos * 32, h, qf);
        const bf16_t* Kg = Kh + (size_t)(b * 2 + kv) * KEYS * 64;
        const bf16_t* Vg = Vt + (size_t)(b * 2 + kv) * 64 * KEYS;
        const int tlo = cq ? 0 : max(0, 2 * qb - 2), thi = cq ? -1 : min(SEQ / 64 - 1, 2 * qb + 3), nloc = thi - tlo + 1, ntile = nloc + CTXL / 64;
        f32x16 o[2];
#pragma unroll
        for (int dt = 0; dt < 2; ++dt)
#pragma unroll
            for (int i = 0; i < 16; ++i) o[dt][i] = 0.f;
        float l = 0.f;
        u32x4 pre[2];
        const int kkey = tid >> 3, kch = tid & 7;
#define SWA_TI(i) ((i) < nloc ? tlo + (i) : SEQ / 64 + ((i) - nloc))
#define SWA_LOAD(i) do { const int key0_ = SWA_TI(i) * 64; \
            pre[0] = *(const u32x4*)(Kg + (size_t)(key0_ + kkey) * 64 + kch * 8); \
            pre[1] = *(const u32x4*)(Vg + (size_t)kkey * KEYS + key0_ + kch * 8); } while (0)
        SWA_LOAD(0);
        for (int t = 0; t < ntile; ++t) {
            unsigned char* buf = smb + (t & 1) * BUFSZ;
            *(u32x4*)(buf + kkey * KP + kch * 16) = pre[0];
            { unsigned char* vq = buf + KT_BYTES + kkey * VP + kch * 16;
              *(u32x2*)vq = (u32x2){pre[1].x, pre[1].y}; *(u32x2*)(vq + 8) = (u32x2){pre[1].z, pre[1].w}; }
            __syncthreads();
            if (t + 1 < ntile) SWA_LOAD(t + 1);
            const int key0t = SWA_TI(t) * 64, qlo = qb * 128 + rg * 32;
            if (!(t < nloc && (key0t > qlo + 31 + 128 || key0t + 63 < qlo - 128)))
                attn_tile<2>(buf, buf + KT_BYTES, qf, o, l, c1, c2, r, h, t < nloc, qpos - key0t);
        }
#undef SWA_LOAD
#undef SWA_TI
        l += __shfl_xor(l, 32);
        l += __builtin_amdgcn_exp2f((p.swa_sink[head] - mb) * LOG2E);
        const float inv = 1.f / l;
        bf16_t* orow = MIX + (size_t)(cq ? TL + b * CTXL + qpos : b * SEQ + qpos) * DM + 512 + head * 64;
#pragma unroll
        for (int dt = 0; dt < 2; ++dt)
#pragma unroll
            for (int g4 = 0; g4 < 4; ++g4) {
                const int d = 32 * dt + 8 * g4 + 4 * h;
                u32x2 w; w.x = pk2(o[dt][4 * g4] * inv, o[dt][4 * g4 + 1] * inv); w.y = pk2(o[dt][4 * g4 + 2] * inv, o[dt][4 * g4 + 3] * inv);
                *(u32x2*)(orow + d) = w;
            }
        __syncthreads();
    }
}

DI float fma_s(float a, float b, float c) { float r; asm volatile("v_fma_f32 %0, %1, %2, %3" : "=v"(r) : "v"(a), "v"(b), "v"(c)); return r; }
DI void cmad(float& xr, float& xi, float ar, float ai, float br, float bi) {
    const float nr = fma_s(-xi, ai, fma_s(xr, ar, br)), ni = fma_s(xi, ar, fma_s(xr, ai, bi));
    xr = nr; xi = ni;
}
template <bool FWD, int Q> DI void s5_quad(const f32x16& br, const f32x16& bi, float ar, float ai, float& Br, float& Bi) {
    constexpr int i0 = FWD ? 4 * Q : 4 * Q + 3, st = FWD ? 1 : -1;
    Br = br[i0]; Bi = bi[i0];
    cmad(Br, Bi, ar, ai, br[i0 + st], bi[i0 + st]); cmad(Br, Bi, ar, ai, br[i0 + 2 * st], bi[i0 + 2 * st]); cmad(Br, Bi, ar, ai, br[i0 + 3 * st], bi[i0 + 3 * st]);
}
DI void s5_bu(const bf16_t* __restrict__ SBq  , bf16x8 af, int pt, int r, int h, f32x16& bur, f32x16& bui) {
#pragma unroll
    for (int i = 0; i < 16; ++i) { bur[i] = 0.f; bui[i] = 0.f; }
    const bf16_t* bp = SBq + (size_t)(pt * 32 + r) * 16 + 8 * h;
    bur = MFMA32(af, *(const bf16x8*)(bp), bur); bur = MFMA32(af, *(const bf16x8*)(bp + 1024), bur);
    bui = MFMA32(af, *(const bf16x8*)(bp + 2048), bui); bui = MFMA32(af, *(const bf16x8*)(bp + 3072), bui);
    float one; asm volatile("v_mov_b32 %0, 1.0" : "=v"(one));
#pragma unroll
    for (int i = 0; i < 16; ++i) { bur[i] *= one; bui[i] *= one; }
}
DI f32x2* s5_cin(unsigned char* ws, int b, int dir, int g) { return (f32x2*)(ws + (dir ? OFF_V : OFF_K) + SZ_QKV / 4) + (size_t)(b * 32 + g) * 264 * 64; }
DI void s5_chunk(int item, int& b, int& g, int& ck, int& row0) {
    ck = item % 264; g = (item / 264) & 31; b = item / (264 * 32);
    row0 = ck < 8 ? TL + b * CTXL + ck * 32 : b * SEQ + (ck - 8) * 32;
}
DI void s5_passA(const int TID, const Params& p, const bf16_t* __restrict__ Z) {
    const int lane = TID & 63, wave = TID >> 6, r = lane & 31, h = lane >> 5;
    const f32x2* SAp = (const f32x2*)(p.ws + OFF_S5A); const bf16_t* SBp = (const bf16_t*)(p.ws + OFF_S5B); f32x2* ST = (f32x2*)(p.ws + OFF_ST);
    for (int item = blockIdx.x * 8 + wave; item < NB * 32 * 264; item += gridDim.x * 8) {
        int b, g, ck, row0; s5_chunk(item, b, g, ck, row0);
        const bf16x8 af = *(const bf16x8*)(Z + (size_t)(row0 + r) * EVEN_IN + g * 16 + 8 * h);
        static_for<0, 2>([&](auto dc) {
            constexpr int dir = decltype(dc)::value;
            static_for<0, 2>([&](auto pc) {
                constexpr int pt = decltype(pc)::value;
                f32x16 bur, bui;
                s5_bu(SBp + (size_t)(dir * 32 + g) * 4096, af, pt, r, h, bur, bui);
                const f32x2 A = SAp[(dir * 32 + g) * 64 + pt * 32 + r];
                float a2r = A[0] * A[0] - A[1] * A[1], a2i = 2.f * A[0] * A[1];
                const float a4r = a2r * a2r - a2i * a2i, a4i = 2.f * a2r * a2i, a8r = a4r * a4r - a4i * a4i, a8i = 2.f * a4r * a4i;
                float Er = 0.f, Ei = 0.f;
                static_for<0, 4>([&](auto kc) {
                    constexpr int q = dir ? 3 - decltype(kc)::value : decltype(kc)::value;
                    float Br, Bi; s5_quad<dir == 0, q>(bur, bui, A[0], A[1], Br, Bi);
                    const float Pr = __shfl_xor(Br, 32), Pi = __shfl_xor(Bi, 32);
                    const bool own_first = (dir == 0) ? (h == 0) : (h == 1);
                    float fr = own_first ? Br : Pr, fi = own_first ? Bi : Pi; const float sr = own_first ? Pr : Br, si = own_first ? Pi : Bi;
                    cmad(fr, fi, a4r, a4i, sr, si);
                    cmad(Er, Ei, a8r, a8i, fr, fi);
                });
                if (h == 0) ST[((size_t)((b * 2 + dir) * 32 + g) * 264 + ck) * 64 + pt * 32 + r] = (f32x2){Er, Ei};
            });
        });
    }
}
DI void s5_passB(const int TID, const Params& p) {
    const f32x2* SAp = (const f32x2*)(p.ws + OFF_S5A); f32x2* ST = (f32x2*)(p.ws + OFF_ST);
    for (int idx = blockIdx.x * 512 + TID; idx < NB * 2 * 32 * 64; idx += gridDim.x * 512) {
        const int pp = idx & 63, bdg = idx >> 6, dir = (bdg >> 5) & 1;
        const f32x2 A = SAp[(bdg & 63) * 64 + pp];
        float ar = A[0], ai = A[1];
#pragma unroll
        for (int q = 0; q < 5; ++q) { const float nr = ar * ar - ai * ai; ai = 2.f * ar * ai; ar = nr; }
        float sr = 0.f, si = 0.f;
        const f32x2* e0 = ST + (size_t)bdg * 264 * 64 + pp;
        f32x2* c0 = s5_cin(p.ws, bdg >> 6, dir, bdg & 31) + pp;
        for (int v0 = 0; v0 < 264; v0 += 12) {
            f32x2 E[12];
#pragma unroll
            for (int k = 0; k < 12; ++k) { const int v = v0 + k; const int ck = dir == 0 ? v : (v < 8 ? 7 - v : 263 - (v - 8)); E[k] = e0[(size_t)ck * 64]; }
#pragma unroll
            for (int k = 0; k < 12; ++k) {
                const int v = v0 + k; const int ck = dir == 0 ? v : (v < 8 ? 7 - v : 263 - (v - 8));
                c0[(size_t)ck * 64] = (f32x2){sr, si};
                cmad(sr, si, ar, ai, E[k][0], E[k][1]);
            }
        }
    }
}
constexpr int HSP = 272;
DI void s5_passC(const int TID, const Params& p, const bf16_t* __restrict__ Z, bf16_t* __restrict__ G) {
    extern __shared__ __attribute__((aligned(16))) unsigned char smb[];
    const int lane = TID & 63, wave = TID >> 6, r = lane & 31, h = lane >> 5, c16 = lane & 15, kg = lane >> 4;
    unsigned char* Hs = smb + wave * (32 * HSP);
    const f32x2* SAp = (const f32x2*)(p.ws + OFF_S5A); const bf16_t* SBp = (const bf16_t*)(p.ws + OFF_S5B); const bf16_t* SCp = (const bf16_t*)(p.ws + OFF_S5C);
    const f32x2* ST = (const f32x2*)(p.ws + OFF_ST);
    for (int item = blockIdx.x * 8 + wave; item < NB * 32 * 264; item += gridDim.x * 8) {
        int b, g, ck, row0; s5_chunk(item, b, g, ck, row0);
        const bf16x8 af = *(const bf16x8*)(Z + (size_t)(row0 + r) * EVEN_IN + g * 16 + 8 * h);
        f32x4 yacc[2] = {{0.f, 0.f, 0.f, 0.f}, {0.f, 0.f, 0.f, 0.f}};
        static_for<0, 2>([&](auto dc) {
            constexpr int dir = decltype(dc)::value;
            static_for<0, 2>([&](auto pc) {
                constexpr int pt = decltype(pc)::value;
                f32x16 bur, bui;
                s5_bu(SBp + (size_t)(dir * 32 + g) * 4096, af, pt, r, h, bur, bui);
                const f32x2 A = SAp[(dir * 32 + g) * 64 + pt * 32 + r];
                float a2r = A[0] * A[0] - A[1] * A[1], a2i = 2.f * A[0] * A[1];
                const float a4r = a2r * a2r - a2i * a2i, a4i = 2.f * a2r * a2i, a8r = a4r * a4r - a4i * a4i, a8i = 2.f * a4r * a4i;
                const f32x2 cin = s5_cin(p.ws, b, dir, g)[(size_t)ck * 64 + pt * 32 + r];
                float Sr = cin[0], Si = cin[1];
                static_for<0, 4>([&](auto kc) {
                    constexpr int q = dir ? 3 - decltype(kc)::value : decltype(kc)::value;
                    float Br, Bi; s5_quad<dir == 0, q>(bur, bui, A[0], A[1], Br, Bi);
                    const float Pr = __shfl_xor(Br, 32), Pi = __shfl_xor(Bi, 32);
                    const bool own_first = (dir == 0) ? (h == 0) : (h == 1);
                    float er = Sr, ei = Si;
                    if (!own_first) cmad(er, ei, a4r, a4i, Pr, Pi);
                    float fr = own_first ? Br : Pr, fi = own_first ? Bi : Pi; const float sr = own_first ? Pr : Br, si = own_first ? Pi : Bi;
                    cmad(fr, fi, a4r, a4i, sr, si);
                    cmad(Sr, Si, a8r, a8i, fr, fi);
                    static_for<0, 4>([&](auto jc) {
                        constexpr int i = dir ? 4 * q + 3 - decltype(jc)::value : 4 * q + decltype(jc)::value;
                        cmad(er, ei, A[0], A[1], bur[i], bui[i]);
                        *(unsigned*)(Hs + (8 * (i >> 2) + 4 * h + (i & 3)) * HSP + (pt * 32 + r) * 4) = pk2(er, ei);
                    });
                });
            });
            LDS_FENCE();
            const bf16_t* cp = SCp + (size_t)(dir * 32 + g) * 2 * 16 * 128 + (size_t)c16 * 128 + 8 * kg;
#pragma unroll
            for (int tt = 0; tt < 2; ++tt)
#pragma unroll
                for (int ks = 0; ks < 4; ++ks) {
                    const bf16x8 hf = *(const bf16x8*)(Hs + (16 * tt + c16) * HSP + (32 * ks + 8 * kg) * 2);
                    yacc[tt] = __builtin_amdgcn_mfma_f32_16x16x32_bf16(hf, *(const bf16x8*)(cp + 32 * ks), yacc[tt], 0, 0, 0);
                    yacc[tt] = __builtin_amdgcn_mfma_f32_16x16x32_bf16(hf, *(const bf16x8*)(cp + 2048 + 32 * ks), yacc[tt], 0, 0, 0);
                }
            LDS_FENCE();
        });
        const float dsk = p.s5_d[g * 16 + c16];
#pragma unroll
        for (int tt = 0; tt < 2; ++tt)
#pragma unroll
            for (int i = 0; i < 4; ++i) {
                const size_t row = (size_t)row0 + 16 * tt + 4 * kg + i;
                const float u = bf2f(Z[row * EVEN_IN + g * 16 + c16]);
                G[row * 512 + g * 16 + c16] = f2bf(gelu_tanh(yacc[tt][i] + dsk * u));
            }
    }
}

constexpr int WLP = 144;
DI void lru_load_wl(const int TID, const Params& p, int n, unsigned char* WL, float* CW) {
    for (int idx = TID; idx < 4 * 4096; idx += 512) {
        const int mat = idx >> 12, de = idx & 4095, d = de >> 6, e = de & 63, dir = mat >> 1;
        const float* src = (mat & 1) ? p.lru_wx : p.lru_wa;
        *(bf16_t*)(WL + mat * 64 * WLP + e * WLP + d * 2) = f2bf(src[(size_t)(dir * 8 + n) * 4096 + de]);
    }
    for (int idx = TID; idx < 4096; idx += 512) { const int e = idx >> 6, d = idx & 63; *(bf16_t*)(WL + 4 * 64 * WLP + e * WLP + d * 2) = (e == d) ? (bf16_t)0x3F80 : (bf16_t)0; }
    if (TID < 320) { const int k = TID >> 6, d = TID & 63; CW[TID] = k < 4 ? p.lru_conv_w[k * 512 + n * 64 + d] : p.lru_conv_b[n * 64 + d]; }
}
DI void lru_afrag(const bf16_t* __restrict__ zr, int t, int seq_len, const float* CW, int h, bf16x8 (&af)[4]) {
#pragma unroll
    for (int s = 0; s < 4; ++s) {
        const int d0 = 16 * s + 8 * h;
        float x[8];
#pragma unroll
        for (int j = 0; j < 8; ++j) x[j] = CW[256 + d0 + j];
#pragma unroll
        for (int k = 0; k < 4; ++k) {
            const int tt = t + k - 2;
            if (tt >= 0 && tt < seq_len) {
                const u32x4 v = *(const u32x4*)(zr + (size_t)tt * ODD_IN + d0);
                const float* w = CW + k * 64 + d0;
                x[0] += bflo(v.x) * w[0]; x[1] += bfhi(v.x) * w[1]; x[2] += bflo(v.y) * w[2]; x[3] += bfhi(v.y) * w[3];
                x[4] += bflo(v.z) * w[4]; x[5] += bfhi(v.z) * w[5]; x[6] += bflo(v.w) * w[6]; x[7] += bfhi(v.w) * w[7];
            }
        }
        u32x4 w4; w4.x = pk2(x[0], x[1]); w4.y = pk2(x[2], x[3]); w4.z = pk2(x[4], x[5]); w4.w = pk2(x[6], x[7]);
        af[s] = __builtin_bit_cast(bf16x8, w4);
    }
}
DI void lru_pre(const unsigned char* WL, const bf16x8 (&af)[4], int et, int r, int h, f32x16 (&pre)[5]) {
#pragma unroll
    for (int mat = 0; mat < 5; ++mat) {
#pragma unroll
        for (int i = 0; i < 16; ++i) pre[mat][i] = 0.f;
#pragma unroll
        for (int s = 0; s < 4; ++s) pre[mat] = MFMA32(af[s], *(const bf16x8*)(WL + mat * 64 * WLP + (et * 32 + r) * WLP + (16 * s + 8 * h) * 2), pre[mat]);
    }
}
DI void lru_gates(const f32x16& pa, const f32x16& px, const f32x16& xcv, float ba, float bx, float sp, float (&a)[16], float (&bq)[16]) {
#pragma unroll
    for (int i = 0; i < 16; ++i) {
        const float rg = sigmoid_f(pa[i] + ba), gi = sigmoid_f(px[i] + bx);
        const float la = -8.f * rg * sp;
        const float av = __builtin_amdgcn_exp2f(la * LOG2E);
        a[i] = av; bq[i] = __builtin_amdgcn_sqrtf(fmaxf(fmaf(-av, av, 1.f), 0.f)) * (gi * xcv[i]);
    }
}
template <bool FWD, int Q> DI void lru_quad(const float (&a)[16], const float (&bq)[16], float& A, float& B) {
    constexpr int i0 = FWD ? 4 * Q : 4 * Q + 3, st = FWD ? 1 : -1;
    A = a[i0] * a[i0 + st] * a[i0 + 2 * st] * a[i0 + 3 * st];
    B = ((bq[i0] * a[i0 + st] + bq[i0 + st]) * a[i0 + 2 * st] + bq[i0 + 2 * st]) * a[i0 + 3 * st] + bq[i0 + 3 * st];
}
DI void lru_passA(const int TID, const Params& p, const bf16_t* __restrict__ Z) {
    extern __shared__ __attribute__((aligned(16))) unsigned char smb[];
    const int lane = TID & 63, wave = TID >> 6, r = lane & 31, h = lane >> 5;
    unsigned char* WL = smb; float* CW = (float*)(smb + 5 * 64 * WLP);
    f32x2* SUM = (f32x2*)(p.ws + OFF_ST);
    const int n = blockIdx.x & 7;
    __syncthreads();
    lru_load_wl(TID, p, n, WL, CW);
    __syncthreads();
    for (int item = (blockIdx.x >> 3) * 8 + wave; item < NB * 264; item += (gridDim.x >> 3) * 8) {
        asm volatile("" ::: "memory");
        const int b = item / 264, ck = item % 264;
        const int seq_len = ck < 8 ? CTXL : SEQ, t0 = ck < 8 ? ck * 32 : (ck - 8) * 32, rowbase = ck < 8 ? TL + b * CTXL : b * SEQ;
        bf16x8 af[4];
        lru_afrag(Z + (size_t)rowbase * ODD_IN + 512 + n * 64, t0 + r, seq_len, CW, h, af);
        static_for<0, 2>([&](auto etc) {
            constexpr int et = decltype(etc)::value;
            const int ch = n * 64 + et * 32 + r;
            f32x16 pre[5];
            lru_pre(WL, af, et, r, h, pre);
            static_for<0, 2>([&](auto dc) {
                constexpr int dir = decltype(dc)::value;
                float a[16], bq[16];
                lru_gates(pre[2 * dir], pre[2 * dir + 1], pre[4], p.lru_ba[dir * 512 + ch], p.lru_bx[dir * 512 + ch], log1pf(__expf(-p.lru_lam[dir * 512 + ch])), a, bq);
                float P = 1.f, E = 0.f;
                static_for<0, 4>([&](auto kc) {
                    constexpr int q = dir ? 3 - decltype(kc)::value : decltype(kc)::value;
                    float A, B;
                    lru_quad<dir == 0, q>(a, bq, A, B);
                    const float Ap = __shfl_xor(A, 32), Bp = __shfl_xor(B, 32);
                    const bool own_first = (dir == 0) ? (h == 0) : (h == 1);
                    const float fA = own_first ? A : Ap, fB = own_first ? B : Bp, sA = own_first ? Ap : A, sB = own_first ? Bp : B;
                    const float pA = fA * sA, pB = sA * fB + sB;
                    E = pA * E + pB; P *= pA;
                });
                if (h == 0) SUM[((size_t)(b * 2 + dir) * 264 + ck) * 512 + ch] = (f32x2){P, E};
            });
        });
    }
}
DI void lru_passB(const int TID, const Params& p) {
    const f32x2* SUM = (const f32x2*)(p.ws + OFF_ST); float* LC = (float*)(p.ws + OFF_LCIN);
    for (int idx = blockIdx.x * 512 + TID; idx < NB * 2 * 512; idx += gridDim.x * 512) {
        const int ch = idx & 511, bd = idx >> 9, dir = bd & 1;
        float s = 0.f;
        for (int v0 = 0; v0 < 264; v0 += 24) {
            f32x2 pe[24];
#pragma unroll
            for (int k = 0; k < 24; ++k) { const int v = v0 + k; const int ck = dir == 0 ? v : (v < 8 ? 7 - v : 263 - (v - 8)); pe[k] = SUM[((size_t)bd * 264 + ck) * 512 + ch]; }
#pragma unroll
            for (int k = 0; k < 24; ++k) { const int v = v0 + k; const int ck = dir == 0 ? v : (v < 8 ? 7 - v : 263 - (v - 8)); LC[((size_t)bd * 264 + ck) * 512 + ch] = s; s = pe[k][0] * s + pe[k][1]; }
        }
    }
}
DI void lru_passC(const int TID, const Params& p, const bf16_t* __restrict__ Z, bf16_t* __restrict__ MIX) {
    extern __shared__ __attribute__((aligned(16))) unsigned char smb[];
    const int lane = TID & 63, wave = TID >> 6, r = lane & 31, h = lane >> 5;
    unsigned char* WL = smb; float* CW = (float*)(smb + 5 * 64 * WLP);
    const float* LC = (const float*)(p.ws + OFF_LCIN);
    const int n = blockIdx.x & 7;
    __syncthreads();
    lru_load_wl(TID, p, n, WL, CW);
    __syncthreads();
    for (int item = (blockIdx.x >> 3) * 8 + wave; item < NB * 256; item += (gridDim.x >> 3) * 8) {
        asm volatile("" ::: "memory");
        const int b = item >> 8, j = item & 255, ck = 8 + j, t0 = j * 32;
        bf16x8 af[4];
        lru_afrag(Z + (size_t)b * SEQ * ODD_IN + 512 + n * 64, t0 + r, SEQ, CW, h, af);
        static_for<0, 2>([&](auto etc) {
            constexpr int et = decltype(etc)::value;
            const int ch = n * 64 + et * 32 + r;
            f32x16 pre[5];
            lru_pre(WL, af, et, r, h, pre);
            float y[16];
            static_for<0, 2>([&](auto dc) {
                constexpr int dir = decltype(dc)::value;
                float a[16], bq[16];
                lru_gates(pre[2 * dir], pre[2 * dir + 1], pre[4], p.lru_ba[dir * 512 + ch], p.lru_bx[dir * 512 + ch], log1pf(__expf(-p.lru_lam[dir * 512 + ch])), a, bq);
                float S = LC[((size_t)(b * 2 + dir) * 264 + ck) * 512 + ch];
                static_for<0, 4>([&](auto kc) {
                    constexpr int q = dir ? 3 - decltype(kc)::value : decltype(kc)::value;
                    float A, B;
                    lru_quad<dir == 0, q>(a, bq, A, B);
                    const float Ap = __shfl_xor(A, 32), Bp = __shfl_xor(B, 32);
                    const bool own_first = (dir == 0) ? (h == 0) : (h == 1);
                    float s = own_first ? S : Ap * S + Bp;
                    const float fA = own_first ? A : Ap, fB = own_first ? B : Bp, sA = own_first ? Ap : A, sB = own_first ? Bp : B;
                    S = (fA * sA) * S + (sA * fB + sB);
                    static_for<0, 4>([&](auto jc) {
                        constexpr int i = dir ? 4 * q + 3 - decltype(jc)::value : 4 * q + decltype(jc)::value;
                        s = a[i] * s + bq[i];
                        if (dir == 0) y[i] = s; else y[i] += s;
                    });
                });
            });
#pragma unroll
            for (int i = 0; i < 16; ++i) {
                const size_t row = (size_t)b * SEQ + t0 + 8 * (i >> 2) + 4 * h + (i & 3);
                const float gz = bf2f(Z[row * ODD_IN + ch]);
                MIX[row * DM + ch] = f2bf(y[i] * gelu_tanh(gz));
            }
        });
    }
}

constexpr int NPHASE = 26;
#ifndef MK_RPT
#define MK_RPT 0ull
#endif
#define RPT(bit, ...) do { __VA_ARGS__; if ((MK_RPT >> (bit)) & 1ull) { __syncthreads(); __VA_ARGS__; } } while (0)
DI void run_phase(const int TID, const Params& p, int ph) {
    if (ph == 0) { RPT(0, prologue_phase(TID, p)); return; }
    const int l = ph >= 14 ? 1 : 0;
    int s = l ? ph - 13 : ph;
    if (l && s >= 9) s += 1;
    const int rb = 16 * l;
    unsigned char* ws = p.ws;
    float* ctxx = (float*)(ws + OFF_CTXX);
    const float* modl = (const float*)(ws + OFF_MOD) + (size_t)l * 5 * MODW;
    bf16_t* XN = (bf16_t*)(ws + OFF_XN); bf16_t* H = (bf16_t*)(ws + OFF_H); bf16_t* G = (bf16_t*)(ws + OFF_G);
    const bool first = (l == 0 && s <= 3);
    const float* srcL = first ? p.x : p.out; const float* srcC = ctxx;
    (void)srcC;
    const int nrows = (l == 1 && s >= 10) ? TL : TT;
    const int f = s >= 11 ? 1 : 0;
    const bf16_t* W13 = (const bf16_t*)(ws + OFF_W + (size_t)(l * 2 + f) * SZ_FFN);
    const bf16_t* W2 = (const bf16_t*)(ws + OFF_W + (size_t)(l * 2 + f) * SZ_FFN + SZ_W13);
    switch (s) {
    case 1: case 4: case 11: {
        const int gi = s == 1 ? 0 : (s == 4 ? 1 : 2);
        const int nsl = (l == 0 && s == 1) ? 0 : (s == 11 ? 4 : 11);
        normmod_phase(TID, srcL, ctxx, p.norm_g + (size_t)(l * 3 + gi) * DM, modl, 3 * gi, 3 * gi + 1, XN, nrows, (const float*)(ws + OFF_Q), nsl);
    } break;
    case 2: case 12: { EpiSwiglu e{H}; RPT(rb + s, gemm_phase(TID, XN, W13, nrows, 2 * DFF, DM, e)); } break;
    case 3: case 13: case 10: {
        const float* gbase = modl + (s == 3 ? 2 : (s == 13 ? 8 : 5)) * DM; const float coef = s == 10 ? 1.0f : 0.5f;
        EpiResid e{srcL, srcC, p.out, ctxx, gbase, coef};
        EpiPartial ea{(float*)(ws + OFF_Q), gbase + (size_t)4 * MODW, coef};
        const bf16_t* Wo = (const bf16_t*)(ws + (l ? OFF_ODOUT : OFF_EVOUT));
        if (s == 10) { gemm_phase(TID, XN, Wo, TL, DM, DM, e); if (nrows == TT) gemm_phase(TID, XN + (size_t)TL * DM, Wo, TC, DM, DM, ea, 4); }
        else { gemm_phase(TID, H, W2, TL, DM, DFF, e); if (nrows == TT) gemm_phase(TID, H + (size_t)TL * DFF, W2, TC, DM, DFF, ea, 11); }
    } break;
    case 5: {
        EpiStoreBf16 e{H, l ? ODD_IN : EVEN_IN};
        RPT(rb + s, gemm_phase(TID, XN, (const bf16_t*)(ws + (l ? OFF_ODIN : OFF_EVIN)), TT, l ? ODD_IN : EVEN_IN, DM, e));
    } break;
    case 6:
        if (l == 0) { RPT(6, qkv_post_phase(TID, p, H, EVEN_IN, 512, 8, 1024, 2, 1152, 2, 64, p.swa_qk_g, p.swa_qk_g + 64)); __syncthreads(); RPT(14, s5_passA(TID, p, H)); }
        else { RPT(22, qkv_post_phase(TID, p, H, ODD_IN, 1024, 8, 1536, 8, 2048, 4, 128, p.diff_qk_g, p.diff_qk_g + 64)); __syncthreads(); RPT(30, lru_passA(TID, p, H)); }
        break;
    case 7:
        if (l == 0) { s5_passB(TID, p); RPT(7, swa_attn_phase(TID, p, H, XN)); }
        else { lru_passB(TID, p); RPT(23, diff_attn_phase(TID, p, H, XN, 0.8f - 0.6f * 0.74081822068171788f)); }
        break;
    case 8:
        if (l == 0) RPT(8, s5_passC(TID, p, H, G)); else RPT(24, lru_passC(TID, p, H, XN));
        break;
    case 9: { EpiGlu e{G, p.s5_glu_b, XN}; RPT(9, gemm_phase(TID, G, (const bf16_t*)(ws + OFF_GLUW), TT, 512, 512, e)); } break;
    default: break;
    }
}

DI int mk_tid(int wv) { int l; asm volatile("v_mbcnt_lo_u32_b32 %0, -1, 0\n\tv_mbcnt_hi_u32_b32 %0, -1, %0" : "=v"(l)); return wv * 64 + l; }
#define XB_TMO      128
#define XB_XCNT(j)  (256  + 64 * (j))
#define XB_XSUB(j)  (1280 + 64 * (j))
#define XB_XGEN(j)  (2304 + 64 * (j))
#define XB_TOP      3328
#define XB_TOPGEN   3392
#define XCD_BAR_WORDS 3456
#define XB_SPIN_CAP (1u << 22)
#define LAS __attribute__((address_space(3)))
DI unsigned xb_ld(unsigned* p) { return __hip_atomic_load(p, __ATOMIC_RELAXED, __HIP_MEMORY_SCOPE_AGENT); }
DI unsigned xb_add(unsigned* p, unsigned v) { return __hip_atomic_fetch_add(p, v, __ATOMIC_RELAXED, __HIP_MEMORY_SCOPE_AGENT); }
DI unsigned xb_xcc_id() { return (unsigned)__builtin_amdgcn_s_getreg((3 << 11) | 20) & 0xFu; }
#define XB_SPIN(cond, bar) do { unsigned _sp = 0; while (cond) { __builtin_amdgcn_s_sleep(1); \
    if ((++_sp & 255u) == 0u) { if (xb_ld(&(bar)[XB_TMO])) break; if (_sp > XB_SPIN_CAP) { atomicAdd(&(bar)[XB_TMO], 1u); break; } } } } while (0)
DI void xcd_barrier_complete(unsigned* bar, unsigned x, unsigned& nloc, unsigned& nx) {
    const unsigned G = gridDim.x;
    unsigned sum, cnt, mine, sp = 0u;
    for (;;) {
        sum = 0u; cnt = 0u; mine = 0u;
#pragma unroll
        for (unsigned j = 0; j < 16; ++j) { const unsigned c = xb_ld(&bar[XB_XCNT(j)]); sum += c; cnt += (c > 0u) ? 1u : 0u; mine = (j == x) ? c : mine; }
        if (sum == G) break;
        __builtin_amdgcn_s_sleep(1);
        if ((++sp & 255u) == 0u) { if (xb_ld(&bar[XB_TMO])) break; if (sp > XB_SPIN_CAP) { atomicAdd(&bar[XB_TMO], 1u); break; } }
    }
    nloc = mine > 0u ? mine : 1u; nx = cnt > 0u ? cnt : 1u;
}
DI void xcd_barrier(unsigned* bar, int tid) {
    extern __shared__ __attribute__((aligned(16))) unsigned char smx[];
    volatile LAS unsigned* st = (volatile LAS unsigned*)(smx + 131072);
    asm volatile("s_waitcnt vmcnt(0)" ::: "memory");
    __syncthreads();
    if (tid == 0) {
        const unsigned x = xb_xcc_id();
        __builtin_amdgcn_s_waitcnt(0);
        unsigned nloc = st[0], nx = st[1];
        if (nloc == 0u) { xcd_barrier_complete(bar, x, nloc, nx); st[0] = nloc; st[1] = nx; }
        const unsigned old = xb_add(&bar[XB_XSUB(x)], 1u);
        const unsigned gen = old / nloc;
        if (old + 1u == (gen + 1u) * nloc) {
            __builtin_amdgcn_fence(__ATOMIC_RELEASE, "agent");
            asm volatile("s_waitcnt vmcnt(0)" ::: "memory");
            const unsigned og = xb_add(&bar[XB_TOP], 1u);
            const unsigned tg = og / nx;
            if (og + 1u == (tg + 1u) * nx) xb_add(&bar[XB_TOPGEN], 1u);
            else XB_SPIN(xb_ld(&bar[XB_TOPGEN]) == tg, bar);
            __builtin_amdgcn_fence(__ATOMIC_ACQUIRE, "agent");
            xb_add(&bar[XB_XGEN(x)], 1u);
            asm volatile("s_waitcnt vmcnt(0)" ::: "memory");
        } else {
            XB_SPIN(xb_ld(&bar[XB_XGEN(x)]) == gen, bar);
            __builtin_amdgcn_fence(__ATOMIC_ACQUIRE, "agent");
            asm volatile("s_waitcnt vmcnt(0)" ::: "memory");
        }
    }
    __syncthreads();
}
template <int K>
DI void run_all(const int wv, const Params& p, int lo, int hi) {
    if constexpr (K < NPHASE) {
        if (K >= lo && K < hi) {
            const int tid = mk_tid(wv);
            run_phase(tid, p, K);
            if (K + 1 < hi) { xcd_barrier((unsigned*)(p.ws + OFF_BAR), tid); if ((MK_RPT >> 63) & 1ull) xcd_barrier((unsigned*)(p.ws + OFF_BAR), tid); }
        }
        run_all<K + 1>(wv, p, lo, hi);
    }
}
__global__ void __launch_bounds__(512) mega_fwd(Params p, int ph_lo, int ph_hi) {
    const int wv = __builtin_amdgcn_readfirstlane((int)(threadIdx.x >> 6));
    {
        extern __shared__ __attribute__((aligned(16))) unsigned char smx[];
        if (threadIdx.x == 0) { *(u32x4*)(smx + 131072) = (u32x4){0u, 0u, 0u, 0u}; (void)xb_add((unsigned*)(p.ws + OFF_BAR) + XB_XCNT(xb_xcc_id()), 1u); }
        __syncthreads();
    }
    if (ph_hi - ph_lo > 1) cg::this_grid().sync();
    run_all<0>(wv, p, ph_lo, ph_hi);
}

#ifndef MK_MULTI
#define MK_MULTI 0
#endif
extern "C" void kernel_launch(void* const* d_in, const int* in_sizes, int n_in, void* d_out, int out_size, void* d_ws, size_t ws_size, hipStream_t stream) {
    static int grid = 0;
    if (grid == 0) {
        if (n_in != 37 || in_sizes[0] != TL * DM || out_size != TL * DM || ws_size < WS_END) {
            fprintf(stderr, "kernel_launch: unexpected problem: n_in %d in0 %d out %d ws %zu (need %zu)\n", n_in, n_in > 0 ? in_sizes[0] : -1, out_size, ws_size, (size_t)WS_END);
            grid = -1; return;
        }
        int dev = 0, cus = 0, per_cu = 0;
        (void)hipGetDevice(&dev);
        (void)hipDeviceGetAttribute(&cus, hipDeviceAttributeMultiprocessorCount, dev);
        if (hipFuncSetAttribute((const void*)mega_fwd, hipFuncAttributeMaxDynamicSharedMemorySize, LDS_BYTES) != hipSuccess) { fprintf(stderr, "kernel_launch: hipFuncSetAttribute failed\n"); grid = -1; return; }
        (void)hipOccupancyMaxActiveBlocksPerMultiprocessor(&per_cu, (const void*)mega_fwd, 512, LDS_BYTES);
        if (per_cu < 1) { fprintf(stderr, "kernel_launch: occupancy query says %d blocks per CU\n", per_cu); per_cu = 1; }
        (void)hipGetLastError();
        grid = cus * per_cu;
    }
    if (grid < 0) return;
    if (hipMemsetAsync((unsigned char*)d_ws + OFF_BAR, 0, 16384, stream) != hipSuccess) { fprintf(stderr, "kernel_launch: memset failed\n"); return; }
    Params p{};
    const float** pp = (const float**)&p;
    for (int i = 0; i < 37; ++i) pp[i] = (const float*)d_in[i];
    p.out = (float*)d_out; p.ws = (unsigned char*)d_ws;
#if MK_MULTI
    for (int ph = 0; ph < NPHASE; ++ph) hipLaunchKernelGGL(mega_fwd, dim3(grid), dim3(512), LDS_BYTES, stream, p, ph, ph + 1);
#else
    int lo = 0, hi = NPHASE;
    void* args[] = {&p, &lo, &hi};
    hipError_t e = hipLaunchCooperativeKernel((const void*)mega_fwd, dim3(grid), dim3(512), args, LDS_BYTES, stream);
    if (e != hipSuccess) fprintf(stderr, "kernel_launch: cooperative launch failed: %s (grid %d)\n", hipGetErrorString(e), grid);
#endif
}
```

```cpp
#include <hip/hip_runtime.h>
#include <hip/hip_cooperative_groups.h>
#include <cstdio>
#include <cstdint>
namespace cg = cooperative_groups;

#define DI __device__ __forceinline__
typedef unsigned short bf16_t;
typedef short bf16x8 __attribute__((ext_vector_type(8)));
typedef short s16x4 __attribute__((ext_vector_type(4)));
typedef float f32x2 __attribute__((ext_vector_type(2)));
typedef float f32x4 __attribute__((ext_vector_type(4)));
typedef float f32x16 __attribute__((ext_vector_type(16)));
typedef unsigned u32x2 __attribute__((ext_vector_type(2)));
typedef unsigned u32x4 __attribute__((ext_vector_type(4)));
typedef __bf16 bf16x2_t __attribute__((ext_vector_type(2)));

constexpr int DM = 1024, NB = 4, SEQ = 8192, CTXL = 256, TL = NB * SEQ, TC = NB * CTXL, TT = TL + TC, DFF = 2816, KEYS = SEQ + CTXL;
constexpr int NMOD = 9, MODW = NMOD * DM;
constexpr int EVEN_IN = 1280, ODD_IN = 2560;
constexpr float EPSN = 1e-6f;
constexpr float LOG2E = 1.4426950408889634f;

constexpr size_t SZ_W13 = (size_t)2 * DFF * DM * 2, SZ_W2 = (size_t)DM * DFF * 2, SZ_FFN = SZ_W13 + SZ_W2;
constexpr size_t OFF_W = 0;
constexpr size_t OFF_EVIN = OFF_W + 4 * SZ_FFN;
constexpr size_t OFF_EVOUT = OFF_EVIN + (size_t)EVEN_IN * DM * 2;
constexpr size_t OFF_GLUW = OFF_EVOUT + (size_t)DM * DM * 2;
constexpr size_t OFF_ODIN = OFF_GLUW + (size_t)512 * 512 * 2;
constexpr size_t OFF_ODOUT = OFF_ODIN + (size_t)ODD_IN * DM * 2;
constexpr size_t OFF_XN = OFF_ODOUT + (size_t)DM * DM * 2;
constexpr size_t OFF_H = OFF_XN + (size_t)TT * DM * 2;
constexpr size_t OFF_CTXX = OFF_H + (size_t)TT * DFF * 2;
constexpr size_t OFF_MOD = OFF_CTXX + (size_t)TC * DM * 4;
constexpr size_t OFF_ROPE = OFF_MOD + (size_t)2 * 5 * MODW * 4;
constexpr size_t OFF_S5A = OFF_ROPE + (size_t)SEQ * 32 * 8;
constexpr size_t OFF_S5B = OFF_S5A + (size_t)2 * 32 * 64 * 8;
constexpr size_t OFF_Q = OFF_S5B + (size_t)2 * 32 * 64 * 16 * 8;
constexpr size_t SZ_QKV = (size_t)NB * 8 * KEYS * 64 * 2;
constexpr size_t OFF_K = OFF_Q + SZ_QKV;
constexpr size_t OFF_V = OFF_K + SZ_QKV;
constexpr size_t OFF_G = OFF_V + SZ_QKV;
constexpr size_t OFF_ST = OFF_G + (size_t)TT * 512 * 2;
constexpr size_t SZ_ST = (size_t)NB * 2 * 32 * 264 * 64 * 8;
constexpr size_t OFF_LCIN = OFF_ST + (size_t)NB * 2 * 264 * 512 * 8;
constexpr size_t OFF_BAR = OFF_ST + SZ_ST;
constexpr size_t OFF_S5C = OFF_BAR + 16384;
constexpr size_t WS_END = OFF_S5C + (size_t)2 * 32 * 2 * 16 * 128 * 2;
static_assert(OFF_LCIN + (size_t)NB * 2 * 264 * 512 * 4 <= OFF_BAR, "lru regions");
static_assert(SZ_QKV / 4 + (size_t)NB * 32 * 264 * 64 * 8 <= SZ_QKV, "s5 carry-in regions");
constexpr int LDS_BYTES = 131072 + 16;

struct Params {
    const float *x, *c, *ctx, *c_ctx, *mod_w, *mod_b, *norm_g, *ffn1_w13, *ffn1_w2, *ffn2_w13, *ffn2_w2, *ev_w_in, *ev_w_out;
    const float *s5_lam_re, *s5_lam_im, *s5_log_dt, *s5_b_re, *s5_b_im, *s5_c_re, *s5_c_im, *s5_d, *s5_glu_w, *s5_glu_b, *swa_qk_g, *swa_sink;
    const float *od_w_in, *od_w_out, *lru_conv_w, *lru_conv_b, *lru_wa, *lru_ba, *lru_wx, *lru_bx, *lru_lam, *diff_qk_g, *diff_lam, *diff_sub_g;
    float* out;
    unsigned char* ws;
};

DI unsigned pk2(float lo, float hi) { f32x2 v = {lo, hi}; bf16x2_t r = __builtin_convertvector(v, bf16x2_t); return __builtin_bit_cast(unsigned, r); }
DI bf16_t f2bf(float x) { return (bf16_t)(pk2(x, 0.f) & 0xffffu); }
DI float bf2f(bf16_t v) { return __uint_as_float((unsigned)v << 16); }
DI float bflo(unsigned w) { return __uint_as_float(w << 16); }
DI float bfhi(unsigned w) { return __uint_as_float(w & 0xffff0000u); }
DI float wave_sum(float v) {
#pragma unroll
    for (int o = 32; o; o >>= 1) v += __shfl_xor(v, o);
    return v;
}
DI float wave_max(float v) {
#pragma unroll
    for (int o = 32; o; o >>= 1) v = fmaxf(v, __shfl_xor(v, o));
    return v;
}
DI float sigmoid_f(float x) { return __builtin_amdgcn_rcpf(1.f + __builtin_amdgcn_exp2f(-LOG2E * x)); }
DI float silu_f(float x) { return x * sigmoid_f(x); }
DI float gelu_tanh(float x) { const float u = 0.7978845608028654f * (x + 0.044715f * x * x * x); return x * sigmoid_f(2.f * u); }
#define LDS_FENCE() asm volatile("s_waitcnt lgkmcnt(0)" ::: "memory")
template <int V> struct IC { static constexpr int value = V; };
template <int I, int N, class F> DI void static_for(F&& f) { if constexpr (I < N) { f(IC<I>{}); static_for<I + 1, N>(f); } }

constexpr int BM = 256, BK = 64, HALF = 128, HT = HALF * BK, NXCD = 8, WGM = 8;
DI int lds_byte(int r, int c) { int st = (r >> 4) * 2 + (c >> 5), rr = r & 15, cc = c & 31, ob = rr * 64 + cc * 2; return st * 1024 + (ob ^ (((ob >> 9) & 1) << 5)); }
DI void stage_rc(int b, int& R, int& C) { int st = b / 1024, sb = b % 1024, swz = sb ^ (((sb >> 9) & 1) << 5); R = (st >> 1) * 16 + swz / 64; C = (st & 1) * 32 + (swz % 64) / 2; }

template <class Epi>
DI void gemm_phase(const int TID, const bf16_t* __restrict__ A, const bf16_t* __restrict__ Bt, int M, int N, int K, const Epi& epi, const int S = 1) {
    extern __shared__ __attribute__((aligned(16))) bf16_t shm[];
    int tidx = TID; asm volatile("" : "+v"(tidx));
#define SA(b, h) (shm + ((b) * 2 + (h)) * HT)
#define SB(b, h) (shm + (4 + (b) * 2 + (h)) * HT)
#define STAGE(P, BASE, br, kt) do { const char* _ub = (const char*)(BASE) + ((long)(br) * K + (long)((kt) + kbase) * BK) * 2; \
      __builtin_amdgcn_global_load_lds((const unsigned*)(_ub + voff0), (unsigned*)((char*)(P) + wv_s * 1024), 16, 0, 0); \
      __builtin_amdgcn_global_load_lds((const unsigned*)(_ub + voff1), (unsigned*)((char*)(P) + wv_s * 1024 + 8192), 16, 0, 0); } while (0)
#define LDA(dst, b, h) for (int m = 0; m < 4; ++m) for (int k = 0; k < 2; ++k) \
    dst[m][k] = *reinterpret_cast<const bf16x8*>((char*)SA(b, h) + lds_byte(wr * 64 + m * 16 + fr, k * 32 + fq * 8))
#define LDB(dst, b, h) for (int n = 0; n < 2; ++n) for (int k = 0; k < 2; ++k) \
    dst[n][k] = *reinterpret_cast<const bf16x8*>((char*)SB(b, h) + lds_byte(wc * 32 + n * 16 + fr, k * 32 + fq * 8))
#define MMA(ai, bj, At_, Bt_) do { __builtin_amdgcn_s_setprio(1); \
    for (int m = 0; m < 4; ++m) for (int n = 0; n < 2; ++n) for (int k = 0; k < 2; ++k) \
      acc[ai][bj][m][n] = __builtin_amdgcn_mfma_f32_16x16x32_bf16(Bt_[n][k], At_[m][k], acc[ai][bj][m][n], 0, 0, 0); \
    __builtin_amdgcn_s_setprio(0); } while (0)
#define WAIT_V(n) asm volatile("s_waitcnt vmcnt(" #n ")" ::: "memory")
#define WAIT_L(n) asm volatile("s_waitcnt lgkmcnt(" #n ")" ::: "memory")
#define BAR __builtin_amdgcn_s_barrier()
#define SCHED __builtin_amdgcn_sched_barrier(0)
    const int nM = M / BM, nN = N / BM, ntile = nM * nN, nwg = ntile * S;
    const int wid = tidx >> 6, lane = tidx & 63, wr = wid >> 2, wc = wid & 3, fr = lane & 15, fq = lane >> 4;
    const int nt = K / BK / S;
    const int wv_s = __builtin_amdgcn_readfirstlane(tidx >> 6);
    unsigned voff0, voff1;
    { int r_, c_; stage_rc(tidx * 16, r_, c_); voff0 = (unsigned)(r_ * K + c_) * 2u; stage_rc(tidx * 16 + 8192, r_, c_); voff1 = (unsigned)(r_ * K + c_) * 2u; }
#define TILE_COORDS(L_, pm_, pn_, kb_) do { int wgid = (int)(L_); \
        if (S == 1) { const int q = nwg / NXCD, r = nwg % NXCD, xcd = wgid % NXCD, off = wgid / NXCD; wgid = (xcd < r ? xcd * (q + 1) : r * (q + 1) + (xcd - r) * q) + off; kb_ = 0; } \
        else { kb_ = (wgid % S) * nt; wgid /= S; } \
        const int nig = WGM * nN, gid = wgid / nig, fm = gid * WGM, gsz = min(nM - fm, WGM); \
        pm_ = fm + ((wgid % nig) % gsz); pn_ = (wgid % nig) / gsz; } while (0)
#define STAGE_P1(brow_, bcol_) do { STAGE(SB(0, 0), Bt, bcol_, 0); STAGE(SA(0, 0), A, brow_, 0); STAGE(SB(0, 1), Bt, (bcol_) + HALF, 0); STAGE(SA(0, 1), A, (brow_) + HALF, 0); } while (0)
    long L = blockIdx.x;
    if (L >= nwg) return;
    int pm, pn, kbase;
    TILE_COORDS(L, pm, pn, kbase);
    STAGE_P1(pm * BM, pn * BM);
    for (;;) {
        const int brow = pm * BM, bcol = pn * BM;
        f32x4 acc[2][2][4][2] = {};
        bf16x8 At[4][2], B0[2][2], B1[2][2];
        if (wr == 1) BAR;
        WAIT_V(0); BAR;
        STAGE(SB(1, 0), Bt, bcol, 1); STAGE(SA(1, 0), A, brow, 1); STAGE(SB(1, 1), Bt, bcol + HALF, 1);
        WAIT_V(6); BAR;
        for (int t = 0; t < nt - 2; t += 2) {
            LDB(B0, 0, 0); SCHED; LDA(At, 0, 0); STAGE(SA(1, 1), A, brow + HALF, t + 1);
            WAIT_L(8); BAR; WAIT_L(0); MMA(0, 0, At, B0); BAR; SCHED;
            LDB(B1, 0, 1); STAGE(SB(0, 0), Bt, bcol, t + 2);
            BAR; WAIT_L(0); MMA(0, 1, At, B1); BAR;
            LDA(At, 0, 1); STAGE(SA(0, 0), A, brow, t + 2);
            BAR; WAIT_L(0); MMA(1, 0, At, B0); BAR; SCHED;
            STAGE(SB(0, 1), Bt, bcol + HALF, t + 2);
            WAIT_V(6); BAR; MMA(1, 1, At, B1); BAR;
            LDB(B0, 1, 0); SCHED; LDA(At, 1, 0); STAGE(SA(0, 1), A, brow + HALF, t + 2);
            WAIT_L(8); BAR; WAIT_L(0); MMA(0, 0, At, B0); BAR; SCHED;
            LDB(B1, 1, 1); STAGE(SB(1, 0), Bt, bcol, t + 3);
            BAR; WAIT_L(0); MMA(0, 1, At, B1); BAR;
            LDA(At, 1, 1); STAGE(SA(1, 0), A, brow, t + 3);
            BAR; WAIT_L(0); MMA(1, 0, At, B0); BAR; SCHED;
            STAGE(SB(1, 1), Bt, bcol + HALF, t + 3);
            WAIT_V(6); BAR; MMA(1, 1, At, B1); BAR;
        }
        { LDB(B0, 0, 0); LDA(At, 0, 0); STAGE(SA(1, 1), A, brow + HALF, nt - 1);
          BAR; WAIT_L(0); MMA(0, 0, At, B0); BAR;
          LDB(B1, 0, 1); BAR; WAIT_L(0); MMA(0, 1, At, B1); BAR;
          LDA(At, 0, 1); WAIT_V(4); BAR; WAIT_L(0); MMA(1, 0, At, B0); MMA(1, 1, At, B1); BAR; }
        { LDB(B0, 1, 0); LDA(At, 1, 0); WAIT_V(2); BAR; WAIT_L(0); MMA(0, 0, At, B0); BAR;
          LDB(B1, 1, 1); WAIT_V(0); BAR; WAIT_L(0); MMA(0, 1, At, B1); BAR;
          LDA(At, 1, 1); BAR; WAIT_L(0); MMA(1, 0, At, B0); MMA(1, 1, At, B1); BAR; }
        if (wr == 0) BAR;
        const int kbase_cur = kbase;
        L += gridDim.x;
        const bool has_next = L < nwg;
        int pm_n = 0, pn_n = 0, kb_n = 0;
        if (has_next) { TILE_COORDS(L, pm_n, pn_n, kb_n); kbase = kb_n; STAGE_P1(pm_n * BM, pn_n * BM); }
        asm volatile("" ::: "memory"); SCHED;
        { int t2 = TID; asm volatile("" : "+v"(t2));
          int pm2 = S == 1 ? pm : pm + (kbase_cur / nt) * nM, pn2 = pn; asm volatile("" : "+s"(pm2), "+s"(pn2));
          epi(acc, pm2, pn2, t2 >> 8, (t2 >> 6) & 3, t2 & 15, (t2 & 63) >> 4); }
        asm volatile("" ::: "memory"); SCHED;
        if (!has_next) break;
        pm = pm_n; pn = pn_n;
    }
#undef TILE_COORDS
#undef STAGE_P1
#undef SA
#undef SB
#undef STAGE
#undef LDA
#undef LDB
#undef MMA
}

struct EpiSwiglu {
    bf16_t* H;
    DI void operator()(const f32x4 (&acc)[2][2][4][2], int pm, int pn, int wr, int wc, int fr, int fq) const {
#pragma unroll
        for (int ai = 0; ai < 2; ++ai)
#pragma unroll
            for (int m = 0; m < 4; ++m) {
                const size_t row = (size_t)pm * BM + ai * HALF + wr * 64 + m * 16 + fr;
#pragma unroll
                for (int bj = 0; bj < 2; ++bj) {
                    const int hc = (pn * BM + bj * HALF + wc * 32) / 2 + 4 * fq;
                    const f32x4 g = acc[ai][bj][m][0], u = acc[ai][bj][m][1];
                    u32x2 w; w.x = pk2(silu_f(g[0]) * u[0], silu_f(g[1]) * u[1]); w.y = pk2(silu_f(g[2]) * u[2], silu_f(g[3]) * u[3]);
                    *(u32x2*)(H + row * DFF + hc) = w;
                }
            }
    }
};
struct EpiResid {
    const float *srcL, *srcC; float *dstL, *dstC; const float* gate  ; float coef;
    DI void operator()(const f32x4 (&acc)[2][2][4][2], int pm, int pn, int wr, int wc, int fr, int fq) const {
        const int row0 = pm * BM;
        const bool lat = row0 < TL;
        const float* src = lat ? srcL : srcC - (size_t)TL * DM;
        float* dst = lat ? dstL : dstC - (size_t)TL * DM;
        const int v = lat ? row0 / SEQ : 4;
        const int col0 = pn * BM + wc * 32 + 4 * fq;
        const float* gv = gate + (size_t)v * MODW + col0;
        f32x4 gt[2][2];
#pragma unroll
        for (int bj = 0; bj < 2; ++bj)
#pragma unroll
            for (int n = 0; n < 2; ++n) gt[bj][n] = *(const f32x4*)(gv + bj * HALF + n * 16) * coef;
#pragma unroll
        for (int ai = 0; ai < 2; ++ai)
#pragma unroll
            for (int m = 0; m < 4; ++m) {
                const size_t off = (size_t)(row0 + ai * HALF + wr * 64 + m * 16 + fr) * DM + col0;
                const float* sp = src + off; float* dp = dst + off;
                f32x4 s[2][2];
#pragma unroll
                for (int bj = 0; bj < 2; ++bj)
#pragma unroll
                    for (int n = 0; n < 2; ++n) s[bj][n] = *(const f32x4*)(sp + bj * HALF + n * 16);
#pragma unroll
                for (int bj = 0; bj < 2; ++bj)
#pragma unroll
                    for (int n = 0; n < 2; ++n) *(f32x4*)(dp + bj * HALF + n * 16) = s[bj][n] + gt[bj][n] * acc[ai][bj][m][n];
                asm volatile("" ::: "memory");
            }
    }
};
struct EpiPartial {
    float* part; const float* gate; float coef;
    DI void operator()(const f32x4 (&acc)[2][2][4][2], int pm, int pn, int wr, int wc, int fr, int fq) const {
        const int col0 = pn * BM + wc * 32 + 4 * fq;
        f32x4 gt[2][2];
#pragma unroll
        for (int bj = 0; bj < 2; ++bj)
#pragma unroll
            for (int n = 0; n < 2; ++n) gt[bj][n] = *(const f32x4*)(gate + col0 + bj * HALF + n * 16) * coef;
#pragma unroll
        for (int ai = 0; ai < 2; ++ai)
#pragma unroll
            for (int m = 0; m < 4; ++m) {
                float* dp = part + (size_t)(pm * BM + ai * HALF + wr * 64 + m * 16 + fr) * DM + col0;
#pragma unroll
                for (int bj = 0; bj < 2; ++bj)
#pragma unroll
                    for (int n = 0; n < 2; ++n) *(f32x4*)(dp + bj * HALF + n * 16) = gt[bj][n] * acc[ai][bj][m][n];
                asm volatile("" ::: "memory");
            }
    }
};
struct EpiStoreBf16 {
    bf16_t* Z; int ldz;
    DI void operator()(const f32x4 (&acc)[2][2][4][2], int pm, int pn, int wr, int wc, int fr, int fq) const {
#pragma unroll
        for (int ai = 0; ai < 2; ++ai)
#pragma unroll
            for (int m = 0; m < 4; ++m) {
                const size_t row = (size_t)pm * BM + ai * HALF + wr * 64 + m * 16 + fr;
#pragma unroll
                for (int bj = 0; bj < 2; ++bj)
#pragma unroll
                    for (int n = 0; n < 2; ++n) {
                        const int col = pn * BM + bj * HALF + wc * 32 + n * 16 + 4 * fq;
                        const f32x4 a = acc[ai][bj][m][n];
                        u32x2 w; w.x = pk2(a[0], a[1]); w.y = pk2(a[2], a[3]);
                        *(u32x2*)(Z + row * ldz + col) = w;
                    }
            }
    }
};
struct EpiGlu {
    const bf16_t* G; const float* bias; bf16_t* MIX;
    DI void operator()(const f32x4 (&acc)[2][2][4][2], int pm, int pn, int wr, int wc, int fr, int fq) const {
        const int col0 = pn * BM + wc * 32 + 4 * fq;
        f32x4 bv[2][2];
#pragma unroll
        for (int bj = 0; bj < 2; ++bj)
#pragma unroll
            for (int n = 0; n < 2; ++n) bv[bj][n] = *(const f32x4*)(bias + col0 + bj * HALF + n * 16);
#pragma unroll
        for (int ai = 0; ai < 2; ++ai)
#pragma unroll
            for (int m = 0; m < 4; ++m) {
                const size_t row = (size_t)pm * BM + ai * HALF + wr * 64 + m * 16 + fr;
                const bf16_t* gp = G + row * 512 + col0; bf16_t* mp = MIX + row * DM + col0;
#pragma unroll
                for (int bj = 0; bj < 2; ++bj)
#pragma unroll
                    for (int n = 0; n < 2; ++n) {
                        const u32x2 gw = *(const u32x2*)(gp + bj * HALF + n * 16);
                        const f32x4 a = acc[ai][bj][m][n] + bv[bj][n];
                        u32x2 w; w.x = pk2(bflo(gw.x) * sigmoid_f(a[0]), bfhi(gw.x) * sigmoid_f(a[1])); w.y = pk2(bflo(gw.y) * sigmoid_f(a[2]), bfhi(gw.y) * sigmoid_f(a[3]));
                        *(u32x2*)(mp + bj * HALF + n * 16) = w;
                    }
                asm volatile("" ::: "memory");
            }
    }
};

DI void transpose_item(const float* __restrict__ W, int K, int N, bf16_t* __restrict__ WT, int mode, float* scr, int item, int lane) {
    const int nblk = N / 32, kb = item / nblk, nb = item % nblk, k0 = 64 * kb, n0 = 32 * nb;
#pragma unroll 8
    for (int i = 0; i < 32; ++i) { const int kk = 2 * i + (lane >> 5); scr[kk * 33 + (lane & 31)] = __builtin_nontemporal_load(W + (size_t)(k0 + kk) * N + n0 + (lane & 31)); }
    LDS_FENCE();
    const int c = lane & 7;
#pragma unroll
    for (int j = 0; j < 4; ++j) {
        const int n = (lane >> 3) + 8 * j; const float* s = scr + (8 * c) * 33 + n;
        u32x4 o; o.x = pk2(s[0 * 33], s[1 * 33]); o.y = pk2(s[2 * 33], s[3 * 33]); o.z = pk2(s[4 * 33], s[5 * 33]); o.w = pk2(s[6 * 33], s[7 * 33]);
        const int nn = n0 + n;
        int row = nn;
        if (mode == 1) { const int jj = nn < DFF ? nn : nn - DFF; row = (jj >> 4) * 32 + (jj & 15) + (nn < DFF ? 0 : 16); }
        *(u32x4*)(WT + (size_t)row * K + k0 + 8 * c) = o;
    }
    LDS_FENCE();
}

DI void prologue_phase(const int TID, const Params& p) {
    extern __shared__ __attribute__((aligned(16))) float shf[];
    const int tid = TID, lane = tid & 63, wave = tid >> 6;
    unsigned char* ws = p.ws;
    {
        float* scr = shf + wave * (64 * 33);
        const int gw = blockIdx.x * 8 + wave, ngw = gridDim.x * 8;
        constexpr int I13 = (DM / 64) * (2 * DFF / 32), I2 = (DFF / 64) * (DM / 32);
        constexpr int IEI = (DM / 64) * (EVEN_IN / 32), IEO = (DM / 64) * (DM / 32), IGL = (512 / 64) * (512 / 32), IOI = (DM / 64) * (ODD_IN / 32), IOO = IEO;
        constexpr int NIT = 4 * (I13 + I2) + IEI + IEO + IGL + IOI + IOO;
        for (int it = gw; it < NIT; it += ngw) {
            int r = it;
            if (r < 4 * (I13 + I2)) {
                const int lf = r / (I13 + I2); r -= lf * (I13 + I2);
                const int l = lf >> 1, f = lf & 1;
                bf16_t* base = (bf16_t*)(ws + OFF_W + (size_t)lf * SZ_FFN);
                if (r < I13) transpose_item((f ? p.ffn2_w13 : p.ffn1_w13) + (size_t)l * DM * 2 * DFF, DM, 2 * DFF, base, 1, scr, r, lane);
                else transpose_item((f ? p.ffn2_w2 : p.ffn1_w2) + (size_t)l * DFF * DM, DFF, DM, (bf16_t*)((unsigned char*)base + SZ_W13), 0, scr, r - I13, lane);
                continue;
            }
            r -= 4 * (I13 + I2);
            if (r < IEI) { transpose_item(p.ev_w_in, DM, EVEN_IN, (bf16_t*)(ws + OFF_EVIN), 0, scr, r, lane); continue; } r -= IEI;
            if (r < IEO) { transpose_item(p.ev_w_out, DM, DM, (bf16_t*)(ws + OFF_EVOUT), 0, scr, r, lane); continue; } r -= IEO;
            if (r < IGL) { transpose_item(p.s5_glu_w, 512, 512, (bf16_t*)(ws + OFF_GLUW), 0, scr, r, lane); continue; } r -= IGL;
            if (r < IOI) { transpose_item(p.od_w_in, DM, ODD_IN, (bf16_t*)(ws + OFF_ODIN), 0, scr, r, lane); continue; } r -= IOI;
            transpose_item(p.od_w_out, DM, DM, (bf16_t*)(ws + OFF_ODOUT), 0, scr, r, lane);
        }
    }
    __syncthreads();
    {
        float* red = shf;
        float* sl = shf + 8 * 5 * 64;
        for (int idx = tid; idx < 5 * DM; idx += 512) { const int v = idx >> 10, k = idx & (DM - 1); sl[idx] = silu_f(v < 4 ? p.c[v * DM + k] : p.c_ctx[k]); }
        __syncthreads();
        float* MOD = (float*)(ws + OFF_MOD);
        for (int item = blockIdx.x; item < 2 * (MODW / 64); item += gridDim.x) {
            const int i = item / (MODW / 64), col = (item % (MODW / 64)) * 64 + lane;
            const float* W = p.mod_w + (size_t)i * DM * MODW + col;
            float a0 = 0.f, a1 = 0.f, a2 = 0.f, a3 = 0.f, a4 = 0.f;
            for (int k = wave * 128; k < wave * 128 + 128; ++k) {
                const float w = __builtin_nontemporal_load(W + (size_t)k * MODW);
                a0 += sl[k] * w; a1 += sl[DM + k] * w; a2 += sl[2 * DM + k] * w; a3 += sl[3 * DM + k] * w; a4 += sl[4 * DM + k] * w;
            }
            __syncthreads();
            red[(wave * 5 + 0) * 64 + lane] = a0; red[(wave * 5 + 1) * 64 + lane] = a1; red[(wave * 5 + 2) * 64 + lane] = a2; red[(wave * 5 + 3) * 64 + lane] = a3; red[(wave * 5 + 4) * 64 + lane] = a4;
            __syncthreads();
            if (tid < 320) {
                const int v = tid >> 6; float s = 0.f;
#pragma unroll
                for (int w8 = 0; w8 < 8; ++w8) s += red[(w8 * 5 + v) * 64 + lane];
                MOD[((size_t)i * 5 + v) * MODW + col] = s + p.mod_b[(size_t)i * MODW + col];
            }
        }
    }
    {
        f32x4* dstc = (f32x4*)(ws + OFF_CTXX); const f32x4* srcc = (const f32x4*)p.ctx;
        for (int idx = blockIdx.x * 512 + tid; idx < TC * DM / 4; idx += gridDim.x * 512) dstc[idx] = srcc[idx];
    }
    {
        f32x2* ROPE = (f32x2*)(ws + OFF_ROPE);
        for (int idx = blockIdx.x * 512 + tid; idx < SEQ * 32; idx += gridDim.x * 512) {
            const int pos = idx >> 5, i = idx & 31;
            const float inv = powf(10000.0f, -(float)(i & 15) / 16.0f);
            const float ang = (float)(i < 16 ? pos / 64 : pos % 64) * inv;
            float sn, cs; sincosf(ang, &sn, &cs);
            ROPE[idx] = (f32x2){cs, sn};
        }
    }
    {
        f32x2* SA_ = (f32x2*)(ws + OFF_S5A); bf16_t* SB_ = (bf16_t*)(ws + OFF_S5B); bf16_t* SC_ = (bf16_t*)(ws + OFF_S5C);
        for (int idx = blockIdx.x * 512 + tid; idx < 2 * 32 * 64; idx += gridDim.x * 512) {
            const int dg = idx >> 6, pp = idx & 63;
            const float lr = p.s5_lam_re[idx], li = p.s5_lam_im[idx], dt = expf(p.s5_log_dt[dg]);
            const float mag = expf(lr * dt); float sn, cs; sincosf(li * dt, &sn, &cs);
            const float ar = mag * cs, ai = mag * sn, den = lr * lr + li * li;
            const float fr = ((ar - 1.f) * lr + ai * li) / den, fi = (ai * lr - (ar - 1.f) * li) / den;
            SA_[idx] = (f32x2){ar, ai};
#pragma unroll
            for (int hh = 0; hh < 16; ++hh) {
                const float br = p.s5_b_re[(size_t)idx * 16 + hh], bi = p.s5_b_im[(size_t)idx * 16 + hh];
                const float vr = fr * br - fi * bi, vi = fr * bi + fi * br;
                const bf16_t rh = f2bf(vr), ih = f2bf(vi);
                SB_[((size_t)(dg * 4 + 0) * 64 + pp) * 16 + hh] = rh; SB_[((size_t)(dg * 4 + 1) * 64 + pp) * 16 + hh] = f2bf(vr - bf2f(rh));
                SB_[((size_t)(dg * 4 + 2) * 64 + pp) * 16 + hh] = ih; SB_[((size_t)(dg * 4 + 3) * 64 + pp) * 16 + hh] = f2bf(vi - bf2f(ih));
            }
        }
        for (int idx = blockIdx.x * 512 + tid; idx < 2 * 32 * 16 * 128; idx += gridDim.x * 512) {
            const int k = idx & 127, hh = (idx >> 7) & 15, dg = idx >> 11;
            const float v = (k & 1) ? -p.s5_c_im[((size_t)dg * 16 + hh) * 64 + (k >> 1)] : p.s5_c_re[((size_t)dg * 16 + hh) * 64 + (k >> 1)];
            const bf16_t vh = f2bf(v);
            SC_[((size_t)(dg * 2 + 0) * 16 + hh) * 128 + k] = vh; SC_[((size_t)(dg * 2 + 1) * 16 + hh) * 128 + k] = f2bf(v - bf2f(vh));
        }
    }
}

DI void normmod_phase(const int TID, const float* __restrict__ xl, float* __restrict__ xc, const float* __restrict__ g, const float* __restrict__ modl, int i_shift, int i_scale,
                      bf16_t* __restrict__ XN, int nrows, const float* __restrict__ part, int nslice) {
    const int lane = TID & 63, wave = TID >> 6;
    for (int row = blockIdx.x * 8 + wave; row < nrows; row += gridDim.x * 8) {
        const float* xr = row < TL ? xl + (size_t)row * DM : xc + (size_t)(row - TL) * DM;
        const int v = row < TL ? row / SEQ : 4;
        const float* sh = modl + (size_t)v * MODW + i_shift * DM; const float* sc = modl + (size_t)v * MODW + i_scale * DM;
        f32x4 x[4]; float ss = 0.f;
#pragma unroll
        for (int j = 0; j < 4; ++j) x[j] = __builtin_nontemporal_load((const f32x4*)(xr + 256 * j + 4 * lane));
        if (row >= TL && nslice > 0) {
            for (int sl = 0; sl < nslice; ++sl)
#pragma unroll
                for (int j = 0; j < 4; ++j) x[j] += *(const f32x4*)(part + ((size_t)sl * TC + (row - TL)) * DM + 256 * j + 4 * lane);
#pragma unroll
            for (int j = 0; j < 4; ++j) *(f32x4*)(xc + (size_t)(row - TL) * DM + 256 * j + 4 * lane) = x[j];
        }
#pragma unroll
        for (int j = 0; j < 4; ++j) ss += x[j][0] * x[j][0] + x[j][1] * x[j][1] + x[j][2] * x[j][2] + x[j][3] * x[j][3];
        const float rstd = rsqrtf(wave_sum(ss) * (1.f / DM) + EPSN);
#pragma unroll
        for (int j = 0; j < 4; ++j) {
            const int col = 256 * j + 4 * lane;
            const f32x4 gg = *(const f32x4*)(g + col), s1 = *(const f32x4*)(sc + col), s0 = *(const f32x4*)(sh + col);
            const f32x4 y = (x[j] * rstd * gg) * (s1 + 1.0f) + s0;
            u32x2 w; w.x = pk2(y[0], y[1]); w.y = pk2(y[2], y[3]);
            *(u32x2*)(XN + (size_t)row * DM + col) = w;
        }
    }
}

DI void qkv_post_phase(const int TID, const Params& p, const bf16_t* __restrict__ Z, int ldz, int qcol, int nq, int kcol, int nk, int vcol, int nvh, int dv,
                       const float* __restrict__ gq, const float* __restrict__ gk) {
    extern __shared__ __attribute__((aligned(16))) unsigned char shb[];
    const int tid = TID, lane = tid & 63, wave = tid >> 6;
    bf16_t* Qh = (bf16_t*)(p.ws + OFF_Q); bf16_t* Kh = (bf16_t*)(p.ws + OFF_K); bf16_t* Vt = (bf16_t*)(p.ws + OFF_V);
    const f32x2* ROPE = (const f32x2*)(p.ws + OFF_ROPE);
    {
        const int hsub = lane >> 4, j = lane & 15, ngrp = (nk + 3) >> 2;
        const f32x4 gq4 = *(const f32x4*)(gq + 4 * j) * (0.125f * LOG2E), gk4 = *(const f32x4*)(gk + 4 * j);
        for (int item = blockIdx.x * 8 + wave; item < TT * ngrp; item += gridDim.x * 8) {
            const int row = item / ngrp, hh = nq + (item % ngrp) * 4 + hsub;
            const bool lat = row < TL, valid = hh < nq + nk, isq = hh < nq;
            const int b = lat ? row / SEQ : (row - TL) / CTXL;
            const int key = lat ? row % SEQ : SEQ + (row - TL) % CTXL;
            const int hd = isq ? hh : hh - nq;
            f32x4 x = {0.f, 0.f, 0.f, 0.f};
            if (valid) { const u32x2 w = __builtin_nontemporal_load((const u32x2*)(Z + (size_t)row * ldz + (isq ? qcol : kcol) + hd * 64 + 4 * j)); x = (f32x4){bflo(w.x), bfhi(w.x), bflo(w.y), bfhi(w.y)}; }
            float ss = x[0] * x[0] + x[1] * x[1] + x[2] * x[2] + x[3] * x[3];
            ss += __shfl_xor(ss, 1); ss += __shfl_xor(ss, 2); ss += __shfl_xor(ss, 4); ss += __shfl_xor(ss, 8);
            const float rstd = rsqrtf(ss * (1.f / 64.f) + EPSN);
            f32x4 y = x * rstd * (isq ? gq4 : gk4);
            f32x4 o; o[0] = __shfl_xor(y[0], 8); o[1] = __shfl_xor(y[1], 8); o[2] = __shfl_xor(y[2], 8); o[3] = __shfl_xor(y[3], 8);
            if (lat) {
                const f32x2* cs = ROPE + key * 32 + 4 * (j & 7);
#pragma unroll
                for (int e = 0; e < 4; ++e) { const f32x2 c = cs[e]; y[e] = j < 8 ? y[e] * c[0] - o[e] * c[1] : o[e] * c[1] + y[e] * c[0]; }
            }
            if (valid) {
                bf16_t* dst = (isq ? Qh + ((size_t)(b * nq + hd) * KEYS + key) * 64 : Kh + ((size_t)(b * nk + hd) * KEYS + key) * 64);
                u32x2 w; w.x = pk2(y[0], y[1]); w.y = pk2(y[2], y[3]);
                *(u32x2*)(dst + 4 * j) = w;
            }
        }
    }
    const int vc = nvh * dv, pitch = vc * 2 + 16;
    for (int item = blockIdx.x; item < TT / 64; item += gridDim.x) {
        const int row0 = item * 64;
        const bool lat = row0 < TL;
        const int b = lat ? row0 / SEQ : (row0 - TL) / CTXL;
        const int key0 = lat ? row0 % SEQ : SEQ + (row0 - TL) % CTXL;
        __syncthreads();
        for (int c = tid; c < 64 * (vc / 8); c += 512) {
            const int r = c / (vc / 8), cc = c % (vc / 8);
            *(u32x4*)(shb + r * pitch + cc * 16) = __builtin_nontemporal_load((const u32x4*)(Z + (size_t)(row0 + r) * ldz + vcol + cc * 8));
        }
        __syncthreads();
        for (int idx = tid; idx < vc * 8; idx += 512) {
            const int tch = idx & 7, col = idx >> 3;
            unsigned short e[8];
#pragma unroll
            for (int k = 0; k < 8; ++k) e[k] = *(const unsigned short*)(shb + (8 * tch + k) * pitch + col * 2);
            u32x4 o; o.x = e[0] | ((unsigned)e[1] << 16); o.y = e[2] | ((unsigned)e[3] << 16); o.z = e[4] | ((unsigned)e[5] << 16); o.w = e[6] | ((unsigned)e[7] << 16);
            const int hd = col / dv, d = col % dv;
            *(u32x4*)(Vt + ((size_t)(b * nvh + hd) * dv + d) * KEYS + key0 + 8 * tch) = o;
        }
    }
}

#define MFMA32(a, b, c) __builtin_amdgcn_mfma_f32_32x32x16_bf16((a), (b), (c), 0, 0, 0)
constexpr int KP = 144, VP = 136;
constexpr int KT_BYTES = 64 * KP;

template <int NDT>
DI void attn_tile(const unsigned char* Kt, const unsigned char* Vtile, const bf16x8 (&qf)[4], f32x16 (&o)[NDT], float& l, float c1, float c2, int r, int h,
                  bool domask, int qk0  ) {
#pragma unroll
    for (int sub = 0; sub < 2; ++sub) {
        f32x16 st;
#pragma unroll
        for (int i = 0; i < 16; ++i) st[i] = -c2;
#pragma unroll
        for (int s = 0; s < 4; ++s) {
            const bf16x8 kf = *(const bf16x8*)(Kt + (32 * sub + r) * KP + (16 * s + 8 * h) * 2);
            st = MFMA32(kf, qf[s], st);
        }
        float pv[16];
#pragma unroll
        for (int i = 0; i < 16; ++i) {
            float e = __builtin_amdgcn_exp2f(st[i]);
            if (domask) { const int dd = qk0 - (32 * sub + (i & 3) + 8 * (i >> 2) + 4 * h); if (dd > 128 || dd < -128) e = 0.f; }
            pv[i] = e; l += e;
        }
        u32x4 w0, w1;
        w0.x = pk2(pv[0], pv[1]); w0.y = pk2(pv[2], pv[3]); w0.z = pk2(pv[4], pv[5]); w0.w = pk2(pv[6], pv[7]);
        w1.x = pk2(pv[8], pv[9]); w1.y = pk2(pv[10], pv[11]); w1.z = pk2(pv[12], pv[13]); w1.w = pk2(pv[14], pv[15]);
        const bf16x8 pf0 = __builtin_bit_cast(bf16x8, w0), pf1 = __builtin_bit_cast(bf16x8, w1);
#pragma unroll
        for (int dt = 0; dt < NDT; ++dt) {
#pragma unroll
            for (int s2 = 0; s2 < 2; ++s2) {
                const unsigned char* vp = Vtile + (32 * dt + r) * VP + (32 * sub + 16 * s2 + 4 * h) * 2;
                const s16x4 lo = *(const s16x4*)vp, hi = *(const s16x4*)(vp + 16);
                const bf16x8 vf = __builtin_shufflevector(lo, hi, 0, 1, 2, 3, 4, 5, 6, 7);
                o[dt] = MFMA32(vf, s2 ? pf1 : pf0, o[dt]);
            }
        }
    }
}

DI void load_q_frags(const bf16_t* __restrict__ zq, const float* __restrict__ gq, const f32x2* __restrict__ rope, int h, bf16x8 (&qf)[4]) {
    float x[4][8]; float ss = 0.f;
#pragma unroll
    for (int s = 0; s < 4; ++s) {
        const u32x4 w = *(const u32x4*)(zq + 16 * s + 8 * h);
        x[s][0] = bflo(w.x); x[s][1] = bfhi(w.x); x[s][2] = bflo(w.y); x[s][3] = bfhi(w.y); x[s][4] = bflo(w.z); x[s][5] = bfhi(w.z); x[s][6] = bflo(w.w); x[s][7] = bfhi(w.w);
#pragma unroll
        for (int j = 0; j < 8; ++j) ss += x[s][j] * x[s][j];
    }
    ss += __shfl_xor(ss, 32);
    const float rstd = rsqrtf(ss * (1.f / 64.f) + EPSN);
#pragma unroll
    for (int s = 0; s < 4; ++s)
#pragma unroll
        for (int j = 0; j < 8; ++j) x[s][j] = x[s][j] * rstd * (gq[16 * s + 8 * h + j] * (0.125f * LOG2E));
    if (rope) {
#pragma unroll
        for (int s = 0; s < 2; ++s)
#pragma unroll
            for (int j = 0; j < 8; ++j) {
                const f32x2 c = rope[16 * s + 8 * h + j];
                const float a = x[s][j], bq = x[s + 2][j];
                x[s][j] = a * c[0] - bq * c[1]; x[s + 2][j] = a * c[1] + bq * c[0];
            }
    }
#pragma unroll
    for (int s = 0; s < 4; ++s) {
        u32x4 w; w.x = pk2(x[s][0], x[s][1]); w.y = pk2(x[s][2], x[s][3]); w.z = pk2(x[s][4], x[s][5]); w.w = pk2(x[s][6], x[s][7]);
        qf[s] = __builtin_bit_cast(bf16x8, w);
    }
}

DI void diff_attn_phase(const int TID, const Params& p, const bf16_t* __restrict__ Z, bf16_t* __restrict__ MIX, float lam_init) {
    extern __shared__ __attribute__((aligned(16))) unsigned char smb[];
    const int tid = TID, lane = tid & 63, wave = tid >> 6, r = lane & 31, h = lane >> 5, rg = wave & 3, m = wave >> 2;
    const bf16_t* Qh = (const bf16_t*)(p.ws + OFF_Q); const bf16_t* Kh = (const bf16_t*)(p.ws + OFF_K); const bf16_t* Vt = (const bf16_t*)(p.ws + OFF_V);
    const float gqm = wave_max(fabsf(p.diff_qk_g[lane])), gkm = wave_max(fabsf(p.diff_qk_g[64 + lane]));
    const float c1 = 0.125f * LOG2E, c2 = 8.f * gqm * gkm * LOG2E;
    const float lam = expf(wave_sum(p.diff_lam[lane] * p.diff_lam[64 + lane])) - expf(wave_sum(p.diff_lam[128 + lane] * p.diff_lam[192 + lane])) + lam_init;
    constexpr int BUFSZ = 2 * KT_BYTES + 128 * VP;
    for (int unit = blockIdx.x; unit < NB * 4 * (SEQ / 128); unit += gridDim.x) {
        const int b = unit >> 8, rem = unit & 255, qb = rem >> 2, hd = rem & 3;
        bf16x8 qf[4];
        { const int qpos_ = qb * 128 + rg * 32 + r;
          load_q_frags(Z + (size_t)(b * SEQ + qpos_) * ODD_IN + 1024 + (2 * hd + m) * 64, p.diff_qk_g, (const f32x2*)(p.ws + OFF_ROPE) + qpos_ * 32, h, qf); }
        const bf16_t* K0g = Kh + (size_t)(b * 8 + 2 * hd) * KEYS * 64;
        const bf16_t* Vg = Vt + (size_t)(b * 4 + hd) * 128 * KEYS;
        f32x16 o[4];
#pragma unroll
        for (int dt = 0; dt < 4; ++dt)
#pragma unroll
            for (int i = 0; i < 16; ++i) o[dt][i] = 0.f;
        float l = 0.f;
        u32x4 pre[4];
        const int kkey = (tid & 511) >> 3, kch = tid & 7;
#define DIFF_LOAD(t) do { const int key0_ = (t) * 64; \
            pre[0] = *(const u32x4*)(K0g + (size_t)(key0_ + kkey) * 64 + kch * 8); \
            pre[1] = *(const u32x4*)(K0g + (size_t)KEYS * 64 + (size_t)(key0_ + kkey) * 64 + kch * 8); \
            pre[2] = *(const u32x4*)(Vg + (size_t)(tid >> 3) * KEYS + key0_ + kch * 8); \
            pre[3] = *(const u32x4*)(Vg + (size_t)((tid >> 3) + 64) * KEYS + key0_ + kch * 8); } while (0)
        DIFF_LOAD(0);
        for (int t = 0; t < KEYS / 64; ++t) {
            unsigned char* buf = smb + (t & 1) * BUFSZ;
            *(u32x4*)(buf + kkey * KP + kch * 16) = pre[0];
            *(u32x4*)(buf + KT_BYTES + kkey * KP + kch * 16) = pre[1];
            { unsigned char* vq = buf + 2 * KT_BYTES + (tid >> 3) * VP + kch * 16;
              *(u32x2*)vq = (u32x2){pre[2].x, pre[2].y}; *(u32x2*)(vq + 8) = (u32x2){pre[2].z, pre[2].w};
              vq += 64 * VP;
              *(u32x2*)vq = (u32x2){pre[3].x, pre[3].y}; *(u32x2*)(vq + 8) = (u32x2){pre[3].z, pre[3].w}; }
            __syncthreads();
            if (t + 1 < KEYS / 64) DIFF_LOAD(t + 1);
            attn_tile<4>(buf + m * KT_BYTES, buf + 2 * KT_BYTES, qf, o, l, c1, c2, r, h, false, 0);
        }
#undef DIFF_LOAD
        l += __shfl_xor(l, 32);
        __syncthreads();
        float* X = (float*)smb;
        if (m == 1) {
            const float inv = lam / l;
#pragma unroll
            for (int dt = 0; dt < 4; ++dt)
#pragma unroll
                for (int i = 0; i < 16; ++i) X[(rg * 64 + lane) * 65 + dt * 16 + i] = o[dt][i] * inv;
        }
        __syncthreads();
        if (m == 0) {
            const float inv = 1.f / l; float ss = 0.f;
#pragma unroll
            for (int dt = 0; dt < 4; ++dt)
#pragma unroll
                for (int i = 0; i < 16; ++i) { const float v = o[dt][i] * inv - X[(rg * 64 + lane) * 65 + dt * 16 + i]; o[dt][i] = v; ss += v * v; }
            ss += __shfl_xor(ss, 32);
            const float rstd = rsqrtf(ss * (1.f / 128.f) + EPSN) * (1.f - lam_init);
            bf16_t* orow = MIX + (size_t)(b * SEQ + qb * 128 + rg * 32 + r) * DM + 512 + hd * 128;
#pragma unroll
            for (int dt = 0; dt < 4; ++dt)
#pragma unroll
                for (int g4 = 0; g4 < 4; ++g4) {
                    const int d = 32 * dt + 8 * g4 + 4 * h;
                    const f32x4 sg = *(const f32x4*)(p.diff_sub_g + d);
                    u32x2 w; w.x = pk2(o[dt][4 * g4] * rstd * sg[0], o[dt][4 * g4 + 1] * rstd * sg[1]); w.y = pk2(o[dt][4 * g4 + 2] * rstd * sg[2], o[dt][4 * g4 + 3] * rstd * sg[3]);
                    *(u32x2*)(orow + d) = w;
                }
        }
        __syncthreads();
    }
}

DI void swa_attn_phase(const int TID, const Params& p, const bf16_t* __restrict__ Z, bf16_t* __restrict__ MIX) {
    extern __shared__ __attribute__((aligned(16))) unsigned char smb[];
    const int tid = TID, lane = tid & 63, wave = tid >> 6, r = lane & 31, h = lane >> 5, rg = wave & 3, hh = wave >> 2;
    const bf16_t* Qh = (const bf16_t*)(p.ws + OFF_Q); const bf16_t* Kh = (const bf16_t*)(p.ws + OFF_K); const bf16_t* Vt = (const bf16_t*)(p.ws + OFF_V);
    const float gqm = wave_max(fabsf(p.swa_qk_g[lane])), gkm = wave_max(fabsf(p.swa_qk_g[64 + lane]));
    const float mb = 8.f * gqm * gkm, c1 = 0.125f * LOG2E, c2 = mb * LOG2E;
    constexpr int BUFSZ = KT_BYTES + 64 * VP;
    constexpr int NLAT = NB * (SEQ / 128) * 4, NCTX = NB * (CTXL / 128) * 4;
    for (int unit = blockIdx.x; unit < NLAT + NCTX; unit += gridDim.x) {
        const bool cq = unit >= NLAT;
        int b, qb, kv, pr;
        if (!cq) { b = unit >> 8; const int rem = unit & 255; qb = rem >> 2; kv = (rem >> 1) & 1; pr = rem & 1; }
        else { const int u2 = unit - NLAT; b = u2 >> 3; const int rem = u2 & 7; qb = rem >> 2; kv = (rem >> 1) & 1; pr = rem & 1; }
        const int head = 4 * kv + 2 * pr + hh;
        const int qpos = qb * 128 + rg * 32 + r;
        bf16x8 qf[4];
        load_q_frags(Z + (size_t)(cq ? TL + b * CTXL + qpos : b * SEQ + qpos) * EVEN_IN + 512 + head * 64, p.swa_qk_g, cq ? (const f32x2*)nullptr : (const f32x2*)(p.ws + OFF_ROPE) + qpos * 32, h, qf);
        const bf16_t* Kg = Kh + (size_t)(b * 2 + kv) * KEYS * 64;
        const bf16_t* Vg = Vt + (size_t)(b * 2 + kv) * 64 * KEYS;
        const int tlo = cq ? 0 : max(0, 2 * qb - 2), thi = cq ? -1 : min(SEQ / 64 - 1, 2 * qb + 3), nloc = thi - tlo + 1, ntile = nloc + CTXL / 64;
        f32x16 o[2];
#pragma unroll
        for (int dt = 0; dt < 2; ++dt)
#pragma unroll
            for (int i = 0; i < 16; ++i) o[dt][i] = 0.f;
        float l = 0.f;
        u32x4 pre[2];
        const int kkey = tid >> 3, kch = tid & 7;
#define SWA_TI(i) ((i) < nloc ? tlo + (i) : SEQ / 64 + ((i) - nloc))
#define SWA_LOAD(i) do { const int key0_ = SWA_TI(i) * 64; \
            pre[0] = *(const u32x4*)(Kg + (size_t)(key0_ + kkey) * 64 + kch * 8); \
            pre[1] = *(const u32x4*)(Vg + (size_t)kkey * KEYS + key0_ + kch * 8); } while (0)
        SWA_LOAD(0);
        for (int t = 0; t < ntile; ++t) {
            unsigned char* buf = smb + (t & 1) * BUFSZ;
            *(u32x4*)(buf + kkey * KP + kch * 16) = pre[0];
            { unsigned char* vq = buf + KT_BYTES + kkey * VP + kch * 16;
              *(u32x2*)vq = (u32x2){pre[1].x, pre[1].y}; *(u32x2*)(vq + 8) = (u32x2){pre[1].z, pre[1].w}; }
            __syncthreads();
            if (t + 1 < ntile) SWA_LOAD(t + 1);
            const int key0t = SWA_TI(t) * 64, qlo = qb * 128 + rg * 32;
            if (!(t < nloc && (key0t > qlo + 31 + 128 || key0t + 63 < qlo - 128)))
                attn_tile<2>(buf, buf + KT_BYTES, qf, o, l, c1, c2, r, h, t < nloc, qpos - key0t);
        }
#undef SWA_LOAD
#undef SWA_TI
        l += __shfl_xor(l, 32);
        l += __builtin_amdgcn_exp2f((p.swa_sink[head] - mb) * LOG2E);
        const float inv = 1.f / l;
        bf16_t* orow = MIX + (size_t)(cq ? TL + b * CTXL + qpos : b * SEQ + qpos) * DM + 512 + head * 64;
#pragma unroll
        for (int dt = 0; dt < 2; ++dt)
#pragma unroll
            for (int g4 = 0; g4 < 4; ++g4) {
                const int d = 32 * dt + 8 * g4 + 4 * h;
                u32x2 w; w.x = pk2(o[dt][4 * g4] * inv, o[dt][4 * g4 + 1] * inv); w.y = pk2(o[dt][4 * g4 + 2] * inv, o[dt][4 * g4 + 3] * inv);
                *(u32x2*)(orow + d) = w;
            }
        __syncthreads();
    }
}

DI float fma_s(float a, float b, float c) { float r; asm volatile("v_fma_f32 %0, %1, %2, %3" : "=v"(r) : "v"(a), "v"(b), "v"(c)); return r; }
DI void cmad(float& xr, float& xi, float ar, float ai, float br, float bi) {
    const float nr = fma_s(-xi, ai, fma_s(xr, ar, br)), ni = fma_s(xi, ar, fma_s(xr, ai, bi));
    xr = nr; xi = ni;
}
template <bool FWD, int Q> DI void s5_quad(const f32x16& br, const f32x16& bi, float ar, float ai, float& Br, float& Bi) {
    constexpr int i0 = FWD ? 4 * Q : 4 * Q + 3, st = FWD ? 1 : -1;
    Br = br[i0]; Bi = bi[i0];
    cmad(Br, Bi, ar, ai, br[i0 + st], bi[i0 + st]); cmad(Br, Bi, ar, ai, br[i0 + 2 * st], bi[i0 + 2 * st]); cmad(Br, Bi, ar, ai, br[i0 + 3 * st], bi[i0 + 3 * st]);
}
DI void s5_bu(const bf16_t* __restrict__ SBq  , bf16x8 af, int pt, int r, int h, f32x16& bur, f32x16& bui) {
#pragma unroll
    for (int i = 0; i < 16; ++i) { bur[i] = 0.f; bui[i] = 0.f; }
    const bf16_t* bp = SBq + (size_t)(pt * 32 + r) * 16 + 8 * h;
    bur = MFMA32(af, *(const bf16x8*)(bp), bur); bur = MFMA32(af, *(const bf16x8*)(bp + 1024), bur);
    bui = MFMA32(af, *(const bf16x8*)(bp + 2048), bui); bui = MFMA32(af, *(const bf16x8*)(bp + 3072), bui);
    float one; asm volatile("v_mov_b32 %0, 1.0" : "=v"(one));
#pragma unroll
    for (int i = 0; i < 16; ++i) { bur[i] *= one; bui[i] *= one; }
}
DI f32x2* s5_cin(unsigned char* ws, int b, int dir, int g) { return (f32x2*)(ws + (dir ? OFF_V : OFF_K) + SZ_QKV / 4) + (size_t)(b * 32 + g) * 264 * 64; }
DI void s5_chunk(int item, int& b, int& g, int& ck, int& row0) {
    ck = item % 264; g = (item / 264) & 31; b = item / (264 * 32);
    row0 = ck < 8 ? TL + b * CTXL + ck * 32 : b * SEQ + (ck - 8) * 32;
}
DI void s5_passA(const int TID, const Params& p, const bf16_t* __restrict__ Z) {
    const int lane = TID & 63, wave = TID >> 6, r = lane & 31, h = lane >> 5;
    const f32x2* SAp = (const f32x2*)(p.ws + OFF_S5A); const bf16_t* SBp = (const bf16_t*)(p.ws + OFF_S5B); f32x2* ST = (f32x2*)(p.ws + OFF_ST);
    for (int item = blockIdx.x * 8 + wave; item < NB * 32 * 264; item += gridDim.x * 8) {
        int b, g, ck, row0; s5_chunk(item, b, g, ck, row0);
        const bf16x8 af = *(const bf16x8*)(Z + (size_t)(row0 + r) * EVEN_IN + g * 16 + 8 * h);
        static_for<0, 2>([&](auto dc) {
            constexpr int dir = decltype(dc)::value;
            static_for<0, 2>([&](auto pc) {
                constexpr int pt = decltype(pc)::value;
                f32x16 bur, bui;
                s5_bu(SBp + (size_t)(dir * 32 + g) * 4096, af, pt, r, h, bur, bui);
                const f32x2 A = SAp[(dir * 32 + g) * 64 + pt * 32 + r];
                float a2r = A[0] * A[0] - A[1] * A[1], a2i = 2.f * A[0] * A[1];
                const float a4r = a2r * a2r - a2i * a2i, a4i = 2.f * a2r * a2i, a8r = a4r * a4r - a4i * a4i, a8i = 2.f * a4r * a4i;
                float Er = 0.f, Ei = 0.f;
                static_for<0, 4>([&](auto kc) {
                    constexpr int q = dir ? 3 - decltype(kc)::value : decltype(kc)::value;
                    float Br, Bi; s5_quad<dir == 0, q>(bur, bui, A[0], A[1], Br, Bi);
                    const float Pr = __shfl_xor(Br, 32), Pi = __shfl_xor(Bi, 32);
                    const bool own_first = (dir == 0) ? (h == 0) : (h == 1);
                    float fr = own_first ? Br : Pr, fi = own_first ? Bi : Pi; const float sr = own_first ? Pr : Br, si = own_first ? Pi : Bi;
                    cmad(fr, fi, a4r, a4i, sr, si);
                    cmad(Er, Ei, a8r, a8i, fr, fi);
                });
                if (h == 0) ST[((size_t)((b * 2 + dir) * 32 + g) * 264 + ck) * 64 + pt * 32 + r] = (f32x2){Er, Ei};
            });
        });
    }
}
DI void s5_passB(const int TID, const Params& p) {
    const f32x2* SAp = (const f32x2*)(p.ws + OFF_S5A); f32x2* ST = (f32x2*)(p.ws + OFF_ST);
    for (int idx = blockIdx.x * 512 + TID; idx < NB * 2 * 32 * 64; idx += gridDim.x * 512) {
        const int pp = idx & 63, bdg = idx >> 6, dir = (bdg >> 5) & 1;
        const f32x2 A = SAp[(bdg & 63) * 64 + pp];
        float ar = A[0], ai = A[1];
#pragma unroll
        for (int q = 0; q < 5; ++q) { const float nr = ar * ar - ai * ai; ai = 2.f * ar * ai; ar = nr; }
        float sr = 0.f, si = 0.f;
        const f32x2* e0 = ST + (size_t)bdg * 264 * 64 + pp;
        f32x2* c0 = s5_cin(p.ws, bdg >> 6, dir, bdg & 31) + pp;
        for (int v0 = 0; v0 < 264; v0 += 12) {
            f32x2 E[12];
#pragma unroll
            for (int k = 0; k < 12; ++k) { const int v = v0 + k; const int ck = dir == 0 ? v : (v < 8 ? 7 - v : 263 - (v - 8)); E[k] = e0[(size_t)ck * 64]; }
#pragma unroll
            for (int k = 0; k < 12; ++k) {
                const int v = v0 + k; const int ck = dir == 0 ? v : (v < 8 ? 7 - v : 263 - (v - 8));
                c0[(size_t)ck * 64] = (f32x2){sr, si};
                cmad(sr, si, ar, ai, E[k][0], E[k][1]);
            }
        }
    }
}
constexpr int HSP = 272;
DI void s5_passC(const int TID, const Params& p, const bf16_t* __restrict__ Z, bf16_t* __restrict__ G) {
    extern __shared__ __attribute__((aligned(16))) unsigned char smb[];
    const int lane = TID & 63, wave = TID >> 6, r = lane & 31, h = lane >> 5, c16 = lane & 15, kg = lane >> 4;
    unsigned char* Hs = smb + wave * (32 * HSP);
    const f32x2* SAp = (const f32x2*)(p.ws + OFF_S5A); const bf16_t* SBp = (const bf16_t*)(p.ws + OFF_S5B); const bf16_t* SCp = (const bf16_t*)(p.ws + OFF_S5C);
    const f32x2* ST = (const f32x2*)(p.ws + OFF_ST);
    for (int item = blockIdx.x * 8 + wave; item < NB * 32 * 264; item += gridDim.x * 8) {
        int b, g, ck, row0; s5_chunk(item, b, g, ck, row0);
        const bf16x8 af = *(const bf16x8*)(Z + (size_t)(row0 + r) * EVEN_IN + g * 16 + 8 * h);
        f32x4 yacc[2] = {{0.f, 0.f, 0.f, 0.f}, {0.f, 0.f, 0.f, 0.f}};
        static_for<0, 2>([&](auto dc) {
            constexpr int dir = decltype(dc)::value;
            static_for<0, 2>([&](auto pc) {
                constexpr int pt = decltype(pc)::value;
                f32x16 bur, bui;
                s5_bu(SBp + (size_t)(dir * 32 + g) * 4096, af, pt, r, h, bur, bui);
                const f32x2 A = SAp[(dir * 32 + g) * 64 + pt * 32 + r];
                float a2r = A[0] * A[0] - A[1] * A[1], a2i = 2.f * A[0] * A[1];
                const float a4r = a2r * a2r - a2i * a2i, a4i = 2.f * a2r * a2i, a8r = a4r * a4r - a4i * a4i, a8i = 2.f * a4r * a4i;
                const f32x2 cin = s5_cin(p.ws, b, dir, g)[(size_t)ck * 64 + pt * 32 + r];
                float Sr = cin[0], Si = cin[1];
                static_for<0, 4>([&](auto kc) {
                    constexpr int q = dir ? 3 - decltype(kc)::value : decltype(kc)::value;
                    float Br, Bi; s5_quad<dir == 0, q>(bur, bui, A[0], A[1], Br, Bi);
                    const float Pr = __shfl_xor(Br, 32), Pi = __shfl_xor(Bi, 32);
                    const bool own_first = (dir == 0) ? (h == 0) : (h == 1);
                    float er = Sr, ei = Si;
                    if (!own_first) cmad(er, ei, a4r, a4i, Pr, Pi);
                    float fr = own_first ? Br : Pr, fi = own_first ? Bi : Pi; const float sr = own_first ? Pr : Br, si = own_first ? Pi : Bi;
                    cmad(fr, fi, a4r, a4i, sr, si);
                    cmad(Sr, Si, a8r, a8i, fr, fi);
                    static_for<0, 4>([&](auto jc) {
                        constexpr int i = dir ? 4 * q + 3 - decltype(jc)::value : 4 * q + decltype(jc)::value;
                        cmad(er, ei, A[0], A[1], bur[i], bui[i]);
                        *(unsigned*)(Hs + (8 * (i >> 2) + 4 * h + (i & 3)) * HSP + (pt * 32 + r) * 4) = pk2(er, ei);
                    });
                });
            });
            LDS_FENCE();
            const bf16_t* cp = SCp + (size_t)(dir * 32 + g) * 2 * 16 * 128 + (size_t)c16 * 128 + 8 * kg;
#pragma unroll
            for (int tt = 0; tt < 2; ++tt)
#pragma unroll
                for (int ks = 0; ks < 4; ++ks) {
                    const bf16x8 hf = *(const bf16x8*)(Hs + (16 * tt + c16) * HSP + (32 * ks + 8 * kg) * 2);
                    yacc[tt] = __builtin_amdgcn_mfma_f32_16x16x32_bf16(hf, *(const bf16x8*)(cp + 32 * ks), yacc[tt], 0, 0, 0);
                    yacc[tt] = __builtin_amdgcn_mfma_f32_16x16x32_bf16(hf, *(const bf16x8*)(cp + 2048 + 32 * ks), yacc[tt], 0, 0, 0);
                }
            LDS_FENCE();
        });
        const float dsk = p.s5_d[g * 16 + c16];
#pragma unroll
        for (int tt = 0; tt < 2; ++tt)
#pragma unroll
            for (int i = 0; i < 4; ++i) {
                const size_t row = (size_t)row0 + 16 * tt + 4 * kg + i;
                const float u = bf2f(Z[row * EVEN_IN + g * 16 + c16]);
                G[row * 512 + g * 16 + c16] = f2bf(gelu_tanh(yacc[tt][i] + dsk * u));
            }
    }
}

constexpr int WLP = 144;
DI void lru_load_wl(const int TID, const Params& p, int n, unsigned char* WL, float* CW) {
    for (int idx = TID; idx < 4 * 4096; idx += 512) {
        const int mat = idx >> 12, de = idx & 4095, d = de >> 6, e = de & 63, dir = mat >> 1;
        const float* src = (mat & 1) ? p.lru_wx : p.lru_wa;
        *(bf16_t*)(WL + mat * 64 * WLP + e * WLP + d * 2) = f2bf(src[(size_t)(dir * 8 + n) * 4096 + de]);
    }
    for (int idx = TID; idx < 4096; idx += 512) { const int e = idx >> 6, d = idx & 63; *(bf16_t*)(WL + 4 * 64 * WLP + e * WLP + d * 2) = (e == d) ? (bf16_t)0x3F80 : (bf16_t)0; }
    if (TID < 320) { const int k = TID >> 6, d = TID & 63; CW[TID] = k < 4 ? p.lru_conv_w[k * 512 + n * 64 + d] : p.lru_conv_b[n * 64 + d]; }
}
DI void lru_afrag(const bf16_t* __restrict__ zr, int t, int seq_len, const float* CW, int h, bf16x8 (&af)[4]) {
#pragma unroll
    for (int s = 0; s < 4; ++s) {
        const int d0 = 16 * s + 8 * h;
        float x[8];
#pragma unroll
        for (int j = 0; j < 8; ++j) x[j] = CW[256 + d0 + j];
#pragma unroll
        for (int k = 0; k < 4; ++k) {
            const int tt = t + k - 2;
            if (tt >= 0 && tt < seq_len) {
                const u32x4 v = *(const u32x4*)(zr + (size_t)tt * ODD_IN + d0);
                const float* w = CW + k * 64 + d0;
                x[0] += bflo(v.x) * w[0]; x[1] += bfhi(v.x) * w[1]; x[2] += bflo(v.y) * w[2]; x[3] += bfhi(v.y) * w[3];
                x[4] += bflo(v.z) * w[4]; x[5] += bfhi(v.z) * w[5]; x[6] += bflo(v.w) * w[6]; x[7] += bfhi(v.w) * w[7];
            }
        }
        u32x4 w4; w4.x = pk2(x[0], x[1]); w4.y = pk2(x[2], x[3]); w4.z = pk2(x[4], x[5]); w4.w = pk2(x[6], x[7]);
        af[s] = __builtin_bit_cast(bf16x8, w4);
    }
}
DI void lru_pre(const unsigned char* WL, const bf16x8 (&af)[4], int et, int r, int h, f32x16 (&pre)[5]) {
#pragma unroll
    for (int mat = 0; mat < 5; ++mat) {
#pragma unroll
        for (int i = 0; i < 16; ++i) pre[mat][i] = 0.f;
#pragma unroll
        for (int s = 0; s < 4; ++s) pre[mat] = MFMA32(af[s], *(const bf16x8*)(WL + mat * 64 * WLP + (et * 32 + r) * WLP + (16 * s + 8 * h) * 2), pre[mat]);
    }
}
DI void lru_gates(const f32x16& pa, const f32x16& px, const f32x16& xcv, float ba, float bx, float sp, float (&a)[16], float (&bq)[16]) {
#pragma unroll
    for (int i = 0; i < 16; ++i) {
        const float rg = sigmoid_f(pa[i] + ba), gi = sigmoid_f(px[i] + bx);
        const float la = -8.f * rg * sp;
        const float av = __builtin_amdgcn_exp2f(la * LOG2E);
        a[i] = av; bq[i] = __builtin_amdgcn_sqrtf(fmaxf(fmaf(-av, av, 1.f), 0.f)) * (gi * xcv[i]);
    }
}
template <bool FWD, int Q> DI void lru_quad(const float (&a)[16], const float (&bq)[16], float& A, float& B) {
    constexpr int i0 = FWD ? 4 * Q : 4 * Q + 3, st = FWD ? 1 : -1;
    A = a[i0] * a[i0 + st] * a[i0 + 2 * st] * a[i0 + 3 * st];
    B = ((bq[i0] * a[i0 + st] + bq[i0 + st]) * a[i0 + 2 * st] + bq[i0 + 2 * st]) * a[i0 + 3 * st] + bq[i0 + 3 * st];
}
DI void lru_passA(const int TID, const Params& p, const bf16_t* __restrict__ Z) {
    extern __shared__ __attribute__((aligned(16))) unsigned char smb[];
    const int lane = TID & 63, wave = TID >> 6, r = lane & 31, h = lane >> 5;
    unsigned char* WL = smb; float* CW = (float*)(smb + 5 * 64 * WLP);
    f32x2* SUM = (f32x2*)(p.ws + OFF_ST);
    const int n = blockIdx.x & 7;
    __syncthreads();
    lru_load_wl(TID, p, n, WL, CW);
    __syncthreads();
    for (int item = (blockIdx.x >> 3) * 8 + wave; item < NB * 264; item += (gridDim.x >> 3) * 8) {
        asm volatile("" ::: "memory");
        const int b = item / 264, ck = item % 264;
        const int seq_len = ck < 8 ? CTXL : SEQ, t0 = ck < 8 ? ck * 32 : (ck - 8) * 32, rowbase = ck < 8 ? TL + b * CTXL : b * SEQ;
        bf16x8 af[4];
        lru_afrag(Z + (size_t)rowbase * ODD_IN + 512 + n * 64, t0 + r, seq_len, CW, h, af);
        static_for<0, 2>([&](auto etc) {
            constexpr int et = decltype(etc)::value;
            const int ch = n * 64 + et * 32 + r;
            f32x16 pre[5];
            lru_pre(WL, af, et, r, h, pre);
            static_for<0, 2>([&](auto dc) {
                constexpr int dir = decltype(dc)::value;
                float a[16], bq[16];
                lru_gates(pre[2 * dir], pre[2 * dir + 1], pre[4], p.lru_ba[dir * 512 + ch], p.lru_bx[dir * 512 + ch], log1pf(__expf(-p.lru_lam[dir * 512 + ch])), a, bq);
                float P = 1.f, E = 0.f;
                static_for<0, 4>([&](auto kc) {
                    constexpr int q = dir ? 3 - decltype(kc)::value : decltype(kc)::value;
                    float A, B;
                    lru_quad<dir == 0, q>(a, bq, A, B);
                    const float Ap = __shfl_xor(A, 32), Bp = __shfl_xor(B, 32);
                    const bool own_first = (dir == 0) ? (h == 0) : (h == 1);
                    const float fA = own_first ? A : Ap, fB = own_first ? B : Bp, sA = own_first ? Ap : A, sB = own_first ? Bp : B;
                    const float pA = fA * sA, pB = sA * fB + sB;
                    E = pA * E + pB; P *= pA;
                });
                if (h == 0) SUM[((size_t)(b * 2 + dir) * 264 + ck) * 512 + ch] = (f32x2){P, E};
            });
        });
    }
}
DI void lru_passB(const int TID, const Params& p) {
    const f32x2* SUM = (const f32x2*)(p.ws + OFF_ST); float* LC = (float*)(p.ws + OFF_LCIN);
    for (int idx = blockIdx.x * 512 + TID; idx < NB * 2 * 512; idx += gridDim.x * 512) {
        const int ch = idx & 511, bd = idx >> 9, dir = bd & 1;
        float s = 0.f;
        for (int v0 = 0; v0 < 264; v0 += 24) {
            f32x2 pe[24];
#pragma unroll
            for (int k = 0; k < 24; ++k) { const int v = v0 + k; const int ck = dir == 0 ? v : (v < 8 ? 7 - v : 263 - (v - 8)); pe[k] = SUM[((size_t)bd * 264 + ck) * 512 + ch]; }
#pragma unroll
            for (int k = 0; k < 24; ++k) { const int v = v0 + k; const int ck = dir == 0 ? v : (v < 8 ? 7 - v : 263 - (v - 8)); LC[((size_t)bd * 264 + ck) * 512 + ch] = s; s = pe[k][0] * s + pe[k][1]; }
        }
    }
}
DI void lru_passC(const int TID, const Params& p, const bf16_t* __restrict__ Z, bf16_t* __restrict__ MIX) {
    extern __shared__ __attribute__((aligned(16))) unsigned char smb[];
    const int lane = TID & 63, wave = TID >> 6, r = lane & 31, h = lane >> 5;
    unsigned char* WL = smb; float* CW = (float*)(smb + 5 * 64 * WLP);
    const float* LC = (const float*)(p.ws + OFF_LCIN);
    const int n = blockIdx.x & 7;
    __syncthreads();
    lru_load_wl(TID, p, n, WL, CW);
    __syncthreads();
    for (int item = (blockIdx.x >> 3) * 8 + wave; item < NB * 256; item += (gridDim.x >> 3) * 8) {
        asm volatile("" ::: "memory");
        const int b = item >> 8, j = item & 255, ck = 8 + j, t0 = j * 32;
        bf16x8 af[4];
        lru_afrag(Z + (size_t)b * SEQ * ODD_IN + 512 + n * 64, t0 + r, SEQ, CW, h, af);
        static_for<0, 2>([&](auto etc) {
            constexpr int et = decltype(etc)::value;
            const int ch = n * 64 + et * 32 + r;
            f32x16 pre[5];
            lru_pre(WL, af, et, r, h, pre);
            float y[16];
            static_for<0, 2>([&](auto dc) {
                constexpr int dir = decltype(dc)::value;
                float a[16], bq[16];
                lru_gates(pre[2 * dir], pre[2 * dir + 1], pre[4], p.lru_ba[dir * 512 + ch], p.lru_bx[dir * 512 + ch], log1pf(__expf(-p.lru_lam[dir * 512 + ch])), a, bq);
                float S = LC[((size_t)(b * 2 + dir) * 264 + ck) * 512 + ch];
                static_for<0, 4>([&](auto kc) {
                    constexpr int q = dir ? 3 - decltype(kc)::value : decltype(kc)::value;
                    float A, B;
                    lru_quad<dir == 0, q>(a, bq, A, B);
                    const float Ap = __shfl_xor(A, 32), Bp = __shfl_xor(B, 32);
                    const bool own_first = (dir == 0) ? (h == 0) : (h == 1);
                    float s = own_first ? S : Ap * S + Bp;
                    const float fA = own_first ? A : Ap, fB = own_first ? B : Bp, sA = own_first ? Ap : A, sB = own_first ? Bp : B;
                    S = (fA * sA) * S + (sA * fB + sB);
                    static_for<0, 4>([&](auto jc) {
                        constexpr int i = dir ? 4 * q + 3 - decltype(jc)::value : 4 * q + decltype(jc)::value;
                        s = a[i] * s + bq[i];
                        if (dir == 0) y[i] = s; else y[i] += s;
                    });
                });
            });
#pragma unroll
            for (int i = 0; i < 16; ++i) {
                const size_t row = (size_t)b * SEQ + t0 + 8 * (i >> 2) + 4 * h + (i & 3);
                const float gz = bf2f(Z[row * ODD_IN + ch]);
                MIX[row * DM + ch] = f2bf(y[i] * gelu_tanh(gz));
            }
        });
    }
}

constexpr int NPHASE = 26;
#ifndef MK_RPT
#define MK_RPT 0ull
#endif
#define RPT(bit, ...) do { __VA_ARGS__; if ((MK_RPT >> (bit)) & 1ull) { __syncthreads(); __VA_ARGS__; } } while (0)
DI void run_phase(const int TID, const Params& p, int ph) {
    if (ph == 0) { RPT(0, prologue_phase(TID, p)); return; }
    const int l = ph >= 14 ? 1 : 0;
    int s = l ? ph - 13 : ph;
    if (l && s >= 9) s += 1;
    const int rb = 16 * l;
    unsigned char* ws = p.ws;
    float* ctxx = (float*)(ws + OFF_CTXX);
    const float* modl = (const float*)(ws + OFF_MOD) + (size_t)l * 5 * MODW;
    bf16_t* XN = (bf16_t*)(ws + OFF_XN); bf16_t* H = (bf16_t*)(ws + OFF_H); bf16_t* G = (bf16_t*)(ws + OFF_G);
    const bool first = (l == 0 && s <= 3);
    const float* srcL = first ? p.x : p.out; const float* srcC = ctxx;
    (void)srcC;
    const int nrows = (l == 1 && s >= 10) ? TL : TT;
    const int f = s >= 11 ? 1 : 0;
    const bf16_t* W13 = (const bf16_t*)(ws + OFF_W + (size_t)(l * 2 + f) * SZ_FFN);
    const bf16_t* W2 = (const bf16_t*)(ws + OFF_W + (size_t)(l * 2 + f) * SZ_FFN + SZ_W13);
    switch (s) {
    case 1: case 4: case 11: {
        const int gi = s == 1 ? 0 : (s == 4 ? 1 : 2);
        const int nsl = (l == 0 && s == 1) ? 0 : (s == 11 ? 4 : 11);
        normmod_phase(TID, srcL, ctxx, p.norm_g + (size_t)(l * 3 + gi) * DM, modl, 3 * gi, 3 * gi + 1, XN, nrows, (const float*)(ws + OFF_Q), nsl);
    } break;
    case 2: case 12: { EpiSwiglu e{H}; RPT(rb + s, gemm_phase(TID, XN, W13, nrows, 2 * DFF, DM, e)); } break;
    case 3: case 13: case 10: {
        const float* gbase = modl + (s == 3 ? 2 : (s == 13 ? 8 : 5)) * DM; const float coef = s == 10 ? 1.0f : 0.5f;
        EpiResid e{srcL, srcC, p.out, ctxx, gbase, coef};
        EpiPartial ea{(float*)(ws + OFF_Q), gbase + (size_t)4 * MODW, coef};
        const bf16_t* Wo = (const bf16_t*)(ws + (l ? OFF_ODOUT : OFF_EVOUT));
        if (s == 10) { gemm_phase(TID, XN, Wo, TL, DM, DM, e); if (nrows == TT) gemm_phase(TID, XN + (size_t)TL * DM, Wo, TC, DM, DM, ea, 4); }
        else { gemm_phase(TID, H, W2, TL, DM, DFF, e); if (nrows == TT) gemm_phase(TID, H + (size_t)TL * DFF, W2, TC, DM, DFF, ea, 11); }
    } break;
    case 5: {
        EpiStoreBf16 e{H, l ? ODD_IN : EVEN_IN};
        RPT(rb + s, gemm_phase(TID, XN, (const bf16_t*)(ws + (l ? OFF_ODIN : OFF_EVIN)), TT, l ? ODD_IN : EVEN_IN, DM, e));
    } break;
    case 6:
        if (l == 0) { RPT(6, qkv_post_phase(TID, p, H, EVEN_IN, 512, 8, 1024, 2, 1152, 2, 64, p.swa_qk_g, p.swa_qk_g + 64)); __syncthreads(); RPT(14, s5_passA(TID, p, H)); }
        else { RPT(22, qkv_post_phase(TID, p, H, ODD_IN, 1024, 8, 1536, 8, 2048, 4, 128, p.diff_qk_g, p.diff_qk_g + 64)); __syncthreads(); RPT(30, lru_passA(TID, p, H)); }
        break;
    case 7:
        if (l == 0) { s5_passB(TID, p); RPT(7, swa_attn_phase(TID, p, H, XN)); }
        else { lru_passB(TID, p); RPT(23, diff_attn_phase(TID, p, H, XN, 0.8f - 0.6f * 0.74081822068171788f)); }
        break;
    case 8:
        if (l == 0) RPT(8, s5_passC(TID, p, H, G)); else RPT(24, lru_passC(TID, p, H, XN));
        break;
    case 9: { EpiGlu e{G, p.s5_glu_b, XN}; RPT(9, gemm_phase(TID, G, (const bf16_t*)(ws + OFF_GLUW), TT, 512, 512, e)); } break;
    default: break;
    }
}

DI int mk_tid(int wv) { int l; asm volatile("v_mbcnt_lo_u32_b32 %0, -1, 0\n\tv_mbcnt_hi_u32_b32 %0, -1, %0" : "=v"(l)); return wv * 64 + l; }
#define XB_TMO      128
#define XB_XCNT(j)  (256  + 64 * (j))
#define XB_XSUB(j)  (1280 + 64 * (j))
#define XB_XGEN(j)  (2304 + 64 * (j))
#define XB_TOP      3328
#define XB_TOPGEN   3392
#define XCD_BAR_WORDS 3456
#define XB_SPIN_CAP (1u << 22)
#define LAS __attribute__((address_space(3)))
DI unsigned xb_ld(unsigned* p) { return __hip_atomic_load(p, __ATOMIC_RELAXED, __HIP_MEMORY_SCOPE_AGENT); }
DI unsigned xb_add(unsigned* p, unsigned v) { return __hip_atomic_fetch_add(p, v, __ATOMIC_RELAXED, __HIP_MEMORY_SCOPE_AGENT); }
DI unsigned xb_xcc_id() { return (unsigned)__builtin_amdgcn_s_getreg((3 << 11) | 20) & 0xFu; }
#define XB_SPIN(cond, bar) do { unsigned _sp = 0; while (cond) { __builtin_amdgcn_s_sleep(1); \
    if ((++_sp & 255u) == 0u) { if (xb_ld(&(bar)[XB_TMO])) break; if (_sp > XB_SPIN_CAP) { atomicAdd(&(bar)[XB_TMO], 1u); break; } } } } while (0)
DI void xcd_barrier_complete(unsigned* bar, unsigned x, unsigned& nloc, unsigned& nx) {
    const unsigned G = gridDim.x;
    unsigned sum, cnt, mine, sp = 0u;
    for (;;) {
        sum = 0u; cnt = 0u; mine = 0u;
#pragma unroll
        for (unsigned j = 0; j < 16; ++j) { const unsigned c = xb_ld(&bar[XB_XCNT(j)]); sum += c; cnt += (c > 0u) ? 1u : 0u; mine = (j == x) ? c : mine; }
        if (sum == G) break;
        __builtin_amdgcn_s_sleep(1);
        if ((++sp & 255u) == 0u) { if (xb_ld(&bar[XB_TMO])) break; if (sp > XB_SPIN_CAP) { atomicAdd(&bar[XB_TMO], 1u); break; } }
    }
    nloc = mine > 0u ? mine : 1u; nx = cnt > 0u ? cnt : 1u;
}
DI void xcd_barrier(unsigned* bar, int tid) {
    extern __shared__ __attribute__((aligned(16))) unsigned char smx[];
    volatile LAS unsigned* st = (volatile LAS unsigned*)(smx + 131072);
    asm volatile("s_waitcnt vmcnt(0)" ::: "memory");
    __syncthreads();
    if (tid == 0) {
        const unsigned x = xb_xcc_id();
        __builtin_amdgcn_s_waitcnt(0);
        unsigned nloc = st[0], nx = st[1];
        if (nloc == 0u) { xcd_barrier_complete(bar, x, nloc, nx); st[0] = nloc; st[1] = nx; }
        const unsigned old = xb_add(&bar[XB_XSUB(x)], 1u);
        const unsigned gen = old / nloc;
        if (old + 1u == (gen + 1u) * nloc) {
            __builtin_amdgcn_fence(__ATOMIC_RELEASE, "agent");
            asm volatile("s_waitcnt vmcnt(0)" ::: "memory");
            const unsigned og = xb_add(&bar[XB_TOP], 1u);
            const unsigned tg = og / nx;
            if (og + 1u == (tg + 1u) * nx) xb_add(&bar[XB_TOPGEN], 1u);
            else XB_SPIN(xb_ld(&bar[XB_TOPGEN]) == tg, bar);
            __builtin_amdgcn_fence(__ATOMIC_ACQUIRE, "agent");
            xb_add(&bar[XB_XGEN(x)], 1u);
            asm volatile("s_waitcnt vmcnt(0)" ::: "memory");
        } else {
            XB_SPIN(xb_ld(&bar[XB_XGEN(x)]) == gen, bar);
            __builtin_amdgcn_fence(__ATOMIC_ACQUIRE, "agent");
            asm volatile("s_waitcnt vmcnt(0)" ::: "memory");
        }
    }
    __syncthreads();
}
template <int K>
DI void run_all(const int wv, const Params& p, int lo, int hi) {
    if constexpr (K < NPHASE) {
        if (K >= lo && K < hi) {
            const int tid = mk_tid(wv);
            run_phase(tid, p, K);
            if (K + 1 < hi) { xcd_barrier((unsigned*)(p.ws + OFF_BAR), tid); if ((MK_RPT >> 63) & 1ull) xcd_barrier((unsigned*)(p.ws + OFF_BAR), tid); }
        }
        run_all<K + 1>(wv, p, lo, hi);
    }
}
__global__ void __launch_bounds__(512) mega_fwd(Params p, int ph_lo, int ph_hi) {
    const int wv = __builtin_amdgcn_readfirstlane((int)(threadIdx.x >> 6));
    {
        extern __shared__ __attribute__((aligned(16))) unsigned char smx[];
        if (threadIdx.x == 0) { *(u32x4*)(smx + 131072) = (u32x4){0u, 0u, 0u, 0u}; (void)xb_add((unsigned*)(p.ws + OFF_BAR) + XB_XCNT(xb_xcc_id()), 1u); }
        __syncthreads();
    }
    if (ph_hi - ph_lo > 1) cg::this_grid().sync();
    run_all<0>(wv, p, ph_lo, ph_hi);
}

#ifndef MK_MULTI
#define MK_MULTI 0
#endif
extern "C" void kernel_launch(void* const* d_in, const int* in_sizes, int n_in, void* d_out, int out_size, void* d_ws, size_t ws_size, hipStream_t stream) {
    static int grid = 0;
    if (grid == 0) {
        if (n_in != 37 || in_sizes[0] != TL * DM || out_size != TL * DM || ws_size < WS_END) {
            fprintf(stderr, "kernel_launch: unexpected problem: n_in %d in0 %d out %d ws %zu (need %zu)\n", n_in, n_in > 0 ? in_sizes[0] : -1, out_size, ws_size, (size_t)WS_END);
            grid = -1; return;
        }
        int dev = 0, cus = 0, per_cu = 0;
        (void)hipGetDevice(&dev);
        (void)hipDeviceGetAttribute(&cus, hipDeviceAttributeMultiprocessorCount, dev);
        if (hipFuncSetAttribute((const void*)mega_fwd, hipFuncAttributeMaxDynamicSharedMemorySize, LDS_BYTES) != hipSuccess) { fprintf(stderr, "kernel_launch: hipFuncSetAttribute failed\n"); grid = -1; return; }
        (void)hipOccupancyMaxActiveBlocksPerMultiprocessor(&per_cu, (const void*)mega_fwd, 512, LDS_BYTES);
        if (per_cu < 1) { fprintf(stderr, "kernel_launch: occupancy query says %d blocks per CU\n", per_cu); per_cu = 1; }
        (void)hipGetLastError();
        grid = cus * per_cu;
    }
    if (grid < 0) return;
    if (hipMemsetAsync((unsigned char*)d_ws + OFF_BAR, 0, 16384, stream) != hipSuccess) { fprintf(stderr, "kernel_launch: memset failed\n"); return; }
    Params p{};
    const float** pp = (const float**)&p;
    for (int i = 0; i < 37; ++i) pp[i] = (const float*)d_in[i];
    p.out = (float*)d_out; p.ws = (unsigned char*)d_ws;
#if MK_MULTI
    for (int ph = 0; ph < NPHASE; ++ph) hipLaunchKernelGGL(mega_fwd, dim3(grid), dim3(512), LDS_BYTES, stream, p, ph, ph + 1);
#else
    int lo = 0, hi = NPHASE;
    void* args[] = {&p, &lo, &hi};
    hipError_t e = hipLaunchCooperativeKernel((const void*)mega_fwd, dim3(grid), dim3(512), args, LDS_BYTES, stream);
    if (e != hipSuccess) fprintf(stderr, "kernel_launch: cooperative launch failed: %s (grid %d)\n", hipGetErrorString(e), grid);
#endif
}
```
